# Optimizing an MI355X kernel written in HIP

```python
import jax
import jax.numpy as jnp
from jax import lax
import numpy as np

D_MODEL = 2048
BATCH = 2
SEQ = 4096
DEPTH = 1

MEM_LEN = 256
EPS = 1e-6
MLSTM_HEADS = 4
MLSTM_QK = 128
MLSTM_V = 256
MLSTM_CHUNK = 64
CONV_WIDTH = 4
HGRN_HEADS = 8
HGRN_DK = 128
HGRN_DV = 128
HGRN_CHUNK = 16
XATTN_HEADS = 4
XATTN_HEAD_DIM = D_MODEL // XATTN_HEADS
D_FF = 5632

MLSTM_QK_W = MLSTM_HEADS * MLSTM_QK
MLSTM_V_W = MLSTM_HEADS * MLSTM_V
HGRN_K_W = HGRN_HEADS * HGRN_DK
HGRN_V_W = HGRN_HEADS * HGRN_DV
SPLIT_SIZES = (MLSTM_QK_W, MLSTM_QK_W, MLSTM_V_W, MLSTM_V_W, MLSTM_HEADS, MLSTM_HEADS,
               HGRN_K_W, HGRN_K_W, HGRN_V_W, HGRN_V_W, D_MODEL, D_MODEL)
D_IN = (2 * MLSTM_QK_W + 2 * MLSTM_V_W + 2 * MLSTM_HEADS + 2 * HGRN_K_W + 2 * HGRN_V_W + 2 * D_MODEL)

kernel_name = 'hybrid_mlstm_hgrn2_macaron_block'


def rmsnorm(x, g):
    xf = x.astype(jnp.float32)
    y = xf * lax.rsqrt(jnp.mean(xf * xf, axis=-1, keepdims=True) + EPS)
    return (y * g.astype(jnp.float32)).astype(x.dtype)


def head_rmsnorm(h, g):
    n_h, d = h.shape[1], h.shape[3]
    y = h * lax.rsqrt(jnp.mean(h * h, axis=-1, keepdims=True) + EPS)
    return y * g.astype(jnp.float32).reshape(1, n_h, 1, d)


def split_heads(t, n_heads):
    b, s, _ = t.shape
    return t.reshape(b, s, n_heads, -1).transpose(0, 2, 1, 3)


def merge_heads(t):
    b, h, s, d = t.shape
    return t.transpose(0, 2, 1, 3).reshape(b, s, h * d)


def to_chunks(t, chunk):
    b, h, s = t.shape[:3]
    return jnp.moveaxis(t.reshape((b, h, s // chunk, chunk) + t.shape[3:]), 2, 0)


def from_chunks(t):
    nc, b, h, l, d = t.shape
    return jnp.moveaxis(t, 0, 2).reshape(b, h, nc * l, d)


def causal_conv(x, w, b):
    c = x.shape[-1]
    y = lax.conv_general_dilated(x, w[:, None, :].astype(x.dtype), window_strides=(1,),
                                 padding=[(CONV_WIDTH - 1, 0)],
                                 dimension_numbers=('NWC', 'WIO', 'NWC'), feature_group_count=c)
    return y + b.astype(x.dtype)


def swiglu(h, w1, w3, w2):
    return (jax.nn.silu(h @ w1) * (h @ w3)) @ w2


def mlstm_chunkwise(q, k, v, i_pre, f_log):
    b_, h_, _, dk = q.shape
    dv = v.shape[-1]
    causal = jnp.tril(jnp.ones((MLSTM_CHUNK, MLSTM_CHUNK), dtype=bool))

    def step(carry, inp):
        c_state, n_state, m_state = carry
        qc, kc, vc, ic, fc = inp
        b = jnp.cumsum(fc, axis=-1)
        d_log = jnp.where(causal, b[..., :, None] - b[..., None, :] + ic[..., None, :], -jnp.inf)
        inter_log = b + m_state[..., None]
        m_t = jnp.maximum(jnp.max(d_log, axis=-1), inter_log)
        s = jnp.einsum('bhtd,bhsd->bhts', qc, kc) * jnp.exp(d_log - m_t[..., None])
        w_inter = jnp.exp(inter_log - m_t)
        num = jnp.einsum('bhts,bhse->bhte', s, vc) + w_inter[..., None] * jnp.einsum('bhtd,bhde->bhte', qc, c_state)
        den = jnp.sum(s, axis=-1) + w_inter * jnp.einsum('bhtd,bhd->bht', qc, n_state)
        h = num / jnp.maximum(jnp.abs(den), jnp.exp(-m_t))[..., None]
        b_last = b[..., -1]
        a_log = b_last[..., None] - b + ic
        m_new = jnp.maximum(b_last + m_state, jnp.max(a_log, axis=-1))
        w_a = jnp.exp(a_log - m_new[..., None])
        decay = jnp.exp(b_last + m_state - m_new)
        c_state = decay[..., None, None] * c_state + jnp.einsum('bhs,bhsd,bhse->bhde', w_a, kc, vc)
        n_state = decay[..., None] * n_state + jnp.einsum('bhs,bhsd->bhd', w_a, kc)
        return (c_state, n_state, m_new), h

    init = (jnp.zeros((b_, h_, dk, dv), jnp.float32), jnp.zeros((b_, h_, dk), jnp.float32),
            jnp.zeros((b_, h_), jnp.float32))
    xs = (to_chunks(q, MLSTM_CHUNK), to_chunks(k, MLSTM_CHUNK), to_chunks(v, MLSTM_CHUNK),
          to_chunks(i_pre, MLSTM_CHUNK), to_chunks(f_log, MLSTM_CHUNK))
    _, h = lax.scan(step, init, xs)
    return from_chunks(h)


def hgrn2_chunkwise(q, k, v, g_log):
    b_, h_, _, dk = q.shape
    dv = v.shape[-1]
    causal = jnp.tril(jnp.ones((HGRN_CHUNK, HGRN_CHUNK), dtype=bool))

    def step(state, inp):
        qc, kc, vc, gc = inp
        g = jnp.cumsum(gc, axis=-2)
        diff = jnp.where(causal[:, :, None], g[..., :, None, :] - g[..., None, :, :], -jnp.inf)
        a = jnp.einsum('bhtd,bhsd,bhtsd->bhts', qc, kc, jnp.exp(diff))
        o = jnp.einsum('bhts,bhse->bhte', a, vc) + jnp.einsum('bhtd,bhde->bhte', qc * jnp.exp(g), state)
        g_last = g[..., -1, :]
        state = jnp.exp(g_last)[..., None] * state + jnp.einsum(
            'bhsd,bhse->bhde', kc * jnp.exp(g_last[..., None, :] - g), vc)
        return state, o

    init = jnp.zeros((b_, h_, dk, dv), jnp.float32)
    xs = (to_chunks(q, HGRN_CHUNK), to_chunks(k, HGRN_CHUNK), to_chunks(v, HGRN_CHUNK),
          to_chunks(g_log, HGRN_CHUNK))
    _, o = lax.scan(step, init, xs)
    return from_chunks(o)


def mlstm_mixer(q_raw, k_raw, v_raw, o_raw, i_raw, f_raw, conv_w, conv_b, ig_bias, fg_bias, head_norm):
    qk = jax.nn.silu(causal_conv(jnp.concatenate([q_raw, k_raw], axis=-1), conv_w, conv_b)).astype(jnp.float32)
    q, k = jnp.split(qk, 2, axis=-1)
    q = split_heads(q, MLSTM_HEADS)
    k = split_heads(k, MLSTM_HEADS) * (MLSTM_QK ** -0.5)
    v = split_heads(v_raw.astype(jnp.float32), MLSTM_HEADS)
    i_pre = (i_raw.astype(jnp.float32) + ig_bias.astype(jnp.float32)).transpose(0, 2, 1)
    f_log = jax.nn.log_sigmoid(f_raw.astype(jnp.float32) + fg_bias.astype(jnp.float32)).transpose(0, 2, 1)
    h = mlstm_chunkwise(q, k, v, i_pre, f_log)
    h = merge_heads(head_rmsnorm(h, head_norm))
    return h * jax.nn.sigmoid(o_raw.astype(jnp.float32))


def hgrn2_mixer(q_raw, f_raw, i_raw, g_raw, lb, head_norm):
    q = split_heads(jax.nn.silu(q_raw.astype(jnp.float32)), HGRN_HEADS) * (HGRN_DK ** -0.5)
    f = lb + (1.0 - lb) * jax.nn.sigmoid(f_raw.astype(jnp.float32))
    k = split_heads(1.0 - f, HGRN_HEADS)
    g_log = split_heads(jnp.log(f), HGRN_HEADS)
    v = split_heads(i_raw.astype(jnp.float32), HGRN_HEADS)
    o = hgrn2_chunkwise(q, k, v, g_log)
    o = merge_heads(head_rmsnorm(o, head_norm))
    return o * jax.nn.silu(g_raw.astype(jnp.float32))


def cross_attention(xn, memn, w_q, w_kv, w_o):
    b, s, _ = xn.shape
    m = memn.shape[1]
    q = (xn @ w_q).reshape(b, s, XATTN_HEADS, XATTN_HEAD_DIM)
    k, v = jnp.split(memn @ w_kv, 2, axis=-1)
    k = k.reshape(b, m, XATTN_HEADS, XATTN_HEAD_DIM)
    v = v.reshape(b, m, XATTN_HEADS, XATTN_HEAD_DIM)
    scores = jnp.einsum('bthd,bmhd->bhtm', q, k).astype(jnp.float32) * (XATTN_HEAD_DIM ** -0.5)
    p = jax.nn.softmax(scores, axis=-1).astype(v.dtype)
    o = jnp.einsum('bhtm,bmhd->bthd', p, v).reshape(b, s, D_MODEL)
    return o @ w_o


def setup_inputs(seed: int = 0) -> dict:
    key = jax.random.key(seed)
    ks = jax.random.split(key, 32)

    def normal(k, shape, scale):
        return scale * jax.random.normal(k, shape, jnp.float32)

    def gain(k, shape):
        return 1.0 + normal(k, shape, 0.02)

    fg_base = jnp.linspace(3.0, 6.0, MLSTM_HEADS, dtype=jnp.float32)[None, :]
    return {
        'x': normal(ks[0], (BATCH, SEQ, D_MODEL), 1.0),
        'mem': normal(ks[1], (BATCH, MEM_LEN, D_MODEL), 1.0),
        'norm_ffn1': gain(ks[2], (DEPTH, D_MODEL)),
        'ffn1_w1': normal(ks[3], (DEPTH, D_MODEL, D_FF), D_MODEL ** -0.5),
        'ffn1_w3': normal(ks[4], (DEPTH, D_MODEL, D_FF), D_MODEL ** -0.5),
        'ffn1_w2': normal(ks[5], (DEPTH, D_FF, D_MODEL), D_FF ** -0.5),
        'norm_mix': gain(ks[6], (DEPTH, D_MODEL)),
        'w_in': normal(ks[7], (DEPTH, D_MODEL, D_IN), D_MODEL ** -0.5),
        'mlstm_conv_w': normal(ks[8], (DEPTH, CONV_WIDTH, 2 * MLSTM_QK_W), CONV_WIDTH ** -0.5),
        'mlstm_conv_b': normal(ks[9], (DEPTH, 2 * MLSTM_QK_W), 0.02),
        'mlstm_ig_bias': normal(ks[10], (DEPTH, MLSTM_HEADS), 0.1),
        'mlstm_fg_bias': fg_base + normal(ks[11], (DEPTH, MLSTM_HEADS), 0.01),
        'mlstm_head_norm': gain(ks[12], (DEPTH, MLSTM_V_W)),
        'hgrn_lb_logits': normal(ks[13], (DEPTH + 1, HGRN_K_W), 0.1),
        'hgrn_head_norm': gain(ks[14], (DEPTH, HGRN_V_W)),
        'w_proj_m': normal(ks[15], (DEPTH, MLSTM_V_W, D_MODEL), MLSTM_V_W ** -0.5),
        'w_proj_h': normal(ks[16], (DEPTH, HGRN_V_W, D_MODEL), HGRN_V_W ** -0.5),
        'w_out': normal(ks[17], (DEPTH, D_MODEL, D_MODEL), D_MODEL ** -0.5),
        'norm_xattn': gain(ks[18], (DEPTH, D_MODEL)),
        'norm_mem': gain(ks[19], (DEPTH, D_MODEL)),
        'xattn_wq': normal(ks[20], (DEPTH, D_MODEL, D_MODEL), D_MODEL ** -0.5),
        'xattn_wkv': normal(ks[21], (DEPTH, D_MODEL, 2 * D_MODEL), D_MODEL ** -0.5),
        'xattn_wo': normal(ks[22], (DEPTH, D_MODEL, D_MODEL), D_MODEL ** -0.5),
        'norm_ffn2': gain(ks[23], (DEPTH, D_MODEL)),
        'ffn2_w1': normal(ks[24], (DEPTH, D_MODEL, D_FF), D_MODEL ** -0.5),
        'ffn2_w3': normal(ks[25], (DEPTH, D_MODEL, D_FF), D_MODEL ** -0.5),
        'ffn2_w2': normal(ks[26], (DEPTH, D_FF, D_MODEL), D_FF ** -0.5),
        'norm_final': gain(ks[27], (D_MODEL,)),
    }


def reference(x, mem, norm_ffn1, ffn1_w1, ffn1_w3, ffn1_w2, norm_mix, w_in, mlstm_conv_w, mlstm_conv_b,
              mlstm_ig_bias, mlstm_fg_bias, mlstm_head_norm, hgrn_lb_logits, hgrn_head_norm, w_proj_m,
              w_proj_h, w_out, norm_xattn, norm_mem, xattn_wq, xattn_wkv, xattn_wo, norm_ffn2, ffn2_w1,
              ffn2_w3, ffn2_w2, norm_final):
    split_points = []
    acc = 0
    for size in SPLIT_SIZES[:-1]:
        acc += size
        split_points.append(acc)
    lb_all = jnp.cumsum(jax.nn.softmax(hgrn_lb_logits.astype(jnp.float32), axis=0), axis=0)
    for l in range(DEPTH):
        h = rmsnorm(x, norm_ffn1[l])
        x = x + 0.5 * swiglu(h, ffn1_w1[l], ffn1_w3[l], ffn1_w2[l])
        h = rmsnorm(x, norm_mix[l])
        (mq, mk, mv, mo, mi, mf, hq, hf, hi, hg, gate_m, gate_h) = jnp.split(h @ w_in[l], split_points, axis=-1)
        y_m = mlstm_mixer(mq, mk, mv, mo, mi, mf, mlstm_conv_w[l], mlstm_conv_b[l], mlstm_ig_bias[l],
                          mlstm_fg_bias[l], mlstm_head_norm[l]).astype(x.dtype)
        lb = lb_all[l + 1] - lb_all[0]
        y_h = hgrn2_mixer(hq, hf, hi, hg, lb, hgrn_head_norm[l]).astype(x.dtype)
        merged = jax.nn.sigmoid(gate_m) * (y_m @ w_proj_m[l]) + jax.nn.sigmoid(gate_h) * (y_h @ w_proj_h[l])
        x = x + merged @ w_out[l]
        h = rmsnorm(x, norm_xattn[l])
        m = rmsnorm(mem, norm_mem[l])
        x = x + cross_attention(h, m, xattn_wq[l], xattn_wkv[l], xattn_wo[l])
        h = rmsnorm(x, norm_ffn2[l])
        x = x + 0.5 * swiglu(h, ffn2_w1[l], ffn2_w3[l], ffn2_w2[l])
    return rmsnorm(x, norm_final)
```

```cpp
#include <hip/hip_runtime.h>
#include <cstdio>
#include <cstdint>

#define LAS __attribute__((address_space(3)))
#define GAS __attribute__((address_space(1)))
typedef unsigned short bf16;
typedef short bf16x8 __attribute__((ext_vector_type(8)));
typedef float f32x4 __attribute__((ext_vector_type(4)));
typedef float f32x2 __attribute__((ext_vector_type(2)));
typedef unsigned u32x4 __attribute__((ext_vector_type(4)));
typedef unsigned u32x2 __attribute__((ext_vector_type(2)));
typedef unsigned long long u64;

constexpr int NB = 2, T = 4096, D = 2048, FF = 5632, M = NB * T;
constexpr int MEM = 256, DIN = 11272;
constexpr float EPS = 1e-6f;
constexpr int NWAVES = 8, NTHR = 512;

constexpr size_t MiB = 1u << 20;
constexpr size_t WS_CTL = 0, CTL_ZERO_BYTES = 1 * MiB;
constexpr size_t WS_SMALL = 1 * MiB;
constexpr size_t WS_MEMN = 3 * MiB;
constexpr size_t WS_KV = 5 * MiB;
constexpr size_t WS_WQKT = 9 * MiB;
constexpr size_t WS_VWOT = 17 * MiB;
constexpr size_t WS_W13 = 25 * MiB;
constexpr size_t WS_W2T = 69 * MiB;
constexpr size_t WS_WIN = 91 * MiB;
constexpr size_t WS_WG = 120 * MiB;
constexpr size_t WS_WPM = 136 * MiB, WS_WPH = 140 * MiB;
constexpr size_t WS_WOUT = 144 * MiB;
constexpr size_t WS_WQ = 152 * MiB;
constexpr size_t WS_WKV = 160 * MiB;
constexpr size_t WS_WO = 176 * MiB;
constexpr size_t WS_X = 184 * MiB;
constexpr size_t WS_XB = 248 * MiB;
constexpr size_t WS_AR = 280 * MiB;
constexpr size_t WS_END = 512 * MiB;
constexpr size_t AR_ACT = WS_AR;
constexpr size_t AR_QKRAW = WS_AR, AR_QC = WS_AR + 16 * MiB, AR_KC = WS_AR + 24 * MiB, AR_MV = WS_AR + 32 * MiB, AR_MO = WS_AR + 48 * MiB;
constexpr size_t AR_HQ = WS_AR + 64 * MiB, AR_HF = WS_AR + 80 * MiB, AR_HI = WS_AR + 96 * MiB, AR_HG = WS_AR + 112 * MiB;
constexpr size_t AR_MST = WS_AR + 128 * MiB;
constexpr size_t AR_HST = WS_AR + 160 * MiB;
constexpr size_t AR_YM = WS_AR + 192 * MiB, AR_YH = WS_AR + 208 * MiB;
constexpr size_t AR_GM = WS_X, AR_GH = WS_X + 32 * MiB;
constexpr size_t AR_TMP = WS_AR;
constexpr size_t AR_MERGED = WS_AR + 64 * MiB;
constexpr size_t AR_SC = WS_AR;
constexpr size_t AR_P = WS_AR + 32 * MiB;
static_assert(AR_YH + 16 * MiB <= WS_END, "arena");
constexpr size_t SM_GATES = 0;
constexpr size_t SM_BLAST = 256 * 1024;
constexpr size_t SM_MLOC = SM_BLAST + 2048;
constexpr size_t SM_MPREV = SM_MLOC + 2048;
constexpr size_t SM_DN = 512 * 1024;
constexpr size_t SM_DEC = 768 * 1024;
constexpr int CW_BAR = 4096;
constexpr int CW_PANEL = 8192;
constexpr size_t CTL_SS = 64 * 1024;
constexpr float SS_SCALE = 16777216.0f, SS_INV = 1.0f / (16777216.0f * 2048.0f);

constexpr int LDS_BYTES = 163840, RING_BYTES = 131072, MISC_OFF = LDS_BYTES - 256;

#define RLX_AGENT __ATOMIC_RELAXED, __HIP_MEMORY_SCOPE_AGENT
__device__ __forceinline__ unsigned f2bf(float f) { unsigned u = __builtin_bit_cast(unsigned, f); return (u + 0x7fffu + ((u >> 16) & 1u)) >> 16; }
__device__ __forceinline__ float bf2f(unsigned h) { return __builtin_bit_cast(float, (h & 0xffffu) << 16); }
typedef float f32x2_t __attribute__((ext_vector_type(2))); typedef __bf16 bf16x2_t __attribute__((ext_vector_type(2)));
__device__ __forceinline__ unsigned pk2(float lo, float hi) { f32x2_t v = {lo, hi}; bf16x2_t b = __builtin_convertvector(v, bf16x2_t); return __builtin_bit_cast(unsigned, b); }
__device__ __forceinline__ float lo_bf(unsigned w) { return __builtin_bit_cast(float, w << 16); }
__device__ __forceinline__ float hi_bf(unsigned w) { return __builtin_bit_cast(float, w & 0xffff0000u); }
__device__ __forceinline__ float sigmoidf_(float x) { return __builtin_amdgcn_rcpf(1.0f + __expf(-x)); }
__device__ __forceinline__ float siluf_(float x) { return x * __builtin_amdgcn_rcpf(1.0f + __expf(-x)); }
__device__ __forceinline__ float wave_sum(float v) {
#pragma unroll
    for (int o = 1; o < 64; o <<= 1) v += __shfl_xor(v, o);
    return v;
}
__device__ __forceinline__ float wave_max(float v) {
#pragma unroll
    for (int o = 1; o < 64; o <<= 1) v = fmaxf(v, __shfl_xor(v, o));
    return v;
}

#define XB_TMO      128
#define XB_XCNT(j)  (256  + 64 * (j))
#define XB_XSUB(j)  (1280 + 64 * (j))
#define XB_XGEN(j)  (2304 + 64 * (j))
#define XB_TOP      3328
#define XB_TOPGEN   3392
#define XCD_BAR_WORDS 3456
#define XB_LSUB(j)  (3456 + 32 * (j))
#define XB_LGEN(j)  (3712 + 32 * (j))
#define XB_SPIN_CAP (1u << 18)
__device__ __forceinline__ unsigned xb_ld(unsigned* p)              { return __hip_atomic_load(p, __ATOMIC_RELAXED, __HIP_MEMORY_SCOPE_AGENT); }
__device__ __forceinline__ unsigned xb_add(unsigned* p, unsigned v) { return __hip_atomic_fetch_add(p, v, __ATOMIC_RELAXED, __HIP_MEMORY_SCOPE_AGENT); }
__device__ __forceinline__ unsigned xb_xcc_id() { return (unsigned)__builtin_amdgcn_s_getreg((3 << 11) | 20) & 0xFu; }
__device__ __forceinline__ unsigned l2_add(unsigned* p, unsigned v) {
    unsigned r; asm volatile("global_atomic_add %0, %1, %2, off sc0\n\ts_waitcnt vmcnt(0)" : "=&v"(r) : "v"(p), "v"(v) : "memory"); return r; }
#define XB_SPIN(cond, bar) do { unsigned _sp = 0; while (cond) { __builtin_amdgcn_s_sleep(1); \
    if ((++_sp & 255u) == 0u) { if (xb_ld(&(bar)[XB_TMO])) break; if (_sp > XB_SPIN_CAP) { atomicAdd(&(bar)[XB_TMO], 1u); break; } } } } while (0)
struct XcdBarrier { unsigned* bar; unsigned x; volatile LAS unsigned* st; };
__device__ __forceinline__ XcdBarrier xcd_barrier_post(unsigned* bar, volatile LAS unsigned* st) {
    XcdBarrier b; b.bar = bar; b.x = xb_xcc_id(); b.st = st;
    if (threadIdx.x == 0) st[2] = xb_add(&bar[XB_XCNT(b.x)], 1u);
    return b;
}
__device__ __forceinline__ void xcd_barrier_complete(unsigned* bar, unsigned x, unsigned& nloc, unsigned& nx, unsigned& uniform) {
    const unsigned G = gridDim.x * gridDim.y * gridDim.z;
    unsigned sum, cnt, mine, sp = 0u;
    for (;;) {
        sum = 0u; cnt = 0u; mine = 0u;
#pragma unroll
        for (unsigned j = 0; j < 16; ++j) { const unsigned c = xb_ld(&bar[XB_XCNT(j)]); sum += c; cnt += (c > 0u) ? 1u : 0u; mine = (j == x) ? c : mine; }
        if (sum == G) break;
        __builtin_amdgcn_s_sleep(1);
        if ((++sp & 255u) == 0u) { if (xb_ld(&bar[XB_TMO])) break; if (sp > XB_SPIN_CAP) { atomicAdd(&bar[XB_TMO], 1u); break; } }
    }
    nloc = mine > 0u ? mine : 1u; nx = cnt > 0u ? cnt : 1u;
    uniform = (G == 256u && cnt == 8u) ? 1u : 0u;
#pragma unroll
    for (unsigned j = 0; j < 8; ++j) if (xb_ld(&bar[XB_XCNT(j)]) != 32u) uniform = 0u;
}
__device__ __forceinline__ void xcd_barrier(const XcdBarrier& b) {
    asm volatile("s_waitcnt vmcnt(0)" ::: "memory");
    __syncthreads();
    if (threadIdx.x == 0) {
        unsigned* bar = b.bar;
        __builtin_amdgcn_s_waitcnt(0);
        unsigned nloc = b.st[0], nx = b.st[1];
        if (nloc == 0u) { unsigned uni; xcd_barrier_complete(bar, b.x, nloc, nx, uni); b.st[0] = nloc; b.st[1] = nx; b.st[3] = uni; }
        const unsigned old = xb_add(&bar[XB_XSUB(b.x)], 1u);
        const unsigned gen = old / nloc;
        if (old + 1u == (gen + 1u) * nloc) {
            __builtin_amdgcn_fence(__ATOMIC_RELEASE, "agent");
            asm volatile("s_waitcnt vmcnt(0)" ::: "memory");
            const unsigned og = xb_add(&bar[XB_TOP], 1u);
            const unsigned tg = og / nx;
            if (og + 1u == (tg + 1u) * nx) xb_add(&bar[XB_TOPGEN], 1u);
            else XB_SPIN(xb_ld(&bar[XB_TOPGEN]) == tg, bar);
            __builtin_amdgcn_fence(__ATOMIC_ACQUIRE, "agent");
            xb_add(&bar[XB_XGEN(b.x)], 1u);
            asm volatile("s_waitcnt vmcnt(0)" ::: "memory");
        } else {
            XB_SPIN(xb_ld(&bar[XB_XGEN(b.x)]) == gen, bar);
            __builtin_amdgcn_fence(__ATOMIC_ACQUIRE, "agent");
            asm volatile("s_waitcnt vmcnt(0)" ::: "memory");
        }
    }
    __syncthreads();
}

__device__ __forceinline__ void xcd_local_barrier(const XcdBarrier& b, const int pg = -1, unsigned* pgw = nullptr) {
    asm volatile("s_waitcnt vmcnt(0)" ::: "memory");
    __syncthreads();
    if (threadIdx.x == 0) {
        unsigned* bar = b.bar;
        __builtin_amdgcn_s_waitcnt(0);
        const unsigned nloc = pg < 0 ? b.st[0] : 8u;
        unsigned* sub = pg < 0 ? &bar[XB_LSUB(b.x)] : pgw + 64 * (4 * (int)b.x + pg); unsigned* gnp = pg < 0 ? &bar[XB_LGEN(b.x)] : pgw + 64 * (4 * (int)b.x + pg) + 32;
        const unsigned old = l2_add(sub, 1u);
        const unsigned gen = old / nloc;
        if (old + 1u == (gen + 1u) * nloc) l2_add(gnp, 1u);
        else XB_SPIN(l2_add(gnp, 0u) == gen, bar);
        __builtin_amdgcn_fence(__ATOMIC_ACQUIRE, "agent");
        asm volatile("s_waitcnt vmcnt(0)" ::: "memory");
    }
    __syncthreads();
}
__device__ __forceinline__ void publish_count(unsigned* ctr) {
    asm volatile("s_waitcnt vmcnt(0)" ::: "memory");
    __syncthreads();
    if (threadIdx.x == 0) { __builtin_amdgcn_fence(__ATOMIC_RELEASE, "agent"); asm volatile("s_waitcnt vmcnt(0)" ::: "memory"); xb_add(ctr, 1u); }
}
__device__ __forceinline__ void await_count(unsigned* ctr, unsigned n, unsigned* bar) {
    if (threadIdx.x == 0) { XB_SPIN(xb_ld(ctr) < n, bar); __builtin_amdgcn_fence(__ATOMIC_ACQUIRE, "agent"); asm volatile("s_waitcnt vmcnt(0)" ::: "memory"); }
    __syncthreads();
}

namespace pg8 {
constexpr int BM = 256, BK = 64, HALF = 128, HTB = HALF * BK * 2, STAGE_BYTES = 8 * HTB, NXCD = 8, WGM = 8;
__host__ __device__ __forceinline__ int lds_byte(int r, int c) { return r * 128 + (((c >> 3) ^ (r & 7)) * 16) + (c & 7) * 2; }
__host__ __device__ __forceinline__ void stage_rc(int b, int& R, int& C) { const int pc = b / 1024, sb = b % 1024, r8 = sb / 128, pos = (sb % 128) / 16; R = pc * 8 + r8; C = (pos ^ r8) * 8; }
__host__ __device__ __forceinline__ int perm32(int rho) { const int n = rho >> 4, i = rho & 15; return 8 * (i >> 2) + 4 * n + (i & 3); }

struct Unit { int pm, pn, kind, aux, nt; };

struct TileOrder {
    int nM, nN, nwg, G, c, loc, p0;
    __device__ void init(int nM_, int nN_, int G_, int c_) { nM = nM_; nN = nN_; nwg = nM * nN; G = G_; c = c_; loc = 0; p0 = 0; }
    __device__ void init_loc(int nN_, int p0_, int lrank) { nM = 4; nN = nN_; nwg = 4 * nN_; G = 32; c = lrank; loc = 1; p0 = p0_; }
    __device__ bool tile(int i, int& pm, int& pn) const {
        if (loc) { const int L = i * 32 + c; if (L >= nwg) return false; pm = p0 + (L & 3); pn = L >> 2; return true; }
        return tileL((long)i * G + c, pm, pn); }
    __device__ bool tileL(long L, int& pm, int& pn) const {
        if (L >= nwg) return false;
        int wgid = (int)L; { const int q = nwg / NXCD, r = nwg % NXCD, xcd = wgid % NXCD, off = wgid / NXCD; wgid = (xcd < r ? xcd * (q + 1) : r * (q + 1) + (xcd - r) * q) + off; }
        const int nig = WGM * nN, gid = wgid / nig, fm = gid * WGM, gsz = (nM - fm) < WGM ? (nM - fm) : WGM;
        pm = fm + ((wgid % nig) % gsz); pn = (wgid % nig) / gsz; return true;
    }
};

template <class Epi, class Sched>
__device__ __forceinline__ void gemm_phase(const char* wsb, LAS unsigned char* lds, const int lda, const int ldb, const Sched& S, const Epi& E) {
    int tid_ = threadIdx.x; asm volatile("" : "+v"(tid_));
    const int tid = tid_, wid = __builtin_amdgcn_readfirstlane(tid >> 6), lane = tid & 63, wr = wid >> 2, wc = wid & 3, fr = lane & 15, fq = lane >> 4;
    unsigned voffA, voffB;
    { int R, C; stage_rc(tid * 16, R, C); const int Rb = (R & ~31) + perm32(R & 31);
      voffA = (unsigned)(R * lda + C) * 2u; voffB = (unsigned)(Rb * ldb + C) * 2u; }
    const unsigned hpA = 64u * (unsigned)lda * 2u, hpB = 64u * (unsigned)ldb * 2u;
    const __amdgpu_buffer_rsrc_t rsW = __builtin_amdgcn_make_buffer_rsrc((void*)wsb, (short)0, 0x7fffffff, 0x00020000);
    const size_t kstep = (size_t)(BK * 2);
    const size_t hstepA = (size_t)HALF * lda * 2, hstepB = (size_t)HALF * ldb * 2;
    const unsigned ldsw = (unsigned)wid * 1024u;
    const int aoff = lds_byte(wr * 64 + fr, fq * 8), boff = lds_byte(wc * 32 + fr, fq * 8), aoff1 = aoff ^ 64, boff1 = boff ^ 64;
#define PG8_SA(b, h) (((b) * 2 + (h)) * HTB)
#define PG8_SB(b, h) ((4 + (b) * 2 + (h)) * HTB)
#define PG8_STAGE(bufoff, gbase, voff, hp) do { const unsigned so_ = (unsigned)((const char*)(gbase) - wsb); \
        __builtin_amdgcn_raw_ptr_buffer_load_lds(rsW, (LAS unsigned*)(lds + (bufoff) + ldsw), 16, (voff), so_, 0, 0); \
        __builtin_amdgcn_raw_ptr_buffer_load_lds(rsW, (LAS unsigned*)(lds + (bufoff) + ldsw + 8192), 16, (voff), so_ + (hp), 0, 0); } while (0)
#define PG8_LDA(dst, b, h) do { _Pragma("unroll") for (int m = 0; m < 4; ++m) _Pragma("unroll") for (int k = 0; k < 2; ++k) dst[m][k] = *(const LAS bf16x8*)(lds + PG8_SA(b, h) + (k ? aoff1 : aoff) + m * 2048); } while (0)
#define PG8_LDB(dst, b, h) do { _Pragma("unroll") for (int n = 0; n < 2; ++n) _Pragma("unroll") for (int k = 0; k < 2; ++k) dst[n][k] = *(const LAS bf16x8*)(lds + PG8_SB(b, h) + (k ? boff1 : boff) + n * 2048); } while (0)
#define PG8_MMA(ai, bj, At, Bt) do { __builtin_amdgcn_s_setprio(1); _Pragma("unroll") for (int m = 0; m < 4; ++m) _Pragma("unroll") for (int n = 0; n < 2; ++n) _Pragma("unroll") for (int k = 0; k < 2; ++k) \
        acc[ai][bj][m][n] = __builtin_amdgcn_mfma_f32_16x16x32_bf16(Bt[n][k], At[m][k], acc[ai][bj][m][n], 0, 0, 0); __builtin_amdgcn_s_setprio(0); } while (0)
#define PG8_WAIT_V(n) asm volatile("s_waitcnt vmcnt(" #n ")" ::: "memory")
#define PG8_WAIT_L(n) asm volatile("s_waitcnt lgkmcnt(" #n ")" ::: "memory")
#define PG8_BAR __builtin_amdgcn_s_barrier()
#define PG8_SCHED __builtin_amdgcn_sched_barrier(0)
    Unit cur, nxt; int ui = 0;
    if (!S.next(0, cur)) return;
    f32x4 acc[2][2][4][2];
#pragma unroll
    for (int a = 0; a < 2; ++a)
#pragma unroll
        for (int b = 0; b < 2; ++b)
#pragma unroll
            for (int m = 0; m < 4; ++m)
#pragma unroll
                for (int n = 0; n < 2; ++n) acc[a][b][m][n] = (f32x4){0.f, 0.f, 0.f, 0.f};
    bf16x8 At[4][2], B0[2][2], B1[2][2];
    const char* cA; const char* cB; S.ptrs(cur, cA, cB);
    typename Epi::Pre pre; E.prefetch(cur, wr, fr, pre);
    PG8_STAGE(PG8_SB(0, 0), cB, voffB, hpB); PG8_STAGE(PG8_SB(0, 1), cB + hstepB, voffB, hpB); PG8_STAGE(PG8_SA(0, 0), cA, voffA, hpA); PG8_STAGE(PG8_SA(0, 1), cA + hstepA, voffA, hpA);
    if (wr == 1) PG8_BAR;
    PG8_WAIT_V(2); PG8_BAR;
    PG8_STAGE(PG8_SB(1, 0), cB + kstep, voffB, hpB); PG8_STAGE(PG8_SA(1, 0), cA + kstep, voffA, hpA); PG8_STAGE(PG8_SB(1, 1), cB + hstepB + kstep, voffB, hpB);
    PG8_WAIT_V(6); PG8_BAR;
    for (;;) {
        const bool has_next = S.next(ui + 1, nxt);
        const char* nA = cA + (size_t)(cur.nt - 2) * kstep; const char* nB = cB + (size_t)(cur.nt - 2) * kstep;
        if (has_next) S.ptrs(nxt, nA, nB);
        const int nt = cur.nt;
        for (int t = 0; t < nt; t += 2) {
            const bool last = (t == nt - 2);
            const char* a1 = cA + (size_t)(t + 1) * kstep;
            const char* a2 = last ? nA : cA + (size_t)(t + 2) * kstep; const char* b2 = last ? nB : cB + (size_t)(t + 2) * kstep;
            const char* a3 = a2 + kstep; const char* b3 = b2 + kstep;
            PG8_LDB(B0, 0, 0); PG8_LDB(B1, 0, 1); PG8_SCHED; PG8_LDA(At, 0, 0); PG8_STAGE(PG8_SA(1, 1), a1 + hstepA, voffA, hpA);
            PG8_WAIT_V(8); PG8_WAIT_L(0); PG8_BAR; PG8_MMA(0, 0, At, B0); PG8_MMA(0, 1, At, B1); PG8_BAR; PG8_SCHED;
            PG8_LDA(At, 0, 1); PG8_STAGE(PG8_SB(0, 0), b2, voffB, hpB); PG8_STAGE(PG8_SB(0, 1), b2 + hstepB, voffB, hpB); PG8_STAGE(PG8_SA(0, 0), a2, voffA, hpA);
            PG8_WAIT_V(8); PG8_WAIT_L(0); PG8_BAR; PG8_MMA(1, 0, At, B0); PG8_MMA(1, 1, At, B1); PG8_BAR; PG8_SCHED;
            PG8_LDB(B0, 1, 0); PG8_LDB(B1, 1, 1); PG8_SCHED; PG8_LDA(At, 1, 0); PG8_STAGE(PG8_SA(0, 1), a2 + hstepA, voffA, hpA);
            PG8_WAIT_V(8); PG8_WAIT_L(0); PG8_BAR; PG8_MMA(0, 0, At, B0); PG8_MMA(0, 1, At, B1); PG8_BAR; PG8_SCHED;
            PG8_LDA(At, 1, 1); PG8_STAGE(PG8_SB(1, 0), b3, voffB, hpB); PG8_STAGE(PG8_SB(1, 1), b3 + hstepB, voffB, hpB); PG8_STAGE(PG8_SA(1, 0), a3, voffA, hpA);
            PG8_WAIT_V(8); PG8_WAIT_L(0); PG8_BAR; PG8_MMA(1, 0, At, B0); PG8_MMA(1, 1, At, B1); PG8_BAR; PG8_SCHED;
        }
        if (wr == 0) PG8_BAR;
        { int fr_e = fr, fq_e = fq; asm volatile("" : "+v"(fr_e), "+v"(fq_e));
          E(acc, cur, wr, wc, fr_e, fq_e, pre);
          }
        if (!has_next) break;
        if (!(Sched::PAIR && cur.kind == 0)) {
#pragma unroll
        for (int a = 0; a < 2; ++a)
#pragma unroll
            for (int b = 0; b < 2; ++b)
#pragma unroll
                for (int m = 0; m < 4; ++m)
#pragma unroll
                    for (int n = 0; n < 2; ++n) acc[a][b][m][n] = (f32x4){0.f, 0.f, 0.f, 0.f};
        }
        cur = nxt; cA = nA; cB = nB; ++ui;
        E.prefetch(cur, wr, fr, pre);
        if (wr == 1) PG8_BAR;
    }
    PG8_WAIT_V(0);
    PG8_BAR;
#undef PG8_SA
#undef PG8_SB
#undef PG8_STAGE
#undef PG8_LDA
#undef PG8_LDB
#undef PG8_MMA
#undef PG8_WAIT_V
#undef PG8_WAIT_L
#undef PG8_BAR
#undef PG8_SCHED
}
}
using pg8::Unit;

struct SchedStd { static constexpr bool PAIR = false;
    pg8::TileOrder o; const char* A; const char* B; size_t astep, bstep, bbatch; int nt;
    __device__ bool next(int i, Unit& u) const { u.kind = 0; u.aux = 0; u.nt = nt; return o.tile(i, u.pm, u.pn); }
    __device__ void ptrs(const Unit& u, const char*& a, const char*& b) const { a = A + (size_t)u.pm * astep; b = B + (size_t)u.pn * bstep + (size_t)(u.pm >> 4) * bbatch; }
};
struct SchedPair { static constexpr bool PAIR = true;
    int G, c; const char *A0, *A1, *B0, *B1; int loc, p0;
    __device__ bool next(int i, Unit& u) const {
        u.kind = i & 1; u.aux = 0; u.nt = 16;
        if (loc) { if (i >= 2) return false; u.pm = p0 + (c & 3); u.pn = c >> 2; return true; }
        const int p = (i >> 1) * G + c; if (p >= 256) return false; u.pm = p >> 3; u.pn = p & 7; return true; }
    __device__ void ptrs(const Unit& u, const char*& a, const char*& b) const { a = (u.kind ? A1 : A0) + (size_t)u.pm * (256 * 1024 * 2); b = (u.kind ? B1 : B0) + (size_t)u.pn * (256 * 1024 * 2); }
};
constexpr size_t TSTEP = (size_t)256 * D * 2;
struct SchedUpKv { static constexpr bool PAIR = false;
    pg8::TileOrder o; int G, c; const char *XBp, *W13p, *MEMNp, *WKVp; int loc, p0, xq;
    __device__ bool next(int i, Unit& u) const { const long L = loc ? (long)i * 32 + c : (long)i * G + c; u.aux = 0; u.nt = 32;
        if (loc) {
            if (L < 176) { u.kind = 0; u.pm = p0 + ((int)L & 3); u.pn = (int)L >> 2; return true; }
            if (L < 180) { const int r = xq * 4 + ((int)L - 176); u.kind = 1; u.pm = r & 1; u.pn = r >> 1; return true; }
            return false; }
        if (L < 1408) { u.kind = 0; return o.tileL(L, u.pm, u.pn); }
        if (L < 1440) { const int r = (int)L - 1408; u.kind = 1; u.pm = r & 1; u.pn = r >> 1; return true; }
        return false; }
    __device__ void ptrs(const Unit& u, const char*& a, const char*& b) const { a = (u.kind ? MEMNp : XBp) + (size_t)u.pm * TSTEP; b = (u.kind ? WKVp : W13p) + (size_t)u.pn * TSTEP; }
};
struct SchedInW { static constexpr bool PAIR = false;
    pg8::TileOrder o; int G, c; const char *XBp, *WINp, *Kp, *Vp, *WQp, *WOp; int loc, p0, xq;
    __device__ bool wunit(int r, Unit& u) const { const int rr = r & 63; u.kind = 1 + (r >> 6); u.aux = ((rr >> 5) << 2) | ((rr >> 3) & 3); u.pm = rr & 7; u.pn = 0; u.nt = 8; return true; }
    __device__ bool next(int i, Unit& u) const {
        u.aux = 0; u.nt = 32; u.kind = 0;
        if (loc) {
            const int L = i * 32 + c;
            if (L < 116) { u.pm = p0 + (L & 3); u.pn = L >> 2; return true; }
            if (i == 3) return wunit(xq * 16 + (c - 20), u);
            if (i == 4 && c >= 20 && c < 24) return wunit(xq * 16 + 12 + (c - 20), u);
            return false; }
        if (G == 256) {
            if (i < 3) return o.tileL((long)i * 256 + c, u.pm, u.pn);
            if (i == 3) { if (768 + c < 928) return o.tileL(768 + c, u.pm, u.pn); return wunit(c - 160, u); }
            if (i == 4 && c >= 160 && c < 192) return wunit(96 + c - 160, u);
            return false;
        }
        const long L = (long)i * G + c;
        if (L < 928) return o.tileL(L, u.pm, u.pn);
        if (L < 1056) return wunit((int)L - 928, u);
        return false; }
    __device__ void ptrs(const Unit& u, const char*& a, const char*& b) const {
        const int bb = u.aux >> 2, hh = u.aux & 3;
        if (u.kind == 0) { a = XBp + (size_t)u.pm * TSTEP; b = WINp + (size_t)u.pn * TSTEP; }
        else if (u.kind == 1) { a = Kp + (size_t)bb * TSTEP + hh * 1024; b = WQp + (size_t)u.pm * TSTEP + hh * 1024; }
        else { a = WOp + (size_t)u.pm * TSTEP + hh * 1024; b = Vp + (size_t)bb * TSTEP + hh * 1024; } }
};

#define EPI_ROWS(ai, m) (u.pm * 256 + (ai) * 128 + wr * 64 + (m) * 16 + fr)
#define EPI_COL8(bj) ((bj) * 128 + wc * 32 + 8 * fq)
struct NoPre {};
struct RowPre { u64 s[8]; };
__device__ __forceinline__ void rowpre_load(const u64* ss, const int pm, int wr, int fr, RowPre& p) {
#pragma unroll
    for (int k = 0; k < 8; ++k) p.s[k] = ((const GAS u64*)ss)[pm * 256 + (k >> 2) * 128 + wr * 64 + (k & 3) * 16 + fr]; }
__device__ __forceinline__ float rinv_of(const u64* ss, int row) { return rsqrtf((float)((const GAS u64*)ss)[row] * SS_INV + EPS); }

struct EpiUp {
    struct Pre { u64 s[8]; };
    __device__ __forceinline__ void prefetch(const Unit& u, int wr, int fr, Pre& p) const {
#pragma unroll
        for (int k = 0; k < 8; ++k) p.s[k] = ((const GAS u64*)ss)[u.pm * 256 + (k >> 2) * 128 + wr * 64 + (k & 3) * 16 + fr]; }
    bf16* act; const u64* ss;
    __device__ __forceinline__ void operator()(const f32x4 (&acc)[2][2][4][2], const Unit& u, int wr, int wc, int fr, int fq, const Pre& pre) const {
#ifdef EPI_TWICE
      for (int rep2 = 0; rep2 < 2; ++rep2) { asm volatile("" : "+v"(fr), "+v"(fq));
#endif
#pragma unroll
        for (int ai = 0; ai < 2; ++ai)
#pragma unroll
            for (int m = 0; m < 4; ++m) {
                const int row = EPI_ROWS(ai, m); const float r = rsqrtf((float)pre.s[ai * 4 + m] * SS_INV + EPS);
                float o[8];
#pragma unroll
                for (int n = 0; n < 2; ++n)
#pragma unroll
                    for (int i = 0; i < 4; ++i) { const float a = acc[ai][0][m][n][i] * r, b = acc[ai][1][m][n][i] * r; o[n * 4 + i] = siluf_(a) * b; }
                u32x4 w; w.x = pk2(o[0], o[1]); w.y = pk2(o[2], o[3]); w.z = pk2(o[4], o[5]); w.w = pk2(o[6], o[7]);
                *(GAS u32x4*)(act + (size_t)row * FF + u.pn * 128 + wc * 32 + 8 * fq) = w;
            }
#ifdef EPI_TWICE
      }
#endif
    }
};
template <bool IN_F32>
struct EpiRes {
    typedef NoPre Pre; __device__ __forceinline__ void prefetch(const Unit&, int, int, Pre&) const {}
    const float* xin32; bf16* xb; u64* ssn; float scale;
    __device__ __forceinline__ void operator()(const f32x4 (&acc)[2][2][4][2], const Unit& u, int wr, int wc, int fr, int fq, const Pre& pre) const {
#pragma unroll
        for (int ai = 0; ai < 2; ++ai)
#pragma unroll
            for (int m = 0; m < 4; ++m) {
                const int row = EPI_ROWS(ai, m); float q = 0.f;
#pragma unroll
                for (int bj = 0; bj < 2; ++bj) {
                    const size_t off = (size_t)row * D + u.pn * 256 + EPI_COL8(bj);
                    f32x4 x0, x1;
                    if (IN_F32) { x0 = *(const GAS f32x4*)(xin32 + off); x1 = *(const GAS f32x4*)(xin32 + off + 4); }
                    else { const u32x4 xw = *(const GAS u32x4*)(xb + off); x0[0] = lo_bf(xw.x); x0[1] = hi_bf(xw.x); x0[2] = lo_bf(xw.y); x0[3] = hi_bf(xw.y); x1[0] = lo_bf(xw.z); x1[1] = hi_bf(xw.z); x1[2] = lo_bf(xw.w); x1[3] = hi_bf(xw.w); }
                    const f32x4 o0 = x0 + acc[ai][bj][m][0] * scale, o1 = x1 + acc[ai][bj][m][1] * scale;
                    u32x4 w; w.x = pk2(o0[0], o0[1]); w.y = pk2(o0[2], o0[3]); w.z = pk2(o1[0], o1[1]); w.w = pk2(o1[2], o1[3]); *(GAS u32x4*)(xb + off) = w;
                    q += (o0[0] * o0[0] + o0[1] * o0[1]) + (o0[2] * o0[2] + o0[3] * o0[3]) + (o1[0] * o1[0] + o1[1] * o1[1]) + (o1[2] * o1[2] + o1[3] * o1[3]);
                }
                q += __shfl_xor(q, 16); q += __shfl_xor(q, 32);
                if (fq == 0) atomicAdd((u64*)(ssn + row), (u64)(q * SS_SCALE));
            }
    }
};
struct EpiResFinal {
    typedef NoPre Pre; __device__ __forceinline__ void prefetch(const Unit&, int, int, Pre&) const {}
    const bf16* xin; float* out; const float* gfin; u64* ssn; unsigned* cnt; float scale;
    __device__ __forceinline__ void operator()(f32x4 (&acc)[2][2][4][2], const Unit& u, int wr, int wc, int fr, int fq, const Pre& pre) const {
#pragma unroll
        for (int ai = 0; ai < 2; ++ai)
#pragma unroll
            for (int m = 0; m < 4; ++m) {
                const int row = EPI_ROWS(ai, m); float q = 0.f;
#pragma unroll
                for (int bj = 0; bj < 2; ++bj) {
                    const size_t off = (size_t)row * D + u.pn * 256 + EPI_COL8(bj);
                    const u32x4 xw = *(const GAS u32x4*)(xin + off);
                    f32x4 x0, x1; x0[0] = lo_bf(xw.x); x0[1] = hi_bf(xw.x); x0[2] = lo_bf(xw.y); x0[3] = hi_bf(xw.y); x1[0] = lo_bf(xw.z); x1[1] = hi_bf(xw.z); x1[2] = lo_bf(xw.w); x1[3] = hi_bf(xw.w);
                    const f32x4 o0 = x0 + acc[ai][bj][m][0] * scale, o1 = x1 + acc[ai][bj][m][1] * scale;
                    acc[ai][bj][m][0] = o0; acc[ai][bj][m][1] = o1;
                    q += (o0[0] * o0[0] + o0[1] * o0[1]) + (o0[2] * o0[2] + o0[3] * o0[3]) + (o1[0] * o1[0] + o1[1] * o1[1]) + (o1[2] * o1[2] + o1[3] * o1[3]);
                }
                q += __shfl_xor(q, 16); q += __shfl_xor(q, 32);
                if (fq == 0) atomicAdd((u64*)(ssn + row), (u64)(q * SS_SCALE));
            }
        asm volatile("s_waitcnt vmcnt(0)" ::: "memory");
        unsigned* c = cnt + 64 * u.pm;
        if (fr == 0 && fq == 0) __hip_atomic_fetch_add(c, 1u, __ATOMIC_RELAXED, __HIP_MEMORY_SCOPE_AGENT);
        if (wr == 0 && wc == 0) {
            unsigned spins = 0;
            while ((unsigned)__builtin_amdgcn_readfirstlane(__hip_atomic_load(c, __ATOMIC_RELAXED, __HIP_MEMORY_SCOPE_AGENT)) < 64u) { __builtin_amdgcn_s_sleep(2); if (++spins > (1u << 22)) break; }
            __builtin_amdgcn_fence(__ATOMIC_ACQUIRE, "agent");
            asm volatile("s_waitcnt vmcnt(0)" ::: "memory");
        }
        asm volatile("" ::: "memory"); __builtin_amdgcn_s_barrier(); asm volatile("" ::: "memory");
#pragma unroll
        for (int ai = 0; ai < 2; ++ai)
#pragma unroll
            for (int m = 0; m < 4; ++m) {
                const int row = EPI_ROWS(ai, m);
                const float r = rsqrtf((float)__hip_atomic_load(ssn + row, __ATOMIC_RELAXED, __HIP_MEMORY_SCOPE_AGENT) * SS_INV + EPS);
#pragma unroll
                for (int bj = 0; bj < 2; ++bj) {
                    const size_t off = (size_t)row * D + u.pn * 256 + EPI_COL8(bj); const int col = u.pn * 256 + EPI_COL8(bj);
                    const f32x4 o0 = acc[ai][bj][m][0], o1 = acc[ai][bj][m][1];
                    *(GAS f32x4*)(out + off) = o0 * r * *(const GAS f32x4*)(gfin + col); *(GAS f32x4*)(out + off + 4) = o1 * r * *(const GAS f32x4*)(gfin + col + 4);
                }
            }
    }
};
struct EpiInproj {
    typedef RowPre Pre; __device__ __forceinline__ void prefetch(const Unit& u, int wr, int fr, Pre& p) const { rowpre_load(ss, u.pm, wr, fr, p); }
    unsigned char* ws; const u64* ss; const float* igb; const float* fgb;
    __device__ __forceinline__ void operator()(const f32x4 (&acc)[2][2][4][2], const Unit& u, int wr, int wc, int fr, int fq, const Pre& pre) const {
        if (u.pn == 28) {
            if (wc == 0 && fq == 0) {
                float* gates = (float*)(ws + WS_SMALL + SM_GATES);
#pragma unroll
                for (int ai = 0; ai < 2; ++ai)
#pragma unroll
                    for (int m = 0; m < 4; ++m) {
                        const int row = EPI_ROWS(ai, m); const float r = rsqrtf((float)pre.s[ai * 4 + m] * SS_INV + EPS);
                        f32x4 gi, gf;
#pragma unroll
                        for (int i = 0; i < 4; ++i) {
                            gi[i] = acc[ai][0][m][0][i] * r + igb[i];
                            const float xf = acc[ai][0][m][1][i] * r + fgb[i];
                            gf[i] = fminf(xf, 0.f) - __logf(1.0f + __expf(-fabsf(xf)));
                        }
                        *(GAS f32x4*)(gates + (size_t)row * 8) = gi; *(GAS f32x4*)(gates + (size_t)row * 8 + 4) = gf;
                    }
            }
            return;
        }
        const int ty = u.pn >> 2;
        bf16* base = (bf16*)(ws + (ty == 0 ? AR_QKRAW : ty == 1 ? AR_MV : ty == 2 ? AR_MO : ty == 3 ? AR_HQ : ty == 4 ? AR_HF : ty == 5 ? AR_HI : AR_HG));
#pragma unroll
        for (int ai = 0; ai < 2; ++ai)
#pragma unroll
            for (int m = 0; m < 4; ++m) {
                const int row = EPI_ROWS(ai, m); const float r = rsqrtf((float)pre.s[ai * 4 + m] * SS_INV + EPS);
#pragma unroll
                for (int bj = 0; bj < 2; ++bj) {
                    float o[8];
#pragma unroll
                    for (int n = 0; n < 2; ++n)
#pragma unroll
                        for (int i = 0; i < 4; ++i) {
                            float v = acc[ai][bj][m][n][i] * r;
                            if (ty == 2) v = sigmoidf_(v); else if (ty == 3) v = siluf_(v) * 0.08838834764831845f; else if (ty == 6) v = siluf_(v);
                            o[n * 4 + i] = v;
                        }
                    u32x4 w; w.x = pk2(o[0], o[1]); w.y = pk2(o[2], o[3]); w.z = pk2(o[4], o[5]); w.w = pk2(o[6], o[7]);
                    *(GAS u32x4*)(base + (size_t)row * 1024 + (u.pn & 3) * 256 + EPI_COL8(bj)) = w;
                }
            }
    }
};
struct EpiGates {
    typedef RowPre Pre; __device__ __forceinline__ void prefetch(const Unit& u, int wr, int fr, Pre& p) const { rowpre_load(ss, u.pm, wr, fr, p); }
    bf16* gm; bf16* gh; const u64* ss;
    __device__ __forceinline__ void operator()(const f32x4 (&acc)[2][2][4][2], const Unit& u, int wr, int wc, int fr, int fq, const Pre& pre) const {
        bf16* base = (u.pn < 8) ? gm : gh;
#pragma unroll
        for (int ai = 0; ai < 2; ++ai)
#pragma unroll
            for (int m = 0; m < 4; ++m) {
                const int row = EPI_ROWS(ai, m); const float r = rsqrtf((float)pre.s[ai * 4 + m] * SS_INV + EPS);
#pragma unroll
                for (int bj = 0; bj < 2; ++bj) {
                    float o[8];
#pragma unroll
                    for (int n = 0; n < 2; ++n)
#pragma unroll
                        for (int i = 0; i < 4; ++i) o[n * 4 + i] = sigmoidf_(acc[ai][bj][m][n][i] * r);
                    u32x4 w; w.x = pk2(o[0], o[1]); w.y = pk2(o[2], o[3]); w.z = pk2(o[4], o[5]); w.w = pk2(o[6], o[7]);
                    *(GAS u32x4*)(base + (size_t)row * D + (u.pn & 7) * 256 + EPI_COL8(bj)) = w;
                }
            }
    }
};
struct EpiProj {
    typedef NoPre Pre; __device__ __forceinline__ void prefetch(const Unit&, int, int, Pre&) const {}
    const bf16* gm; const bf16* gh; bf16* merged;
    __device__ __forceinline__ void operator()(f32x4 (&acc)[2][2][4][2], const Unit& u, int wr, int wc, int fr, int fq, const Pre& pre) const {
#pragma unroll
        for (int ai = 0; ai < 2; ++ai)
#pragma unroll
            for (int m = 0; m < 4; ++m) {
                const int row = EPI_ROWS(ai, m);
#pragma unroll
                for (int bj = 0; bj < 2; ++bj) {
                    const size_t off = (size_t)row * D + u.pn * 256 + EPI_COL8(bj);
                    const u32x4 hw = *(const GAS u32x4*)(gh + off);
                    float h8[8] = {lo_bf(hw.x), hi_bf(hw.x), lo_bf(hw.y), hi_bf(hw.y), lo_bf(hw.z), hi_bf(hw.z), lo_bf(hw.w), hi_bf(hw.w)};
                    if (u.kind == 0) {
                        const u32x4 gw = *(const GAS u32x4*)(gm + off);
                        const float g8[8] = {lo_bf(gw.x), hi_bf(gw.x), lo_bf(gw.y), hi_bf(gw.y), lo_bf(gw.z), hi_bf(gw.z), lo_bf(gw.w), hi_bf(gw.w)};
#pragma unroll
                        for (int i = 0; i < 4; ++i) { acc[ai][bj][m][0][i] *= g8[i] * __builtin_amdgcn_rcpf(fmaxf(h8[i], 1e-30f)); acc[ai][bj][m][1][i] *= g8[4 + i] * __builtin_amdgcn_rcpf(fmaxf(h8[4 + i], 1e-30f)); }
                    } else {
                        const f32x4 a = acc[ai][bj][m][0], b = acc[ai][bj][m][1];
                        u32x4 w; w.x = pk2(a[0] * h8[0], a[1] * h8[1]); w.y = pk2(a[2] * h8[2], a[3] * h8[3]); w.z = pk2(b[0] * h8[4], b[1] * h8[5]); w.w = pk2(b[2] * h8[6], b[3] * h8[7]); *(GAS u32x4*)(merged + off) = w;
                    }
                }
            }
    }
};
struct EpiScores {
    typedef RowPre Pre; __device__ __forceinline__ void prefetch(const Unit& u, int wr, int fr, Pre& p) const { rowpre_load(ss, u.pm, wr, fr, p); }
    bf16* p; const u64* ss; LAS float* xch;
    __device__ __forceinline__ void operator()(const f32x4 (&acc)[2][2][4][2], const Unit& u, int wr, int wc, int fr, int fq, const Pre& pre) const {
        float v[2][4][16];
#pragma unroll
        for (int ai = 0; ai < 2; ++ai)
#pragma unroll
            for (int m = 0; m < 4; ++m) {
                const int row = EPI_ROWS(ai, m), rl = ai * 128 + wr * 64 + m * 16 + fr; const float r = rsqrtf((float)pre.s[ai * 4 + m] * SS_INV + EPS) * 0.04419417382415922f;
                float mx = -INFINITY;
#pragma unroll
                for (int bj = 0; bj < 2; ++bj)
#pragma unroll
                    for (int n = 0; n < 2; ++n)
#pragma unroll
                        for (int i = 0; i < 4; ++i) { const float x = acc[ai][bj][m][n][i] * r; v[ai][m][bj * 8 + n * 4 + i] = x; mx = fmaxf(mx, x); }
                mx = fmaxf(mx, __shfl_xor(mx, 16)); mx = fmaxf(mx, __shfl_xor(mx, 32));
                if (fq == 0) xch[rl * 4 + wc] = mx;
            }
        asm volatile("s_waitcnt lgkmcnt(0)" ::: "memory"); __builtin_amdgcn_s_barrier(); asm volatile("" ::: "memory");
#pragma unroll
        for (int ai = 0; ai < 2; ++ai)
#pragma unroll
            for (int m = 0; m < 4; ++m) {
                const int rl = ai * 128 + wr * 64 + m * 16 + fr; const f32x4 pm = *(const LAS f32x4*)(xch + rl * 4);
                const float mx = fmaxf(fmaxf(pm[0], pm[1]), fmaxf(pm[2], pm[3])); float sm = 0.f;
#pragma unroll
                for (int k = 0; k < 16; ++k) { const float e = __expf(v[ai][m][k] - mx); v[ai][m][k] = e; sm += e; }
                sm += __shfl_xor(sm, 16); sm += __shfl_xor(sm, 32);
                if (fq == 0) xch[1024 + rl * 4 + wc] = sm;
            }
        asm volatile("s_waitcnt lgkmcnt(0)" ::: "memory"); __builtin_amdgcn_s_barrier(); asm volatile("" ::: "memory");
#pragma unroll
        for (int ai = 0; ai < 2; ++ai)
#pragma unroll
            for (int m = 0; m < 4; ++m) {
                const int row = EPI_ROWS(ai, m), rl = ai * 128 + wr * 64 + m * 16 + fr; const f32x4 ps = *(const LAS f32x4*)(xch + 1024 + rl * 4);
                const float inv = __builtin_amdgcn_rcpf((ps[0] + ps[1]) + (ps[2] + ps[3]));
#pragma unroll
                for (int bj = 0; bj < 2; ++bj) {
                    const float* e = &v[ai][m][bj * 8];
                    u32x4 w; w.x = pk2(e[0] * inv, e[1] * inv); w.y = pk2(e[2] * inv, e[3] * inv); w.z = pk2(e[4] * inv, e[5] * inv); w.w = pk2(e[6] * inv, e[7] * inv);
                    *(GAS u32x4*)(p + (size_t)row * 1024 + u.pn * 256 + EPI_COL8(bj)) = w;
                }
            }
    }
};
__device__ __forceinline__ void store_tile_bf16(const f32x4 (&acc)[2][2][4][2], bf16* base, int ldc, int wr, int wc, int fr, int fq) {
#pragma unroll
    for (int ai = 0; ai < 2; ++ai)
#pragma unroll
        for (int m = 0; m < 4; ++m) {
            const int rl = ai * 128 + wr * 64 + m * 16 + fr;
#pragma unroll
            for (int bj = 0; bj < 2; ++bj) {
                const f32x4 a = acc[ai][bj][m][0], b = acc[ai][bj][m][1];
                u32x4 w; w.x = pk2(a[0], a[1]); w.y = pk2(a[2], a[3]); w.z = pk2(b[0], b[1]); w.w = pk2(b[2], b[3]);
                *(GAS u32x4*)(base + (size_t)rl * ldc + EPI_COL8(bj)) = w;
            }
        }
}
struct EpiUpKv {
    typedef EpiUp::Pre Pre; __device__ __forceinline__ void prefetch(const Unit& u, int wr, int fr, Pre& p) const { if (u.kind == 0) up.prefetch(u, wr, fr, p); }
    EpiUp up; bf16* kv;
    __device__ __forceinline__ void operator()(const f32x4 (&acc)[2][2][4][2], const Unit& u, int wr, int wc, int fr, int fq, const Pre& pre) const {
        if (u.kind == 0) up(acc, u, wr, wc, fr, fq, pre);
        else store_tile_bf16(acc, kv + (size_t)(u.pn >> 3) * (512 * D) + (size_t)u.pm * (256 * D) + (u.pn & 7) * 256, D, wr, wc, fr, fq);
    }
};
struct EpiInW {
    typedef RowPre Pre; __device__ __forceinline__ void prefetch(const Unit& u, int wr, int fr, Pre& p) const { if (u.kind == 0) inp.prefetch(u, wr, fr, p); }
    EpiInproj inp; bf16* wqkt; bf16* vwot;
    __device__ __forceinline__ void operator()(const f32x4 (&acc)[2][2][4][2], const Unit& u, int wr, int wc, int fr, int fq, const Pre& pre) const {
        const int bb = u.aux >> 2, hh = u.aux & 3;
        if (u.kind == 0) inp(acc, u, wr, wc, fr, fq, pre);
        else if (u.kind == 1) store_tile_bf16(acc, wqkt + (size_t)bb * (1024 * D) + (size_t)hh * (256 * D) + u.pm * 256, D, wr, wc, fr, fq);
        else store_tile_bf16(acc, vwot + (size_t)bb * (2048 * 1024) + (size_t)u.pm * (256 * 1024) + hh * 256, 1024, wr, wc, fr, fq);
    }
};

struct Args { const float* in[28]; float* out; unsigned char* ws; };
enum { I_X = 0, I_MEM, I_NFFN1, I_F1W1, I_F1W3, I_F1W2, I_NMIX, I_WIN, I_CONVW, I_CONVB, I_IGB, I_FGB, I_MHN, I_LBL, I_HHN, I_WPM, I_WPH, I_WOUT, I_NX, I_NMEM, I_WQ, I_WKV, I_WO,
       I_NFFN2, I_F2W1, I_F2W3, I_F2W2, I_NFIN };

struct CvtDesc { const float* src; const float* gain; bf16* dst; int ld_src, ld_dst, col0, nvalid, k0; };
__device__ __forceinline__ void cvt_load(const CvtDesc& d, int lane, f32x4 (&v)[8]) {
    const int kc = lane & 7, ng = lane >> 3; const bool ok = (4 * ng) < d.nvalid;
#pragma unroll
    for (int j = 0; j < 8; ++j) v[j] = ok ? __builtin_nontemporal_load((const GAS f32x4*)(d.src + (size_t)(d.k0 + 8 * kc + j) * d.ld_src + d.col0 + 4 * ng)) : (f32x4){0.f, 0.f, 0.f, 0.f};
}
__device__ __forceinline__ void cvt_store(const CvtDesc& d, int lane, f32x4 (&v)[8]) {
    const int kc = lane & 7, ng = lane >> 3;
    if (d.gain) {
        const f32x4 g0 = *(const f32x4*)(d.gain + d.k0 + 8 * kc), g1 = *(const f32x4*)(d.gain + d.k0 + 8 * kc + 4);
        v[0] *= g0[0]; v[1] *= g0[1]; v[2] *= g0[2]; v[3] *= g0[3]; v[4] *= g1[0]; v[5] *= g1[1]; v[6] *= g1[2]; v[7] *= g1[3];
    }
#pragma unroll
    for (int i = 0; i < 4; ++i) {
        u32x4 w; w.x = pk2(v[0][i], v[1][i]); w.y = pk2(v[2][i], v[3][i]); w.z = pk2(v[4][i], v[5][i]); w.w = pk2(v[6][i], v[7][i]);
        *(u32x4*)(d.dst + (size_t)(4 * ng + i) * d.ld_dst + d.k0 + 8 * kc) = w;
    }
}
__device__ __forceinline__ CvtDesc mk_desc(const float* src, int ld_src, int col0, int nvalid, int k0, const float* gain, bf16* dst, int ld_dst) {
    CvtDesc d; d.src = src; d.gain = gain; d.dst = dst; d.ld_src = ld_src; d.ld_dst = ld_dst; d.col0 = col0; d.nvalid = nvalid; d.k0 = k0; return d; }
__device__ __forceinline__ CvtDesc ffn_desc(int it, const float* w1, const float* w3, const float* w2, const float* gain, bf16* w13, bf16* w2t) {
    if (it < 11264) { const int nb = it % 352, kb = it / 352; const int pn = nb >> 3, bj = (nb >> 2) & 1, cb = nb & 3;
        return mk_desc(bj ? w3 : w1, FF, pn * 128 + cb * 32, 32, kb * 64, gain, w13 + (size_t)nb * 32 * D, D); }
    it -= 11264;
    const int nb = it % 64, kb = it / 64; return mk_desc(w2, D, nb * 32, 32, kb * 64, nullptr, w2t + (size_t)nb * 32 * FF, FF);
}
constexpr int N_FFN_ITEMS = 11264 + 5632;
#ifndef PHASES
#define PHASES 0xFFFFFu
#endif
#define PH(k) ((PHASES >> (k)) & 1u)
#ifndef REPS
#define REPS 0x0u
#endif
#define NREP(k) ((int)PH(k) + (int)((REPS >> (k)) & 1u))

__device__ __forceinline__ bf16x8 ldfrag(const LAS unsigned char* base, int row, int stride, int kbyte) { return *(const LAS bf16x8*)(base + row * stride + kbyte); }
#define MFMA16(a, b, c) __builtin_amdgcn_mfma_f32_16x16x32_bf16((a), (b), (c), 0, 0, 0)
__device__ __forceinline__ float wave_scan_incl(float v, int lane) {
    (void)lane;
#define WS_DPP(ctrl, rmask) v += __builtin_bit_cast(float, __builtin_amdgcn_update_dpp(0, __builtin_bit_cast(int, v), (ctrl), (rmask), 0xf, false))
    WS_DPP(0x111, 0xf); WS_DPP(0x112, 0xf); WS_DPP(0x114, 0xf); WS_DPP(0x118, 0xf);
    WS_DPP(0x142, 0xa);
    WS_DPP(0x143, 0xc);
#undef WS_DPP
    return v;
}
__device__ __forceinline__ void unpack8(const u32x4 w, float (&f)[8]) { f[0] = lo_bf(w.x); f[1] = hi_bf(w.x); f[2] = lo_bf(w.y); f[3] = hi_bf(w.y); f[4] = lo_bf(w.z); f[5] = hi_bf(w.z); f[6] = lo_bf(w.w); f[7] = hi_bf(w.w); }
__device__ __forceinline__ void put_t8(LAS unsigned char* Tt, int col0, int s, const u32x4 vw) {
    LAS bf16* p = (LAS bf16*)(Tt + col0 * 144 + s * 2);
    p[0 * 72] = (bf16)(vw.x & 0xffffu); p[1 * 72] = (bf16)(vw.x >> 16); p[2 * 72] = (bf16)(vw.y & 0xffffu); p[3 * 72] = (bf16)(vw.y >> 16);
    p[4 * 72] = (bf16)(vw.z & 0xffffu); p[5 * 72] = (bf16)(vw.z >> 16); p[6 * 72] = (bf16)(vw.w & 0xffffu); p[7 * 72] = (bf16)(vw.w >> 16);
}

struct MaRegs { u32x4 vr[4], qk[5]; float fl, ip; };
struct HaRegs { u32x4 hr[2], fr[2]; };
__device__ __forceinline__ void ma_load(int item, int tid, const GAS float* gates, const GAS bf16* QKRAW, const GAS bf16* MV, MaRegs& r) {
    const int b = item >> 8, h = (item >> 6) & 3, c = item & 63, R0 = b * T + c * 64;
#pragma unroll
    for (int i = 0; i < 4; ++i) { const int idx = tid + NTHR * i, row = idx >> 5, ch = idx & 31; r.vr[i] = *(const GAS u32x4*)(MV + (size_t)(R0 + row) * 1024 + h * 256 + ch * 8); }
#pragma unroll
    for (int j = 0; j < 5; ++j) { const int idx = tid + NTHR * j, row = idx >> 5, ch = idx & 31, tt = c * 64 - 3 + row;
        r.qk[j] = (idx < 67 * 32 && tt >= 0) ? *(const GAS u32x4*)(QKRAW + (size_t)(b * T + tt) * 1024 + (ch >> 4) * 512 + h * 128 + (ch & 15) * 8) : (u32x4){0u, 0u, 0u, 0u}; }
    r.fl = 0.f; r.ip = 0.f;
    if (tid < 64) { r.fl = gates[(size_t)(R0 + tid) * 8 + 4 + h]; r.ip = gates[(size_t)(R0 + tid) * 8 + h]; }
}
__device__ __forceinline__ void ha_load(int it, int tid, const GAS bf16* HF, const GAS bf16* HI, HaRegs& r) {
    const int b = it >> 9, h = (it >> 6) & 7, c = it & 63, R0 = b * T + c * 64;
#pragma unroll
    for (int i = 0; i < 2; ++i) { const int idx = tid + NTHR * i, row = idx >> 4, ch = idx & 15;
        r.hr[i] = *(const GAS u32x4*)(HI + (size_t)(R0 + row) * 1024 + h * 128 + ch * 8); r.fr[i] = *(const GAS u32x4*)(HF + (size_t)(R0 + row) * 1024 + h * 128 + ch * 8); }
}
__device__ __forceinline__ void mlstm_stage_convw(LAS unsigned char* lds, int h, int tid, const GAS float* convw, const GAS float* convb) {
    LAS float* CW = (LAS float*)(lds + 2048 + 18432 + 36864 + 35376 + 33792);
    if (tid < 320) { const int j = tid >> 6, c4 = tid & 63, col = (c4 >> 5) * 512 + h * 128 + (c4 & 31) * 4;
        *(LAS f32x4*)(CW + j * 256 + c4 * 4) = *(const GAS f32x4*)((j < 4 ? convw + j * 1024 : convb) + col); }
}
__device__ __forceinline__ void mlstm_state_item(LAS unsigned char* lds, int item, int tid, MaRegs& rg, int nxt, const GAS float* gates, const GAS float* convw, const GAS float* convb, const GAS bf16* QKRAW, GAS bf16* QC, GAS bf16* KC,
                                                 const GAS bf16* MV, GAS bf16* MST, GAS float* DN, GAS float* BLAST, GAS float* MLOC) {
    const int lane = tid & 63, w = __builtin_amdgcn_readfirstlane(tid >> 6), l15 = lane & 15, lg = lane >> 4;
    const int b = item >> 8, h = (item >> 6) & 3, c = item & 63, R0 = b * T + c * 64;
    LAS float* sc = (LAS float*)lds;
    LAS unsigned char* KWt = lds + 2048;
    LAS unsigned char* Vt = KWt + 18432;
    LAS unsigned char* RAW = Vt + 36864;
    LAS unsigned char* VR = RAW + 35376;
    const LAS float* CW = (const LAS float*)(VR + 33792);
    const int s = lane;
    if (w == 0) {
        const float bs = wave_scan_incl(rg.fl, lane); const float blast = __shfl(bs, 63);
        const float a = blast - bs + rg.ip; const float ml = wave_max(a);
        sc[128 + lane] = __expf(a - ml);
        if (lane == 0) { BLAST[item] = blast; MLOC[item] = ml; }
    }
#pragma unroll
    for (int i = 0; i < 4; ++i) { const int idx = tid + NTHR * i; *(LAS u32x4*)(VR + (idx >> 5) * 528 + (idx & 31) * 16) = rg.vr[i]; }
#pragma unroll
    for (int j = 0; j < 5; ++j) { const int idx = tid + NTHR * j; if (idx < 67 * 32) *(LAS u32x4*)(RAW + (idx >> 5) * 528 + (idx & 31) * 16) = rg.qk[j]; }
    if (nxt < 512) ma_load(nxt, tid, gates, QKRAW, MV, rg);
    __syncthreads();
#pragma unroll
    for (int i = 0; i < 4; ++i) put_t8(Vt, (w + 8 * i) * 8, s, *(const LAS u32x4*)(VR + s * 528 + (w + 8 * i) * 16));
    const float ws_ = sc[128 + s];
#pragma unroll
    for (int i = 0; i < 4; ++i) {
        const int g = w + 8 * i, isk = g >> 4, d0 = (g & 15) * 8, cc0 = isk * 512 + h * 128 + d0;
        float y[8];
        { const f32x4 b0 = *(const LAS f32x4*)(CW + 1024 + g * 8), b1 = *(const LAS f32x4*)(CW + 1024 + g * 8 + 4); y[0] = b0[0]; y[1] = b0[1]; y[2] = b0[2]; y[3] = b0[3]; y[4] = b1[0]; y[5] = b1[1]; y[6] = b1[2]; y[7] = b1[3]; }
#pragma unroll
        for (int j = 0; j < 4; ++j) { const f32x4 w0 = *(const LAS f32x4*)(CW + j * 256 + g * 8), w1 = *(const LAS f32x4*)(CW + j * 256 + g * 8 + 4); float x[8]; unpack8(*(const LAS u32x4*)(RAW + (s + j) * 528 + g * 16), x);
            y[0] += w0[0] * x[0]; y[1] += w0[1] * x[1]; y[2] += w0[2] * x[2]; y[3] += w0[3] * x[3]; y[4] += w1[0] * x[4]; y[5] += w1[1] * x[5]; y[6] += w1[2] * x[6]; y[7] += w1[3] * x[7]; }
#pragma unroll
        for (int e = 0; e < 8; ++e) y[e] = siluf_(y[e]) * (isk ? 0.08838834764831845f : 1.0f);
        u32x4 o; o.x = pk2(y[0], y[1]); o.y = pk2(y[2], y[3]); o.z = pk2(y[4], y[5]); o.w = pk2(y[6], y[7]);
        if (!isk) *(GAS u32x4*)(QC + (size_t)(R0 + s) * 512 + h * 128 + d0) = o;
        else { *(GAS u32x4*)(KC + (size_t)(R0 + s) * 512 + h * 128 + d0) = o;
            float kr[8]; unpack8(o, kr);
            u32x4 kw; kw.x = pk2(kr[0] * ws_, kr[1] * ws_); kw.y = pk2(kr[2] * ws_, kr[3] * ws_); kw.z = pk2(kr[4] * ws_, kr[5] * ws_); kw.w = pk2(kr[6] * ws_, kr[7] * ws_);
            put_t8(KWt, d0, s, kw); }
    }
    __syncthreads();
    if (tid < 128) {
        float n = 0.f;
#pragma unroll
        for (int j = 0; j < 8; ++j) { const u32x4 kw = *(const LAS u32x4*)(KWt + tid * 144 + j * 16);
            n += (lo_bf(kw.x) + hi_bf(kw.x)) + (lo_bf(kw.y) + hi_bf(kw.y)) + (lo_bf(kw.z) + hi_bf(kw.z)) + (lo_bf(kw.w) + hi_bf(kw.w)); }
        DN[(size_t)item * 128 + tid] = n;
    }
    {
        bf16x8 vf[2][2];
#pragma unroll
        for (int je = 0; je < 2; ++je)
#pragma unroll
            for (int kk = 0; kk < 2; ++kk) vf[je][kk] = ldfrag(Vt, 16 * (2 * w + je) + l15, 144, (32 * kk + 8 * lg) * 2);
#pragma unroll 2
        for (int dt = 0; dt < 8; ++dt) {
            const bf16x8 k0 = ldfrag(KWt, 16 * dt + l15, 144, (8 * lg) * 2), k1 = ldfrag(KWt, 16 * dt + l15, 144, (32 + 8 * lg) * 2);
#pragma unroll
            for (int je = 0; je < 2; ++je) {
                f32x4 a = {0.f, 0.f, 0.f, 0.f};
                a = MFMA16(k0, vf[je][0], a); a = MFMA16(k1, vf[je][1], a);
                u32x2 o; o.x = pk2(a[0], a[1]); o.y = pk2(a[2], a[3]);
                *(GAS u32x2*)(MST + ((size_t)item * 256 + 16 * (2 * w + je) + l15) * 128 + 16 * dt + 4 * lg) = o;
            }
        }
    }
    __syncthreads();
}

__device__ __forceinline__ void hgrn_state_item(LAS unsigned char* lds, int it, int tid, HaRegs& rg, int nxt, const GAS bf16* HF, const GAS bf16* HI, const GAS float* lbl, GAS bf16* HST, GAS float* DEC) {
    const int lane = tid & 63, w = __builtin_amdgcn_readfirstlane(tid >> 6), l15 = lane & 15, lg = lane >> 4;
    const int b = it >> 9, h = (it >> 6) & 7, c = it & 63, R0 = b * T + c * 64;
    LAS float* Gt = (LAS float*)(lds + 2048);
    LAS unsigned char* KDt = lds + 2048 + 34816;
    LAS unsigned char* Vt = KDt + 18432;
    LAS unsigned char* HR = Vt + 18432;
    LAS unsigned char* FR = HR + 17408;
    const int s = lane;
#pragma unroll
    for (int i = 0; i < 2; ++i) { const int idx = tid + NTHR * i; *(LAS u32x4*)(HR + (idx >> 4) * 272 + (idx & 15) * 16) = rg.hr[i]; *(LAS u32x4*)(FR + (idx >> 4) * 272 + (idx & 15) * 16) = rg.fr[i]; }
    if (nxt < 1024) ha_load(nxt, tid, HF, HI, rg);
    __syncthreads();
    u32x4 hv[2], fv[2];
#pragma unroll
    for (int i = 0; i < 2; ++i) { hv[i] = *(const LAS u32x4*)(HR + s * 272 + (w + 8 * i) * 16); fv[i] = *(const LAS u32x4*)(FR + s * 272 + (w + 8 * i) * 16); }
#pragma unroll
    for (int i = 0; i < 2; ++i) {
        put_t8(Vt, (w + 8 * i) * 8, s, hv[i]);
        const int d0 = (w + 8 * i) * 8, dd = h * 128 + d0; float f[8], kd[8], dl[8]; unpack8(fv[i], f);
#pragma unroll
        for (int e = 0; e < 8; ++e) { const float lbv = ((const LAS float*)(FR + 17408))[dd + e]; const float sg = sigmoidf_(f[e]);
            const float Gs = wave_scan_incl(__logf(lbv + (1.f - lbv) * sg), lane); const float Gl = __shfl(Gs, 63);
            kd[e] = (1.f - lbv) * (1.f - sg) * __expf(Gl - Gs); dl[e] = __expf(Gl); }
        u32x4 o; o.x = pk2(kd[0], kd[1]); o.y = pk2(kd[2], kd[3]); o.z = pk2(kd[4], kd[5]); o.w = pk2(kd[6], kd[7]);
        put_t8(KDt, d0, s, o);
        if (lane == 63) { *(GAS f32x4*)(DEC + (size_t)it * 128 + d0) = (f32x4){dl[0], dl[1], dl[2], dl[3]}; *(GAS f32x4*)(DEC + (size_t)it * 128 + d0 + 4) = (f32x4){dl[4], dl[5], dl[6], dl[7]}; }
    }
    __syncthreads();
    {
        const bf16x8 v0 = ldfrag(Vt, 16 * w + l15, 144, (8 * lg) * 2), v1 = ldfrag(Vt, 16 * w + l15, 144, (32 + 8 * lg) * 2);
#pragma unroll 2
        for (int dt = 0; dt < 8; ++dt) {
            f32x4 a = {0.f, 0.f, 0.f, 0.f};
            a = MFMA16(ldfrag(KDt, 16 * dt + l15, 144, (8 * lg) * 2), v0, a); a = MFMA16(ldfrag(KDt, 16 * dt + l15, 144, (32 + 8 * lg) * 2), v1, a);
            u32x2 o; o.x = pk2(a[0], a[1]); o.y = pk2(a[2], a[3]);
            *(GAS u32x2*)(HST + ((size_t)it * 128 + 16 * w + l15) * 128 + 16 * dt + 4 * lg) = o;
        }
    }
    __syncthreads();
}

struct MoRegs { u32x4 vv[4], qq[2], kq[2], cs[8]; float fl, ip, mprev, npv; };
struct HoRegs { u32x4 hv[2], fv[2], qw[2], cs[4]; };
struct OutPtrs { const GAS float* gates; const GAS float* MPREV; const GAS float* NPREV; const GAS bf16* QC; const GAS bf16* KC; const GAS bf16* MV; const GAS bf16* MST; const GAS bf16* HQ; const GAS bf16* HF; const GAS bf16* HI; const GAS bf16* HST; };
__device__ __forceinline__ void mo_load(int item, int tid, const OutPtrs& P, MoRegs& r) {
    const int lane = tid & 63, w = __builtin_amdgcn_readfirstlane(tid >> 6);
    const int b = item >> 8, h = (item >> 6) & 3, c = item & 63, R0 = b * T + c * 64;
#pragma unroll
    for (int j = 0; j < 8; ++j) { const int q = tid + NTHR * j; r.cs[j] = *(const GAS u32x4*)(P.MST + ((size_t)item * 256 + (q >> 4)) * 128 + (q & 15) * 8); }
#pragma unroll
    for (int i = 0; i < 4; ++i) r.vv[i] = *(const GAS u32x4*)(P.MV + (size_t)(R0 + lane) * 1024 + h * 256 + (w + 8 * i) * 8);
#pragma unroll
    for (int i = 0; i < 2; ++i) { const int idx = tid + NTHR * i, s = idx >> 4, ch = idx & 15;
        r.qq[i] = *(const GAS u32x4*)(P.QC + (size_t)(R0 + s) * 512 + h * 128 + ch * 8); r.kq[i] = *(const GAS u32x4*)(P.KC + (size_t)(R0 + s) * 512 + h * 128 + ch * 8); }
    r.fl = 0.f; r.ip = 0.f; r.mprev = 0.f; r.npv = 0.f;
    if (w == 0) { r.fl = P.gates[(size_t)(R0 + lane) * 8 + 4 + h]; r.ip = P.gates[(size_t)(R0 + lane) * 8 + h]; r.mprev = P.MPREV[item]; }
    if (w == 1 || w == 2) r.npv = P.NPREV[(size_t)item * 128 + (w - 1) * 64 + lane];
}
__device__ __forceinline__ void ho_load(int it, int tid, const OutPtrs& P, HoRegs& r) {
    const int lane = tid & 63, w = __builtin_amdgcn_readfirstlane(tid >> 6), d8 = tid & 15, sr = tid >> 4;
    const int b = it >> 9, h = (it >> 6) & 7, c = it & 63, R0 = b * T + c * 64;
#pragma unroll
    for (int j = 0; j < 4; ++j) { const int q = tid + NTHR * j; r.cs[j] = *(const GAS u32x4*)(P.HST + ((size_t)it * 128 + (q >> 4)) * 128 + (q & 15) * 8); }
#pragma unroll
    for (int i = 0; i < 2; ++i) { r.hv[i] = *(const GAS u32x4*)(P.HI + (size_t)(R0 + lane) * 1024 + h * 128 + (w + 8 * i) * 8);
        r.fv[i] = *(const GAS u32x4*)(P.HF + (size_t)(R0 + sr + 32 * i) * 1024 + h * 128 + d8 * 8); r.qw[i] = *(const GAS u32x4*)(P.HQ + (size_t)(R0 + sr + 32 * i) * 1024 + h * 128 + d8 * 8); }
}
__device__ __forceinline__ void mlstm_out_item(LAS unsigned char* lds, int item, int tid, const OutPtrs& P, MoRegs& rm, int nxt,
                                               const GAS bf16* MO, const GAS float* mhn, GAS bf16* YM) {
    const int lane = tid & 63, w = __builtin_amdgcn_readfirstlane(tid >> 6), l15 = lane & 15, lg = lane >> 4;
    const int b = item >> 8, h = (item >> 6) & 3, c = item & 63, R0 = b * T + c * 64;
    LAS float* sc = (LAS float*)lds;
    LAS unsigned char* Qs = lds + 4096;
    LAS unsigned char* Ks = Qs + 17408;
    LAS unsigned char* Ss = Ks + 17408;
    LAS unsigned char* Vt = Ss + 9216;
    LAS unsigned char* Cs = Vt + 36864;
    const int tt = w & 3, hh = w >> 2, t = 16 * tt + l15;
    {
#pragma unroll
        for (int i = 0; i < 2; ++i) { const int idx = tid + NTHR * i, s = idx >> 4, ch = idx & 15; *(LAS u32x4*)(Qs + s * 272 + ch * 16) = rm.qq[i]; *(LAS u32x4*)(Ks + s * 272 + ch * 16) = rm.kq[i]; }
#pragma unroll
        for (int i = 0; i < 4; ++i) put_t8(Vt, (w + 8 * i) * 8, lane, rm.vv[i]);
#pragma unroll
        for (int j = 0; j < 8; ++j) { const int q = tid + NTHR * j; *(LAS u32x4*)(Cs + (q >> 4) * 272 + (q & 15) * 16) = rm.cs[j]; }
        if (w == 0) {
            const float bs = wave_scan_incl(rm.fl, lane); float pm = rm.ip - bs;
#pragma unroll
            for (int o = 1; o < 64; o <<= 1) { const float u = __shfl_up(pm, o); if (lane >= o) pm = fmaxf(pm, u); }
            const float mt = bs + fmaxf(rm.mprev, pm);
            sc[lane] = bs; sc[64 + lane] = rm.ip; sc[128 + lane] = mt; sc[192 + lane] = __expf(bs + rm.mprev - mt);
        }
        if (w == 1 || w == 2) sc[512 + (w - 1) * 64 + lane] = rm.npv;
        if (nxt < 512) mo_load(nxt, tid, P, rm);
    }
    __syncthreads();
    bf16x8 qf[4];
#pragma unroll
    for (int kk = 0; kk < 4; ++kk) qf[kk] = ldfrag(Qs, t, 272, (32 * kk + 8 * lg) * 2);
    f32x4 a2[8];
#pragma unroll
    for (int et = 0; et < 8; ++et) { f32x4 a = {0.f, 0.f, 0.f, 0.f};
#pragma unroll
        for (int kk = 0; kk < 4; ++kk) a = MFMA16(ldfrag(Cs, 128 * hh + 16 * et + l15, 272, (32 * kk + 8 * lg) * 2), qf[kk], a);
        a2[et] = a; }
    float qn;
    {
        float acc = 0.f;
#pragma unroll
        for (int kk = 0; kk < 4; ++kk) { const f32x4 n0 = *(const LAS f32x4*)(sc + 512 + 32 * kk + 8 * lg), n1 = *(const LAS f32x4*)(sc + 512 + 32 * kk + 8 * lg + 4);
            float q8[8]; unpack8(__builtin_bit_cast(u32x4, qf[kk]), q8);
            acc += (q8[0] * n0[0] + q8[1] * n0[1]) + (q8[2] * n0[2] + q8[3] * n0[3]) + (q8[4] * n1[0] + q8[5] * n1[1]) + (q8[6] * n1[2] + q8[7] * n1[3]); }
        acc += __shfl_xor(acc, 16); acc += __shfl_xor(acc, 32); qn = acc;
    }
    {
        const float bt = sc[t], mt = sc[128 + t]; float rs = 0.f;
#pragma unroll
        for (int j = 0; j < 2; ++j) {
            const int st = 2 * hh + j; f32x4 a = {0.f, 0.f, 0.f, 0.f};
            if (st <= tt) {
#pragma unroll
                for (int kk = 0; kk < 4; ++kk) a = MFMA16(ldfrag(Ks, 16 * st + l15, 272, (32 * kk + 8 * lg) * 2), qf[kk], a);
            }
            float o[4];
#pragma unroll
            for (int r = 0; r < 4; ++r) { const int s = 16 * st + 4 * lg + r; o[r] = (s <= t) ? a[r] * __expf(bt - sc[s] + sc[64 + s] - mt) : 0.f; }
            u32x2 wv; wv.x = pk2(o[0], o[1]); wv.y = pk2(o[2], o[3]);
            *(LAS u32x2*)(Ss + t * 144 + (16 * st + 4 * lg) * 2) = wv;
            rs += (lo_bf(wv.x) + hi_bf(wv.x)) + (lo_bf(wv.y) + hi_bf(wv.y));
        }
        rs += __shfl_xor(rs, 16); rs += __shfl_xor(rs, 32);
        if (lg == 0) sc[256 + 64 * hh + t] = rs;
    }
    u32x2 mo[8];
#pragma unroll
    for (int et = 0; et < 8; ++et) mo[et] = *(const GAS u32x2*)(MO + (size_t)(R0 + t) * 1024 + h * 256 + 128 * hh + 16 * et + 4 * lg);
    __syncthreads();
    {
        const bf16x8 s0 = ldfrag(Ss, t, 144, (8 * lg) * 2), s1 = ldfrag(Ss, t, 144, (32 + 8 * lg) * 2);
        const float wi = sc[192 + t];
        const float den = (sc[256 + t] + sc[320 + t]) + wi * qn; const float dinv = 1.0f / fmaxf(fabsf(den), __expf(-sc[128 + t]));
        float q2 = 0.f;
#pragma unroll
        for (int et = 0; et < 8; ++et) {
            const int e0 = 128 * hh + 16 * et; f32x4 a1 = {0.f, 0.f, 0.f, 0.f};
            a1 = MFMA16(ldfrag(Vt, e0 + l15, 144, (8 * lg) * 2), s0, a1); a1 = MFMA16(ldfrag(Vt, e0 + l15, 144, (32 + 8 * lg) * 2), s1, a1);
#pragma unroll
            for (int r = 0; r < 4; ++r) { const float hv = (a1[r] + wi * a2[et][r]) * dinv; a2[et][r] = hv; q2 += hv * hv; }
        }
        q2 += __shfl_xor(q2, 16); q2 += __shfl_xor(q2, 32);
        if (lg == 0) sc[384 + 64 * hh + t] = q2;
        __syncthreads();
        const float rn = rsqrtf((sc[384 + t] + sc[448 + t]) * (1.0f / 256.0f) + EPS);
#pragma unroll
        for (int et = 0; et < 8; ++et) {
            const int e = 128 * hh + 16 * et + 4 * lg; const f32x4 g4 = *(const LAS f32x4*)(Cs + 69632 + e * 4);
            u32x2 o; o.x = pk2(a2[et][0] * rn * g4[0] * lo_bf(mo[et].x), a2[et][1] * rn * g4[1] * hi_bf(mo[et].x)); o.y = pk2(a2[et][2] * rn * g4[2] * lo_bf(mo[et].y), a2[et][3] * rn * g4[3] * hi_bf(mo[et].y));
            *(GAS u32x2*)(YM + (size_t)(R0 + t) * 1024 + h * 256 + e) = o;
        }
    }
    __syncthreads();
}

__device__ __forceinline__ void hgrn_out_item(LAS unsigned char* lds, int it, int tid, const OutPtrs& P, HoRegs& rh, int nxt, const GAS bf16* HG, const GAS float* lbl, const GAS float* hhn, GAS bf16* YH) {
    const int lane = tid & 63, w = __builtin_amdgcn_readfirstlane(tid >> 6), l15 = lane & 15, lg = lane >> 4;
    const int b = it >> 9, h = (it >> 6) & 7, c = it & 63, R0 = b * T + c * 64;
    LAS float* sc = (LAS float*)lds;
    LAS float* Gs = (LAS float*)(lds + 4096);
    LAS unsigned char* Qt = lds + 4096 + 32768;
    LAS unsigned char* Kt = Qt + 17408;
    LAS unsigned char* Qe = Kt + 17408;
    LAS unsigned char* As = Qe + 17408;
    LAS unsigned char* Vt = As + 9216;
    LAS unsigned char* Cs = Vt + 18432;
    const int d8 = tid & 15, sr = tid >> 4;
    const int tt = w & 3, hh = w >> 2, t = 16 * tt + l15;
    float qv[2][8], kv[2][8];
    {
#pragma unroll
        for (int j = 0; j < 4; ++j) { const int q = tid + NTHR * j; *(LAS u32x4*)(Cs + (q >> 4) * 272 + (q & 15) * 16) = rh.cs[j]; }
        float lbv[8];
        { const LAS float* LBV = (const LAS float*)(Cs + 34816); const int dd = h * 128 + d8 * 8; const f32x4 a0 = *(const LAS f32x4*)(LBV + dd), a1 = *(const LAS f32x4*)(LBV + dd + 4);
#pragma unroll
          for (int e = 0; e < 4; ++e) { lbv[e] = a0[e]; lbv[4 + e] = a1[e]; } }
#pragma unroll
        for (int i = 0; i < 2; ++i) {
            put_t8(Vt, (w + 8 * i) * 8, lane, rh.hv[i]);
            float f[8]; unpack8(rh.fv[i], f); unpack8(rh.qw[i], qv[i]); f32x4 g0, g1;
#pragma unroll
            for (int e = 0; e < 8; ++e) { const float sg = sigmoidf_(f[e]); const float g = __logf(lbv[e] + (1.f - lbv[e]) * sg); kv[i][e] = (1.f - lbv[e]) * (1.f - sg); if (e < 4) g0[e] = g; else g1[e - 4] = g; }
            *(LAS f32x4*)(Gs + (sr + 32 * i) * 128 + d8 * 8) = g0; *(LAS f32x4*)(Gs + (sr + 32 * i) * 128 + d8 * 8 + 4) = g1;
        }
    }
    u32x2 hg[4];
#pragma unroll
    for (int et = 0; et < 4; ++et) hg[et] = *(const GAS u32x2*)(HG + (size_t)(R0 + t) * 1024 + h * 128 + 64 * hh + 16 * et + 4 * lg);
    if (nxt < 512 + 1024) ho_load(nxt - 512, tid, P, rh);
    __syncthreads();
    {
        const int d = tid & 127, seg = tid >> 7; float g[16]; float Gc = 0.f;
#pragma unroll
        for (int j = 0; j < 16; ++j) g[j] = Gs[(16 * seg + j) * 128 + d];
#pragma unroll
        for (int j = 0; j < 16; ++j) { Gc += g[j]; Gs[(16 * seg + j) * 128 + d] = Gc; }
        sc[128 + seg * 128 + d] = Gc;
    }
    __syncthreads();
    {
        float t0[8], t1[8], t2[8], gm[8];
        { const f32x4 a0 = *(const LAS f32x4*)(sc + 128 + d8 * 8), a1 = *(const LAS f32x4*)(sc + 128 + d8 * 8 + 4), b0 = *(const LAS f32x4*)(sc + 256 + d8 * 8), b1 = *(const LAS f32x4*)(sc + 256 + d8 * 8 + 4),
                      c0 = *(const LAS f32x4*)(sc + 384 + d8 * 8), c1 = *(const LAS f32x4*)(sc + 384 + d8 * 8 + 4), m0 = *(const LAS f32x4*)(Gs + 31 * 128 + d8 * 8), m1 = *(const LAS f32x4*)(Gs + 31 * 128 + d8 * 8 + 4);
#pragma unroll
          for (int e = 0; e < 4; ++e) { t0[e] = a0[e]; t0[4 + e] = a1[e]; t1[e] = b0[e]; t1[4 + e] = b1[e]; t2[e] = c0[e]; t2[4 + e] = c1[e]; gm[e] = m0[e] + a0[e]; gm[4 + e] = m1[e] + a1[e]; } }
#pragma unroll
        for (int i = 0; i < 2; ++i) { const int s = sr + 32 * i, seg = s >> 4;
            const f32x4 g0 = *(const LAS f32x4*)(Gs + s * 128 + d8 * 8), g1 = *(const LAS f32x4*)(Gs + s * 128 + d8 * 8 + 4);
            float g[8] = {g0[0], g0[1], g0[2], g0[3], g1[0], g1[1], g1[2], g1[3]};
            float a[8], bq[8], cq[8];
#pragma unroll
            for (int e = 0; e < 8; ++e) { g[e] += (seg > 0 ? t0[e] : 0.f) + (seg > 1 ? t1[e] : 0.f) + (seg > 2 ? t2[e] : 0.f);
                a[e] = qv[i][e] * __expf(g[e] - gm[e]); bq[e] = kv[i][e] * __expf(gm[e] - g[e]); cq[e] = qv[i][e] * __expf(g[e]); }
            u32x4 o; o.x = pk2(a[0], a[1]); o.y = pk2(a[2], a[3]); o.z = pk2(a[4], a[5]); o.w = pk2(a[6], a[7]); *(LAS u32x4*)(Qt + s * 272 + d8 * 16) = o;
            o.x = pk2(bq[0], bq[1]); o.y = pk2(bq[2], bq[3]); o.z = pk2(bq[4], bq[5]); o.w = pk2(bq[6], bq[7]); *(LAS u32x4*)(Kt + s * 272 + d8 * 16) = o;
            o.x = pk2(cq[0], cq[1]); o.y = pk2(cq[2], cq[3]); o.z = pk2(cq[4], cq[5]); o.w = pk2(cq[6], cq[7]); *(LAS u32x4*)(Qe + s * 272 + d8 * 16) = o; }
    }
    __syncthreads();
    {
        bf16x8 qf[4];
#pragma unroll
        for (int kk = 0; kk < 4; ++kk) qf[kk] = ldfrag(Qt, t, 272, (32 * kk + 8 * lg) * 2);
#pragma unroll
        for (int j = 0; j < 2; ++j) {
            const int st = 2 * hh + j; f32x4 a = {0.f, 0.f, 0.f, 0.f};
            if (st <= tt) {
#pragma unroll
                for (int kk = 0; kk < 4; ++kk) a = MFMA16(ldfrag(Kt, 16 * st + l15, 272, (32 * kk + 8 * lg) * 2), qf[kk], a);
            }
            float o[4];
#pragma unroll
            for (int r = 0; r < 4; ++r) { const int s = 16 * st + 4 * lg + r; o[r] = (s <= t) ? a[r] : 0.f; }
            u32x2 wv; wv.x = pk2(o[0], o[1]); wv.y = pk2(o[2], o[3]);
            *(LAS u32x2*)(As + t * 144 + (16 * st + 4 * lg) * 2) = wv;
        }
    }
    f32x4 oacc[4];
    {
        bf16x8 qe[4];
#pragma unroll
        for (int kk = 0; kk < 4; ++kk) qe[kk] = ldfrag(Qe, t, 272, (32 * kk + 8 * lg) * 2);
#pragma unroll
        for (int et = 0; et < 4; ++et) { f32x4 a = {0.f, 0.f, 0.f, 0.f};
#pragma unroll
            for (int kk = 0; kk < 4; ++kk) a = MFMA16(ldfrag(Cs, 64 * hh + 16 * et + l15, 272, (32 * kk + 8 * lg) * 2), qe[kk], a);
            oacc[et] = a; }
    }
    __syncthreads();
    {
        const bf16x8 a0 = ldfrag(As, t, 144, (8 * lg) * 2), a1 = ldfrag(As, t, 144, (32 + 8 * lg) * 2);
        float q2 = 0.f;
#pragma unroll
        for (int et = 0; et < 4; ++et) {
            const int e0 = 64 * hh + 16 * et; f32x4 a = oacc[et];
            a = MFMA16(ldfrag(Vt, e0 + l15, 144, (8 * lg) * 2), a0, a); a = MFMA16(ldfrag(Vt, e0 + l15, 144, (32 + 8 * lg) * 2), a1, a);
            oacc[et] = a; q2 += (a[0] * a[0] + a[1] * a[1]) + (a[2] * a[2] + a[3] * a[3]);
        }
        q2 += __shfl_xor(q2, 16); q2 += __shfl_xor(q2, 32);
        if (lg == 0) sc[64 * hh + t] = q2;
        __syncthreads();
        const float rn = rsqrtf((sc[t] + sc[64 + t]) * (1.0f / 128.0f) + EPS);
#pragma unroll
        for (int et = 0; et < 4; ++et) {
            const int e = 64 * hh + 16 * et + 4 * lg; const f32x4 g4 = *(const LAS f32x4*)(Cs + 34816 + 4096 + (h * 128 + e) * 4);
            u32x2 o; o.x = pk2(oacc[et][0] * rn * g4[0] * lo_bf(hg[et].x), oacc[et][1] * rn * g4[1] * hi_bf(hg[et].x)); o.y = pk2(oacc[et][2] * rn * g4[2] * lo_bf(hg[et].y), oacc[et][3] * rn * g4[3] * hi_bf(hg[et].y));
            *(GAS u32x2*)(YH + (size_t)(R0 + t) * 1024 + h * 128 + e) = o;
        }
    }
    __syncthreads();
}

typedef const volatile unsigned long long __attribute__((address_space(4)))* KArgs;
#define KINP(i) ((const float*)kargs[(i)])
constexpr int I0 = N_FFN_ITEMS, I1 = I0 + 7424, I2 = I1 + 4096, I3 = I2 + 1024, I4 = I3 + 1024, I5 = I4 + 2048, I6 = I5 + 4096, I7 = I6 + 2048;
__device__ __forceinline__ CvtDesc w_desc(KArgs kargs, unsigned char* ws, int it) {
    if (it < I0) return ffn_desc(it, KINP(I_F1W1), KINP(I_F1W3), KINP(I_F1W2), KINP(I_NFFN1), (bf16*)(ws + WS_W13), (bf16*)(ws + WS_W2T));
    if (it < I1) { const int r = it - I0, nb = r % 232, kb = r / 232;
        const int col0 = nb < 96 ? nb * 32 : (nb < 224 ? nb * 32 + 8 : 3072); const int nv = nb < 224 ? 32 : (nb == 224 ? 8 : 0);
        return mk_desc(KINP(I_WIN), DIN, col0, nv, kb * 64, KINP(I_NMIX), (bf16*)(ws + WS_WIN) + (size_t)nb * 32 * D, D); }
    if (it < I2) { const int r = it - I1, nb = r % 128, kb = r / 128; return mk_desc(KINP(I_WIN), DIN, 7176 + nb * 32, 32, kb * 64, KINP(I_NMIX), (bf16*)(ws + WS_WG) + (size_t)nb * 32 * D, D); }
    if (it < I3) { const int r = it - I2, nb = r % 64, kb = r / 64; return mk_desc(KINP(I_WPM), D, nb * 32, 32, kb * 64, nullptr, (bf16*)(ws + WS_WPM) + (size_t)nb * 32 * 1024, 1024); }
    if (it < I4) { const int r = it - I3, nb = r % 64, kb = r / 64; return mk_desc(KINP(I_WPH), D, nb * 32, 32, kb * 64, nullptr, (bf16*)(ws + WS_WPH) + (size_t)nb * 32 * 1024, 1024); }
    if (it < I5) { const int r = it - I4, nb = r % 64, kb = r / 64; return mk_desc(KINP(I_WOUT), D, nb * 32, 32, kb * 64, nullptr, (bf16*)(ws + WS_WOUT) + (size_t)nb * 32 * D, D); }
    if (it < I6) { const int r = it - I5, nb = r % 128, kb = r / 128; return mk_desc(KINP(I_WKV), 2 * D, nb * 32, 32, kb * 64, nullptr, (bf16*)(ws + WS_WKV) + (size_t)nb * 32 * D, D); }
    { const int r = it - I6, nb = r % 64, kb = r / 64; return mk_desc(KINP(I_WO), D, nb * 32, 32, kb * 64, nullptr, (bf16*)(ws + WS_WO) + (size_t)nb * 32 * D, D); }
}
constexpr int WIN_P0 = 3712;
template <bool EARLY>
__device__ __forceinline__ void copy_items(KArgs kargs, unsigned char* ws, int first, int count, int cw, int ncw) {
    int ln = threadIdx.x & 63; asm volatile("" : "+v"(ln));
#pragma unroll 1
    for (int base = cw; base < count; base += 4 * ncw) {
        CvtDesc d[4]; f32x4 v[4][8];
#pragma unroll
        for (int u = 0; u < 4; ++u) { const int j = base + u * ncw; if (j < count) { d[u] = w_desc(kargs, ws, EARLY ? (j < 11264 ? j : (j < 11264 + WIN_P0 ? (I1 - WIN_P0) + (j - 11264) : I4 + (j - 11264 - WIN_P0))) : first + j); cvt_load(d[u], ln, v[u]); } }
#pragma unroll
        for (int u = 0; u < 4; ++u) { const int j = base + u * ncw; if (j < count) cvt_store(d[u], ln, v[u]); }
    }
}
__device__ __forceinline__ void wq_row(KArgs kargs, unsigned char* ws, int d, int lane) {
    const float g = KINP(I_NX)[d]; const f32x4* src = (const f32x4*)(KINP(I_WQ) + (size_t)d * D) + lane; bf16* dst = (bf16*)(ws + WS_WQ) + (size_t)d * D;
    f32x4 v[8];
#pragma unroll
    for (int j = 0; j < 8; ++j) v[j] = __builtin_nontemporal_load(src + 64 * j);
#pragma unroll
    for (int j = 0; j < 8; ++j) { const f32x4 o = v[j] * g; u32x2 w; w.x = pk2(o[0], o[1]); w.y = pk2(o[2], o[3]); *(GAS u32x2*)(dst + 256 * j + 4 * lane) = w; }
}

__global__ void __launch_bounds__(NTHR, 2) fwd_kernel(Args args) {
    extern __shared__ __attribute__((aligned(16))) unsigned char lds_raw[];
    LAS unsigned char* lds = (LAS unsigned char*)lds_raw;
    volatile LAS unsigned* MISC = (volatile LAS unsigned*)(lds + MISC_OFF);
    const int tid = threadIdx.x, lane = tid & 63, wave = __builtin_amdgcn_readfirstlane(tid >> 6);
    const int G = gridDim.x, bid = blockIdx.x;
    KArgs kargs = (KArgs)__builtin_amdgcn_kernarg_segment_ptr();
#define INP(i) ((const float*)kargs[(i)])
    unsigned char* ws = (unsigned char*)kargs[29];
    unsigned* ctl = (unsigned*)(ws + WS_CTL);
    if (tid < 64) MISC[tid] = 0u;
    __syncthreads();
    XcdBarrier bar = xcd_barrier_post(ctl + CW_BAR, MISC + 8);
    u64* ss = (u64*)(ws + WS_CTL + CTL_SS);
    const int gw = bid * NWAVES + wave, NGW = G * NWAVES;
    float* X = (float*)(ws + WS_X); bf16* XB = (bf16*)(ws + WS_XB);
    float* smallf = (float*)(ws + WS_SMALL);

    const bool split = (G == 256);
    constexpr int NEARLY = 11264 + WIN_P0 + (I7 - I4), NMID = (I1 - WIN_P0) - 11264, NLATE = I4 - I1;

    for (int rep_ = 0; rep_ < NREP(0); ++rep_) if (rep_ == 0 || (xcd_barrier(bar), true))
    {
        if (split) copy_items<true>(kargs, ws, 0, NEARLY, gw, NGW); else copy_items<false>(kargs, ws, 0, I7, gw, NGW);
#pragma unroll 1
        for (int d = gw; d < D; d += NGW) wq_row(kargs, ws, d, lane);
#pragma unroll 1
        for (int it = gw; it < 8192 + 512; it += NGW) {
            if (it < 8192) { const int row = it;
                const f32x4* src = (const f32x4*)(INP(I_X) + (size_t)row * D) + lane; bf16* dst = XB + (size_t)row * D; float s = 0.f;
                f32x4 v[8];
#pragma unroll
                for (int j = 0; j < 8; ++j) v[j] = __builtin_nontemporal_load(src + 64 * j);
#pragma unroll
                for (int j = 0; j < 8; ++j) { s += (v[j][0] * v[j][0] + v[j][1] * v[j][1]) + (v[j][2] * v[j][2] + v[j][3] * v[j][3]); u32x2 w; w.x = pk2(v[j][0], v[j][1]); w.y = pk2(v[j][2], v[j][3]); *(u32x2*)(dst + 256 * j + 4 * lane) = w; }
                s = wave_sum(s); if (lane == 0) ss[row] = (u64)(s * SS_SCALE); }
            else { const int row = it - 8192;
                const f32x4* src = (const f32x4*)(INP(I_MEM) + (size_t)row * D) + lane; const f32x4* gp = (const f32x4*)INP(I_NMEM) + lane; bf16* dst = (bf16*)(ws + WS_MEMN) + (size_t)row * D;
                f32x4 v[8]; float s = 0.f;
#pragma unroll
                for (int j = 0; j < 8; ++j) { v[j] = __builtin_nontemporal_load(src + 64 * j); s += (v[j][0] * v[j][0] + v[j][1] * v[j][1]) + (v[j][2] * v[j][2] + v[j][3] * v[j][3]); }
                const float r = rsqrtf(wave_sum(s) * (1.0f / D) + EPS);
#pragma unroll
                for (int j = 0; j < 8; ++j) { const f32x4 o = v[j] * r * gp[64 * j]; u32x2 w; w.x = pk2(o[0], o[1]); w.y = pk2(o[2], o[3]); *(u32x2*)(dst + 256 * j + 4 * lane) = w; } }
        }
    }
    xcd_barrier(bar);

    const bool LOCF = (MISC[11] != 0u);
    const int lrf = (int)MISC[10], xf = (int)bar.x;
    unsigned* rdyMID = ctl + 12416; unsigned* rdyKV = ctl + 12480;
#define FRONT_BARRIER() do { if (LOCF) xcd_local_barrier(bar, lrf & 3, ctl + 13312); else xcd_barrier(bar); } while (0)
    for (int rep_ = 0; rep_ < NREP(1); ++rep_) if (rep_ == 0 || (xcd_barrier(bar), true))
    { SchedUpKv S; S.o.init(32, 44, G, bid); S.G = G; S.c = bid; S.XBp = (const char*)XB; S.W13p = (const char*)(ws + WS_W13); S.MEMNp = (const char*)(ws + WS_MEMN); S.WKVp = (const char*)(ws + WS_WKV);
      S.loc = 0; S.p0 = 0; S.xq = 0; if (LOCF) { S.loc = 1; S.p0 = 4 * xf; S.xq = xf; S.c = lrf; }
      EpiUpKv E{EpiUp{(bf16*)(ws + AR_ACT), ss + 0 * M}, (bf16*)(ws + WS_KV)};
      pg8::gemm_phase((const char*)ws, lds, D, D, S, E);
      if (LOCF) {
          if (lrf >= 16 && lrf < 20) publish_count(rdyKV);
          if (lrf >= 20) { copy_items<false>(kargs, ws, 11264, NMID, (xf * 12 + lrf - 20) * NWAVES + wave, 96 * NWAVES); publish_count(rdyMID); }
      } else if (split && bid >= 160) copy_items<false>(kargs, ws, 11264, NMID, (bid - 160) * NWAVES + wave, 96 * NWAVES); }
    FRONT_BARRIER();
    if (LOCF) await_count(rdyMID, 96u, bar.bar);
    for (int rep_ = 0; rep_ < NREP(2); ++rep_) if (rep_ == 0 || (xcd_barrier(bar), true))
    { SchedStd S; S.o.init(32, 8, G, bid); if (LOCF) S.o.init_loc(8, 4 * xf, lrf);
      S.A = (const char*)(ws + AR_ACT); S.B = (const char*)(ws + WS_W2T); S.astep = (size_t)256 * FF * 2; S.bstep = (size_t)256 * FF * 2; S.bbatch = 0; S.nt = FF / 64;
      EpiRes<true> E{INP(I_X), XB, ss + 1 * M, 0.5f};
      pg8::gemm_phase((const char*)ws, lds, FF, FF, S, E); }
    FRONT_BARRIER();
    if (LOCF) await_count(rdyKV, 32u, bar.bar);
    for (int rep_ = 0; rep_ < NREP(3); ++rep_) if (rep_ == 0 || (xcd_barrier(bar), true))
    { SchedInW S; S.o.init(32, 29, G, bid); S.G = G; S.c = bid; S.XBp = (const char*)XB; S.WINp = (const char*)(ws + WS_WIN); S.Kp = (const char*)(ws + WS_KV); S.Vp = (const char*)(ws + WS_KV) + (size_t)512 * D * 2;
      S.WQp = (const char*)(ws + WS_WQ); S.WOp = (const char*)(ws + WS_WO);
      S.loc = 0; S.p0 = 0; S.xq = 0; if (LOCF) { S.loc = 1; S.p0 = 4 * xf; S.xq = xf; S.c = lrf; }
      EpiInW E{EpiInproj{ws, ss + 1 * M, INP(I_IGB), INP(I_FGB)}, (bf16*)(ws + WS_WQKT), (bf16*)(ws + WS_VWOT)};
      pg8::gemm_phase((const char*)ws, lds, D, D, S, E);
      if (LOCF) { if (lrf >= 24) copy_items<false>(kargs, ws, I1, NLATE, (xf * 8 + lrf - 24) * NWAVES + wave, 64 * NWAVES); }
      else if (split && bid >= 192) copy_items<false>(kargs, ws, I1, NLATE, (bid - 192) * NWAVES + wave, 64 * NWAVES); }
    xcd_barrier(bar);

    const bool LOCM = (MISC[11] != 0u);
    const int lrk = (int)MISC[10], xq = (int)bar.x;
    const int ms = LOCM ? 32 : G;
    const int m0 = LOCM ? xq * 64 + lrk : bid, m1 = LOCM ? xq * 64 + 64 : 512;
    const int h0 = LOCM ? xq * 128 + lrk : (bid + G - 512 % G) % G, h1 = LOCM ? xq * 128 + 128 : 1024;
#define MIX_BARRIER() do { if (LOCM) xcd_local_barrier(bar); else xcd_barrier(bar); } while (0)
    for (int rep_ = 0; rep_ < NREP(7); ++rep_) if (rep_ == 0 || (xcd_barrier(bar), true))
    {
        const GAS float* convw = (const GAS float*)INP(I_CONVW); const GAS float* convb = (const GAS float*)INP(I_CONVB); const GAS float* lbl = (const GAS float*)INP(I_LBL);
        const GAS float* gates = (const GAS float*)(smallf + SM_GATES / 4);
        GAS float* BLAST = (GAS float*)(smallf + SM_BLAST / 4); GAS float* MLOC = (GAS float*)(smallf + SM_MLOC / 4); GAS float* DN = (GAS float*)(smallf + SM_DN / 4); GAS float* DEC = (GAS float*)(smallf + SM_DEC / 4);
        int tid7 = threadIdx.x; asm volatile("" : "+v"(tid7));
        {   MaRegs rm; const GAS bf16* QKRAW = (const GAS bf16*)(ws + AR_QKRAW); const GAS bf16* MV = (const GAS bf16*)(ws + AR_MV);
            if (m0 < m1) { mlstm_stage_convw(lds, (m0 >> 6) & 3, tid7, convw, convb); ma_load(m0, tid7, gates, QKRAW, MV, rm); }
#pragma unroll 1
            for (int item = m0; item < m1; item += ms)
                mlstm_state_item(lds, item, tid7, rm, (item + ms < m1) ? item + ms : (1 << 20), gates, convw, convb, QKRAW, (GAS bf16*)(ws + AR_QC), (GAS bf16*)(ws + AR_KC), MV, (GAS bf16*)(ws + AR_MST), DN, BLAST, MLOC);
        }
        {   HaRegs rh;
            const GAS bf16* HF = (const GAS bf16*)(ws + AR_HF); const GAS bf16* HI = (const GAS bf16*)(ws + AR_HI);
            if (h0 < h1) { LAS float* LBV = (LAS float*)(lds + 2048 + 34816 + 18432 + 18432 + 17408 * 2);
                LBV[tid7] = sigmoidf_(lbl[1024 + tid7] - lbl[tid7]); LBV[512 + tid7] = sigmoidf_(lbl[1536 + tid7] - lbl[512 + tid7]);
                ha_load(h0, tid7, HF, HI, rh); }
#pragma unroll 1
            for (int it = h0; it < h1; it += ms)
                hgrn_state_item(lds, it, tid7, rh, (it + ms < h1) ? it + ms : (1 << 20), HF, HI, lbl, (GAS bf16*)(ws + AR_HST), DEC);
        }
    }
    MIX_BARRIER();

    for (int rep_ = 0; rep_ < NREP(8); ++rep_) if (rep_ == 0 || (xcd_barrier(bar), true))
    {
        const float* BLAST = smallf + SM_BLAST / 4; const float* MLOC = smallf + SM_MLOC / 4; float* MPREV = smallf + SM_MPREV / 4; float* DN = smallf + SM_DN / 4; const float* DEC = smallf + SM_DEC / 4;
        bf16* MST = (bf16*)(ws + AR_MST); bf16* HST = (bf16*)(ws + AR_HST);
        const int q8 = LOCM ? (lrk < 16 ? (xq << 13) + lrk * NTHR + tid : 65536 + ((2 * xq + ((lrk - 16) >> 3)) << 12) + ((lrk - 16) & 7) * NTHR + tid) : bid * NTHR + tid;
        const int q8s = LOCM ? (1 << 24) : G * NTHR;
#pragma unroll 1
        for (int q = q8; q < 131072; q += q8s) {
            if (q < 65536) {
                const int bh = q >> 13, qi = q & 8191; float m = 0.f; f32x4 C = {0.f, 0.f, 0.f, 0.f};
#define P8_LDM(c0, dw, bl, ml) _Pragma("unroll") for (int j = 0; j < 8; ++j) { const int item = bh * 64 + (c0) + j; dw[j] = *(const u32x2*)(MST + (size_t)item * 32768 + qi * 4); bl[j] = BLAST[item]; ml[j] = MLOC[item]; }
#define P8_PRM(c0, dw, bl, ml) _Pragma("unroll") for (int j = 0; j < 8; ++j) { \
                        const int item = bh * 64 + (c0) + j; u32x2 cw; cw.x = pk2(C[0], C[1]); cw.y = pk2(C[2], C[3]); *(u32x2*)(MST + (size_t)item * 32768 + qi * 4) = cw; \
                        if (qi == 0) MPREV[item] = m; \
                        const float mn = fmaxf(bl[j] + m, ml[j]), dec = __expf(bl[j] + m - mn), wl = __expf(ml[j] - mn); \
                        C[0] = dec * C[0] + wl * lo_bf(dw[j].x); C[1] = dec * C[1] + wl * hi_bf(dw[j].x); C[2] = dec * C[2] + wl * lo_bf(dw[j].y); C[3] = dec * C[3] + wl * hi_bf(dw[j].y); m = mn; }
                u32x2 dwA[8], dwB[8]; float blA[8], mlA[8], blB[8], mlB[8];
                P8_LDM(0, dwA, blA, mlA); P8_LDM(8, dwB, blB, mlB);
                P8_PRM(0, dwA, blA, mlA); P8_LDM(16, dwA, blA, mlA); P8_PRM(8, dwB, blB, mlB); P8_LDM(24, dwB, blB, mlB); P8_PRM(16, dwA, blA, mlA); P8_LDM(32, dwA, blA, mlA); P8_PRM(24, dwB, blB, mlB); P8_LDM(40, dwB, blB, mlB);
                P8_PRM(32, dwA, blA, mlA); P8_LDM(48, dwA, blA, mlA); P8_PRM(40, dwB, blB, mlB); P8_LDM(56, dwB, blB, mlB); P8_PRM(48, dwA, blA, mlA); P8_PRM(56, dwB, blB, mlB);
#undef P8_LDM
#undef P8_PRM
            } else {
                const int q2 = q - 65536, bh = q2 >> 12, qi = q2 & 4095, d = (qi * 4) & 127; f32x4 Sx = {0.f, 0.f, 0.f, 0.f};
#define P8_LDH(c0, dw, dc) _Pragma("unroll") for (int j = 0; j < 8; ++j) { const int it = bh * 64 + (c0) + j; dw[j] = *(const u32x2*)(HST + (size_t)it * 16384 + qi * 4); dc[j] = *(const f32x4*)(DEC + (size_t)it * 128 + d); }
#define P8_PRH(c0, dw, dc) _Pragma("unroll") for (int j = 0; j < 8; ++j) { \
                        const int it = bh * 64 + (c0) + j; u32x2 cw; cw.x = pk2(Sx[0], Sx[1]); cw.y = pk2(Sx[2], Sx[3]); *(u32x2*)(HST + (size_t)it * 16384 + qi * 4) = cw; \
                        Sx[0] = dc[j][0] * Sx[0] + lo_bf(dw[j].x); Sx[1] = dc[j][1] * Sx[1] + hi_bf(dw[j].x); Sx[2] = dc[j][2] * Sx[2] + lo_bf(dw[j].y); Sx[3] = dc[j][3] * Sx[3] + hi_bf(dw[j].y); }
                u32x2 dwA[8], dwB[8]; f32x4 dcA[8], dcB[8];
                P8_LDH(0, dwA, dcA); P8_LDH(8, dwB, dcB);
                P8_PRH(0, dwA, dcA); P8_LDH(16, dwA, dcA); P8_PRH(8, dwB, dcB); P8_LDH(24, dwB, dcB); P8_PRH(16, dwA, dcA); P8_LDH(32, dwA, dcA); P8_PRH(24, dwB, dcB); P8_LDH(40, dwB, dcB);
                P8_PRH(32, dwA, dcA); P8_LDH(48, dwA, dcA); P8_PRH(40, dwB, dcB); P8_LDH(56, dwB, dcB); P8_PRH(48, dwA, dcA); P8_PRH(56, dwB, dcB);
#undef P8_LDH
#undef P8_PRH
            }
        }
#pragma unroll 1
        for (int q = LOCM ? ((lrk == 0 && tid < 128) ? xq * 128 + tid : 1024) : bid * NTHR + tid; q < 1024; q += q8s) {
            const int bh = q >> 7, d = q & 127; float m = 0.f, n = 0.f;
#pragma unroll 1
            for (int c0 = 0; c0 < 64; c0 += 16) {
                float dn[16], bl[16], ml[16];
#pragma unroll
                for (int j = 0; j < 16; ++j) { const int item = bh * 64 + c0 + j; dn[j] = DN[(size_t)item * 128 + d]; bl[j] = BLAST[item]; ml[j] = MLOC[item]; }
#pragma unroll
                for (int j = 0; j < 16; ++j) { const int item = bh * 64 + c0 + j; DN[(size_t)item * 128 + d] = n;
                    const float mn = fmaxf(bl[j] + m, ml[j]), dec = __expf(bl[j] + m - mn), wl = __expf(ml[j] - mn); n = dec * n + wl * dn[j]; m = mn; }
            }
        }
    }
    MIX_BARRIER();
    for (int rep_ = 0; rep_ < NREP(9); ++rep_) if (rep_ == 0 || (xcd_barrier(bar), true))
    {
        const GAS float* lbl = (const GAS float*)INP(I_LBL); const GAS float* mhn = (const GAS float*)INP(I_MHN); const GAS float* hhn = (const GAS float*)INP(I_HHN);
        const GAS float* gates = (const GAS float*)(smallf + SM_GATES / 4); const GAS float* MPREV = (const GAS float*)(smallf + SM_MPREV / 4); const GAS float* NPREV = (const GAS float*)(smallf + SM_DN / 4);
        int tid9 = threadIdx.x; asm volatile("" : "+v"(tid9));
        const OutPtrs OP{gates, MPREV, NPREV, (const GAS bf16*)(ws + AR_QC), (const GAS bf16*)(ws + AR_KC), (const GAS bf16*)(ws + AR_MV), (const GAS bf16*)(ws + AR_MST),
                         (const GAS bf16*)(ws + AR_HQ), (const GAS bf16*)(ws + AR_HF), (const GAS bf16*)(ws + AR_HI), (const GAS bf16*)(ws + AR_HST)};
        {   MoRegs rm;
            if (m0 < m1) { if (tid9 < 64) *(LAS f32x4*)(lds + 4096 + 17408 * 2 + 9216 + 36864 + 69632 + tid9 * 16) = *(const GAS f32x4*)(mhn + ((m0 >> 6) & 3) * 256 + tid9 * 4);
                             mo_load(m0, tid9, OP, rm); }
#pragma unroll 1
            for (int item = m0; item < m1; item += ms)
                mlstm_out_item(lds, item, tid9, OP, rm, (item + ms < m1) ? item + ms : (1 << 20), (const GAS bf16*)(ws + AR_MO), mhn, (GAS bf16*)(ws + AR_YM));
        }
        {   HoRegs rh; const int first = 512 + h0;
            if (h0 < h1) {
                LAS float* LBV = (LAS float*)(lds + 4096 + 32768 + 17408 * 3 + 9216 + 18432 + 34816);
                LBV[tid9] = sigmoidf_(lbl[1024 + tid9] - lbl[tid9]); LBV[512 + tid9] = sigmoidf_(lbl[1536 + tid9] - lbl[512 + tid9]);
                LBV[1024 + tid9] = hhn[tid9]; LBV[1536 + tid9] = hhn[512 + tid9];
                __syncthreads();
                ho_load(first - 512, tid9, OP, rh); }
#pragma unroll 1
            for (int item = first; item < 512 + h1; item += ms)
                hgrn_out_item(lds, item - 512, tid9, OP, rh, (item + ms < 512 + h1) ? item + ms : (1 << 20), (const GAS bf16*)(ws + AR_HG), lbl, hhn, (GAS bf16*)(ws + AR_YH));
        }
    }

    for (int rep_ = 0; rep_ < NREP(10); ++rep_) if (rep_ == 0 || (xcd_barrier(bar), true))
    { SchedStd S; S.o.init(32, 16, G, bid); if (LOCM) S.o.init_loc(16, 4 * xq, lrk);
      S.A = (const char*)XB; S.B = (const char*)(ws + WS_WG); S.astep = 256 * D * 2; S.bstep = 256 * D * 2; S.bbatch = 0; S.nt = 32;
      EpiGates E{(bf16*)(ws + AR_GM), (bf16*)(ws + AR_GH), ss + 1 * M};
      pg8::gemm_phase((const char*)ws, lds, D, D, S, E); }
    xcd_barrier(bar);
    const bool LOC = (MISC[11] != 0u);
    const int lrank = (int)MISC[10], lp0 = 4 * (int)bar.x;
    unsigned* rdyW13 = ctl + 12288; unsigned* rdyW2T = ctl + 12352;
#define PHASE_BARRIER() do { if (LOC) xcd_local_barrier(bar, lrank & 3, ctl + 13312); else xcd_barrier(bar); } while (0)
    for (int rep_ = 0; rep_ < NREP(11); ++rep_) if (rep_ == 0 || (xcd_barrier(bar), true))
    { SchedPair S{G, bid, (const char*)(ws + AR_YM), (const char*)(ws + AR_YH), (const char*)(ws + WS_WPM), (const char*)(ws + WS_WPH), 0, 0};
      if (LOC) { S.loc = 1; S.p0 = lp0; S.c = lrank; }
      EpiProj E{(const bf16*)(ws + AR_GM), (const bf16*)(ws + AR_GH), (bf16*)(ws + AR_MERGED)};
      pg8::gemm_phase((const char*)ws, lds, 1024, 1024, S, E); }
    PHASE_BARRIER();
    for (int rep_ = 0; rep_ < NREP(12); ++rep_) if (rep_ == 0 || (xcd_barrier(bar), true))
    { SchedStd S; S.o.init(32, 8, G, bid); if (LOC) S.o.init_loc(8, lp0, lrank);
      S.A = (const char*)(ws + AR_MERGED); S.B = (const char*)(ws + WS_WOUT); S.astep = 256 * D * 2; S.bstep = 256 * D * 2; S.bbatch = 0; S.nt = 32;
      EpiRes<false> E{nullptr, XB, ss + 2 * M, 1.0f};
      pg8::gemm_phase((const char*)ws, lds, D, D, S, E); }
    PHASE_BARRIER();
    for (int rep_ = 0; rep_ < NREP(13); ++rep_) if (rep_ == 0 || (xcd_barrier(bar), true))
    { SchedStd S; S.o.init(32, 4, G, bid); if (LOC) S.o.init_loc(4, lp0, lrank);
      S.A = (const char*)XB; S.B = (const char*)(ws + WS_WQKT); S.astep = 256 * D * 2; S.bstep = 256 * D * 2; S.bbatch = (size_t)1024 * D * 2; S.nt = 32;
      EpiScores E{(bf16*)(ws + AR_P), ss + 2 * M, (LAS float*)(lds + RING_BYTES)};
      pg8::gemm_phase((const char*)ws, lds, D, D, S, E);
      const int cfirst = (G > 128) ? 128 : 0, nconv = (G - cfirst) * NWAVES;
      const bool copier = LOC ? (lrank >= 16) : (bid >= cfirst); const int cidx = LOC ? ((int)bar.x * 16 + lrank - 16) : (bid - cfirst);
      if (copier) {
          const float* w1 = INP(I_F2W1); const float* w3 = INP(I_F2W3); const float* w2 = INP(I_F2W2); const float* gn = INP(I_NFFN2);
          const int nit = (G == 256) ? 11264 : N_FFN_ITEMS;
#pragma unroll 1
          for (int base = cidx * NWAVES + wave; base < nit; base += 4 * nconv) {
              CvtDesc d[4]; f32x4 v[4][8];
#pragma unroll
              for (int u = 0; u < 4; ++u) { const int it = base + u * nconv; if (it < nit) { d[u] = ffn_desc(it, w1, w3, w2, gn, (bf16*)(ws + WS_W13), (bf16*)(ws + WS_W2T)); cvt_load(d[u], lane, v[u]); } }
#pragma unroll
              for (int u = 0; u < 4; ++u) { const int it = base + u * nconv; if (it < nit) cvt_store(d[u], lane, v[u]); }
          }
          if (LOC) publish_count(rdyW13);
      } }
    PHASE_BARRIER();
    for (int rep_ = 0; rep_ < NREP(15); ++rep_) if (rep_ == 0 || (xcd_barrier(bar), true))
    { SchedStd S; S.o.init(32, 8, G, bid); if (LOC) S.o.init_loc(8, lp0, lrank);
      S.A = (const char*)(ws + AR_P); S.B = (const char*)(ws + WS_VWOT); S.astep = 256 * 1024 * 2; S.bstep = 256 * 1024 * 2; S.bbatch = (size_t)2048 * 1024 * 2; S.nt = 16;
      EpiRes<false> E{nullptr, XB, ss + 3 * M, 1.0f};
      pg8::gemm_phase((const char*)ws, lds, 1024, 1024, S, E); }
    PHASE_BARRIER();
    if (LOC) await_count(rdyW13, 128u, bar.bar);
    for (int rep_ = 0; rep_ < NREP(16); ++rep_) if (rep_ == 0 || (xcd_barrier(bar), true))
    { SchedStd S; S.o.init(32, 44, G, bid); if (LOC) S.o.init_loc(44, lp0, lrank);
      S.A = (const char*)XB; S.B = (const char*)(ws + WS_W13); S.astep = 256 * D * 2; S.bstep = 256 * D * 2; S.bbatch = 0; S.nt = 32;
      EpiUp E{(bf16*)(ws + AR_ACT), ss + 3 * M};
      pg8::gemm_phase((const char*)ws, lds, D, D, S, E);
      const bool copier16 = LOC ? (lrank >= 16) : (bid >= 128); const int cidx16 = LOC ? ((int)bar.x * 16 + lrank - 16) : (bid - 128);
      if (G == 256 && copier16) {
          const float* w1 = INP(I_F2W1); const float* w3 = INP(I_F2W3); const float* w2 = INP(I_F2W2); const float* gn = INP(I_NFFN2); const int nconv = 128 * NWAVES;
          int ln16 = threadIdx.x & 63; asm volatile("" : "+v"(ln16));
#pragma unroll 1
          for (int base = 11264 + cidx16 * NWAVES + wave; base < N_FFN_ITEMS; base += 4 * nconv) {
              CvtDesc d[4]; f32x4 v[4][8];
#pragma unroll
              for (int u = 0; u < 4; ++u) { const int it = base + u * nconv; if (it < N_FFN_ITEMS) { d[u] = ffn_desc(it, w1, w3, w2, gn, (bf16*)(ws + WS_W13), (bf16*)(ws + WS_W2T)); cvt_load(d[u], ln16, v[u]); } }
#pragma unroll
              for (int u = 0; u < 4; ++u) { const int it = base + u * nconv; if (it < N_FFN_ITEMS) cvt_store(d[u], ln16, v[u]); }
          }
          if (LOC) publish_count(rdyW2T);
      } }
    PHASE_BARRIER();
    if (LOC) await_count(rdyW2T, 128u, bar.bar);
    if (G == 256) {
        SchedStd S; S.o.init(32, 8, G, bid); if (LOC) S.o.init_loc(8, lp0, lrank); S.A = (const char*)(ws + AR_ACT); S.B = (const char*)(ws + WS_W2T); S.astep = (size_t)256 * FF * 2; S.bstep = (size_t)256 * FF * 2; S.bbatch = 0; S.nt = FF / 64;
        EpiResFinal E{XB, (float*)kargs[28], INP(I_NFIN), ss + 4 * M, ctl + CW_PANEL, 0.5f};
        pg8::gemm_phase((const char*)ws, lds, FF, FF, S, E);
    } else {
        { SchedStd S; S.o.init(32, 8, G, bid); S.A = (const char*)(ws + AR_ACT); S.B = (const char*)(ws + WS_W2T); S.astep = (size_t)256 * FF * 2; S.bstep = (size_t)256 * FF * 2; S.bbatch = 0; S.nt = FF / 64;
          EpiRes<false> E{nullptr, XB, ss + 4 * M, 0.5f};
          pg8::gemm_phase((const char*)ws, lds, FF, FF, S, E); }
        xcd_barrier(bar);
        for (int row = gw; row < M; row += NGW) {
            const float r = rinv_of(ss + 4 * M, row);
            const u32x2* src = (const u32x2*)(XB + (size_t)row * D) + lane; const f32x4* gp = (const f32x4*)INP(I_NFIN) + lane; f32x4* dst = (f32x4*)((float*)kargs[28] + (size_t)row * D) + lane;
#pragma unroll
            for (int j = 0; j < 8; ++j) { const u32x2 xw = src[64 * j]; const f32x4 xv = {lo_bf(xw.x), hi_bf(xw.x), lo_bf(xw.y), hi_bf(xw.y)}; dst[64 * j] = xv * r * gp[64 * j]; }
        }
    }
}

extern "C" void kernel_launch(void* const* d_in, const int* in_sizes, int n_in, void* d_out, int out_size, void* d_ws, size_t ws_size, hipStream_t stream) {
    static int grid = 0;
    if (grid == 0) {
        if (n_in != 28 || in_sizes[0] != M * D || out_size != M * D || ws_size < WS_END) {
            fprintf(stderr, "kernel_launch: unexpected problem: n_in %d in0 %d out %d ws %zu (need %zu)\n", n_in, n_in > 0 ? in_sizes[0] : -1, out_size, ws_size, (size_t)WS_END); grid = -1; return; }
        int dev = 0, cus = 0;
        if (hipGetDevice(&dev) != hipSuccess || hipDeviceGetAttribute(&cus, hipDeviceAttributeMultiprocessorCount, dev) != hipSuccess) { fprintf(stderr, "kernel_launch: device query failed\n"); grid = -1; return; }
        if (hipFuncSetAttribute((const void*)fwd_kernel, hipFuncAttributeMaxDynamicSharedMemorySize, LDS_BYTES) != hipSuccess) { fprintf(stderr, "kernel_launch: hipFuncSetAttribute failed\n"); grid = -1; return; }
        int per_cu = 0;
        if (hipOccupancyMaxActiveBlocksPerMultiprocessor(&per_cu, (const void*)fwd_kernel, NTHR, LDS_BYTES) != hipSuccess || per_cu < 1) fprintf(stderr, "kernel_launch: note: occupancy query reports %d\n", per_cu);
        (void)hipGetLastError();
        grid = cus;
    }
    if (grid < 0) return;
    if (hipMemsetAsync((char*)d_ws + WS_CTL, 0, CTL_ZERO_BYTES, stream) != hipSuccess) { fprintf(stderr, "kernel_launch: memset failed\n"); return; }
    Args a{};
    for (int i = 0; i < 28; ++i) a.in[i] = (const float*)d_in[i];
    a.out = (float*)d_out; a.ws = (unsigned char*)d_ws;
    hipLaunchKernelGGL(fwd_kernel, dim3(grid), dim3(NTHR), LDS_BYTES, stream, a);
}
```

```cpp
#include <hip/hip_runtime.h>
#include <cstdio>
#include <cstdint>

#define LAS __attribute__((address_space(3)))
#define GAS __attribute__((address_space(1)))
typedef unsigned short bf16;
typedef short bf16x8 __attribute__((ext_vector_type(8)));
typedef float f32x4 __attribute__((ext_vector_type(4)));
typedef float f32x2 __attribute__((ext_vector_type(2)));
typedef unsigned u32x4 __attribute__((ext_vector_type(4)));
typedef unsigned u32x2 __attribute__((ext_vector_type(2)));
typedef unsigned long long u64;

constexpr int NB = 2, T = 4096, D = 2048, FF = 5632, M = NB * T;
constexpr int MEM = 256, DIN = 11272;
constexpr float EPS = 1e-6f;
constexpr int NWAVES = 8, NTHR = 512;

constexpr size_t MiB = 1u << 20;
constexpr size_t WS_CTL = 0, CTL_ZERO_BYTES = 1 * MiB;
constexpr size_t WS_SMALL = 1 * MiB;
constexpr size_t WS_MEMN = 3 * MiB;
constexpr size_t WS_KV = 5 * MiB;
constexpr size_t WS_WQKT = 9 * MiB;
constexpr size_t WS_VWOT = 17 * MiB;
constexpr size_t WS_W13 = 25 * MiB;
constexpr size_t WS_W2T = 69 * MiB;
constexpr size_t WS_WIN = 91 * MiB;
constexpr size_t WS_WG = 120 * MiB;
constexpr size_t WS_WPM = 136 * MiB, WS_WPH = 140 * MiB;
constexpr size_t WS_WOUT = 144 * MiB;
constexpr size_t WS_WQ = 152 * MiB;
constexpr size_t WS_WKV = 160 * MiB;
constexpr size_t WS_WO = 176 * MiB;
constexpr size_t WS_X = 184 * MiB;
constexpr size_t WS_XB = 248 * MiB;
constexpr size_t WS_AR = 280 * MiB;
constexpr size_t WS_END = 512 * MiB;
constexpr size_t AR_ACT = WS_AR;
constexpr size_t AR_QKRAW = WS_AR, AR_QC = WS_AR + 16 * MiB, AR_KC = WS_AR + 24 * MiB, AR_MV = WS_AR + 32 * MiB, AR_MO = WS_AR + 48 * MiB;
constexpr size_t AR_HQ = WS_AR + 64 * MiB, AR_HF = WS_AR + 80 * MiB, AR_HI = WS_AR + 96 * MiB, AR_HG = WS_AR + 112 * MiB;
constexpr size_t AR_MST = WS_AR + 128 * MiB;
constexpr size_t AR_HST = WS_AR + 160 * MiB;
constexpr size_t AR_YM = WS_AR + 192 * MiB, AR_YH = WS_AR + 208 * MiB;
constexpr size_t AR_GM = WS_X, AR_GH = WS_X + 32 * MiB;
constexpr size_t AR_TMP = WS_AR;
constexpr size_t AR_MERGED = WS_AR + 64 * MiB;
constexpr size_t AR_SC = WS_AR;
constexpr size_t AR_P = WS_AR + 32 * MiB;
static_assert(AR_YH + 16 * MiB <= WS_END, "arena");
constexpr size_t SM_GATES = 0;
constexpr size_t SM_BLAST = 256 * 1024;
constexpr size_t SM_MLOC = SM_BLAST + 2048;
constexpr size_t SM_MPREV = SM_MLOC + 2048;
constexpr size_t SM_DN = 512 * 1024;
constexpr size_t SM_DEC = 768 * 1024;
constexpr int CW_BAR = 4096;
constexpr int CW_PANEL = 8192;
constexpr size_t CTL_SS = 64 * 1024;
constexpr float SS_SCALE = 16777216.0f, SS_INV = 1.0f / (16777216.0f * 2048.0f);

constexpr int LDS_BYTES = 163840, RING_BYTES = 131072, MISC_OFF = LDS_BYTES - 256;

#define RLX_AGENT __ATOMIC_RELAXED, __HIP_MEMORY_SCOPE_AGENT
__device__ __forceinline__ unsigned f2bf(float f) { unsigned u = __builtin_bit_cast(unsigned, f); return (u + 0x7fffu + ((u >> 16) & 1u)) >> 16; }
__device__ __forceinline__ float bf2f(unsigned h) { return __builtin_bit_cast(float, (h & 0xffffu) << 16); }
typedef float f32x2_t __attribute__((ext_vector_type(2))); typedef __bf16 bf16x2_t __attribute__((ext_vector_type(2)));
__device__ __forceinline__ unsigned pk2(float lo, float hi) { f32x2_t v = {lo, hi}; bf16x2_t b = __builtin_convertvector(v, bf16x2_t); return __builtin_bit_cast(unsigned, b); }
__device__ __forceinline__ float lo_bf(unsigned w) { return __builtin_bit_cast(float, w << 16); }
__device__ __forceinline__ float hi_bf(unsigned w) { return __builtin_bit_cast(float, w & 0xffff0000u); }
__device__ __forceinline__ float sigmoidf_(float x) { return __builtin_amdgcn_rcpf(1.0f + __expf(-x)); }
__device__ __forceinline__ float siluf_(float x) { return x * __builtin_amdgcn_rcpf(1.0f + __expf(-x)); }
__device__ __forceinline__ float wave_sum(float v) {
#pragma unroll
    for (int o = 1; o < 64; o <<= 1) v += __shfl_xor(v, o);
    return v;
}
__device__ __forceinline__ float wave_max(float v) {
#pragma unroll
    for (int o = 1; o < 64; o <<= 1) v = fmaxf(v, __shfl_xor(v, o));
    return v;
}

#define XB_TMO      128
#define XB_XCNT(j)  (256  + 64 * (j))
#define XB_XSUB(j)  (1280 + 64 * (j))
#define XB_XGEN(j)  (2304 + 64 * (j))
#define XB_TOP      3328
#define XB_TOPGEN   3392
#define XCD_BAR_WORDS 3456
#define XB_LSUB(j)  (3456 + 32 * (j))
#define XB_LGEN(j)  (3712 + 32 * (j))
#define XB_SPIN_CAP (1u << 18)
__device__ __forceinline__ unsigned xb_ld(unsigned* p)              { return __hip_atomic_load(p, __ATOMIC_RELAXED, __HIP_MEMORY_SCOPE_AGENT); }
__device__ __forceinline__ unsigned xb_add(unsigned* p, unsigned v) { return __hip_atomic_fetch_add(p, v, __ATOMIC_RELAXED, __HIP_MEMORY_SCOPE_AGENT); }
__device__ __forceinline__ unsigned xb_xcc_id() { return (unsigned)__builtin_amdgcn_s_getreg((3 << 11) | 20) & 0xFu; }
#define XB_SPIN(cond, bar) do { unsigned _sp = 0; while (cond) { __builtin_amdgcn_s_sleep(1); \
    if ((++_sp & 255u) == 0u) { if (xb_ld(&(bar)[XB_TMO])) break; if (_sp > XB_SPIN_CAP) { atomicAdd(&(bar)[XB_TMO], 1u); break; } } } } while (0)
struct XcdBarrier { unsigned* bar; unsigned x; volatile LAS unsigned* st; };
__device__ __forceinline__ XcdBarrier xcd_barrier_post(unsigned* bar, volatile LAS unsigned* st) {
    XcdBarrier b; b.bar = bar; b.x = xb_xcc_id(); b.st = st;
    if (threadIdx.x == 0) st[2] = xb_add(&bar[XB_XCNT(b.x)], 1u);
    return b;
}
__device__ __forceinline__ void xcd_barrier_complete(unsigned* bar, unsigned x, unsigned& nloc, unsigned& nx, unsigned& uniform) {
    const unsigned G = gridDim.x * gridDim.y * gridDim.z;
    unsigned sum, cnt, mine, sp = 0u;
    for (;;) {
        sum = 0u; cnt = 0u; mine = 0u;
#pragma unroll
        for (unsigned j = 0; j < 16; ++j) { const unsigned c = xb_ld(&bar[XB_XCNT(j)]); sum += c; cnt += (c > 0u) ? 1u : 0u; mine = (j == x) ? c : mine; }
        if (sum == G) break;
        __builtin_amdgcn_s_sleep(1);
        if ((++sp & 255u) == 0u) { if (xb_ld(&bar[XB_TMO])) break; if (sp > XB_SPIN_CAP) { atomicAdd(&bar[XB_TMO], 1u); break; } }
    }
    nloc = mine > 0u ? mine : 1u; nx = cnt > 0u ? cnt : 1u;
    uniform = (G == 256u && cnt == 8u) ? 1u : 0u;
#pragma unroll
    for (unsigned j = 0; j < 8; ++j) if (xb_ld(&bar[XB_XCNT(j)]) != 32u) uniform = 0u;
}
__device__ __forceinline__ void xcd_barrier(const XcdBarrier& b) {
    asm volatile("s_waitcnt vmcnt(0)" ::: "memory");
    __syncthreads();
    if (threadIdx.x == 0) {
        unsigned* bar = b.bar;
        __builtin_amdgcn_s_waitcnt(0);
        unsigned nloc = b.st[0], nx = b.st[1];
        if (nloc == 0u) { unsigned uni; xcd_barrier_complete(bar, b.x, nloc, nx, uni); b.st[0] = nloc; b.st[1] = nx; b.st[3] = uni; }
        const unsigned old = xb_add(&bar[XB_XSUB(b.x)], 1u);
        const unsigned gen = old / nloc;
        if (old + 1u == (gen + 1u) * nloc) {
            __builtin_amdgcn_fence(__ATOMIC_RELEASE, "agent");
            asm volatile("s_waitcnt vmcnt(0)" ::: "memory");
            const unsigned og = xb_add(&bar[XB_TOP], 1u);
            const unsigned tg = og / nx;
            if (og + 1u == (tg + 1u) * nx) xb_add(&bar[XB_TOPGEN], 1u);
            else XB_SPIN(xb_ld(&bar[XB_TOPGEN]) == tg, bar);
            __builtin_amdgcn_fence(__ATOMIC_ACQUIRE, "agent");
            xb_add(&bar[XB_XGEN(b.x)], 1u);
            asm volatile("s_waitcnt vmcnt(0)" ::: "memory");
        } else {
            XB_SPIN(xb_ld(&bar[XB_XGEN(b.x)]) == gen, bar);
            __builtin_amdgcn_fence(__ATOMIC_ACQUIRE, "agent");
            asm volatile("s_waitcnt vmcnt(0)" ::: "memory");
        }
    }
    __syncthreads();
}

__device__ __forceinline__ void xcd_local_barrier(const XcdBarrier& b, const int pg = -1, unsigned* pgw = nullptr) {
    asm volatile("s_waitcnt vmcnt(0)" ::: "memory");
    __syncthreads();
    if (threadIdx.x == 0) {
        unsigned* bar = b.bar;
        __builtin_amdgcn_s_waitcnt(0);
        const unsigned nloc = pg < 0 ? b.st[0] : 8u;
        unsigned* sub = pg < 0 ? &bar[XB_LSUB(b.x)] : pgw + 64 * (4 * (int)b.x + pg); unsigned* gnp = pg < 0 ? &bar[XB_LGEN(b.x)] : pgw + 64 * (4 * (int)b.x + pg) + 32;
        const unsigned old = xb_add(sub, 1u);
        const unsigned gen = old / nloc;
        if (old + 1u == (gen + 1u) * nloc) xb_add(gnp, 1u);
        else XB_SPIN(xb_ld(gnp) == gen, bar);
        __builtin_amdgcn_fence(__ATOMIC_ACQUIRE, "agent");
        asm volatile("s_waitcnt vmcnt(0)" ::: "memory");
    }
    __syncthreads();
}
__device__ __forceinline__ void publish_count(unsigned* ctr) {
    asm volatile("s_waitcnt vmcnt(0)" ::: "memory");
    __syncthreads();
    if (threadIdx.x == 0) { __builtin_amdgcn_fence(__ATOMIC_RELEASE, "agent"); asm volatile("s_waitcnt vmcnt(0)" ::: "memory"); xb_add(ctr, 1u); }
}
__device__ __forceinline__ void await_count(unsigned* ctr, unsigned n, unsigned* bar) {
    if (threadIdx.x == 0) { XB_SPIN(xb_ld(ctr) < n, bar); __builtin_amdgcn_fence(__ATOMIC_ACQUIRE, "agent"); asm volatile("s_waitcnt vmcnt(0)" ::: "memory"); }
    __syncthreads();
}

namespace pg8 {
constexpr int BM = 256, BK = 64, HALF = 128, HTB = HALF * BK * 2, STAGE_BYTES = 8 * HTB, NXCD = 8, WGM = 8;
__host__ __device__ __forceinline__ int lds_byte(int r, int c) { return r * 128 + (((c >> 3) ^ (r & 7)) * 16) + (c & 7) * 2; }
__host__ __device__ __forceinline__ void stage_rc(int b, int& R, int& C) { const int pc = b / 1024, sb = b % 1024, r8 = sb / 128, pos = (sb % 128) / 16; R = pc * 8 + r8; C = (pos ^ r8) * 8; }
__host__ __device__ __forceinline__ int perm32(int rho) { const int n = rho >> 4, i = rho & 15; return 8 * (i >> 2) + 4 * n + (i & 3); }

struct Unit { int pm, pn, kind, aux, nt; };

struct TileOrder {
    int nM, nN, nwg, G, c, loc, p0;
    __device__ void init(int nM_, int nN_, int G_, int c_) { nM = nM_; nN = nN_; nwg = nM * nN; G = G_; c = c_; loc = 0; p0 = 0; }
    __device__ void init_loc(int nN_, int p0_, int lrank) { nM = 4; nN = nN_; nwg = 4 * nN_; G = 32; c = lrank; loc = 1; p0 = p0_; }
    __device__ bool tile(int i, int& pm, int& pn) const {
        if (loc) { const int L = i * 32 + c; if (L >= nwg) return false; pm = p0 + (L & 3); pn = L >> 2; return true; }
        return tileL((long)i * G + c, pm, pn); }
    __device__ bool tileL(long L, int& pm, int& pn) const {
        if (L >= nwg) return false;
        int wgid = (int)L; { const int q = nwg / NXCD, r = nwg % NXCD, xcd = wgid % NXCD, off = wgid / NXCD; wgid = (xcd < r ? xcd * (q + 1) : r * (q + 1) + (xcd - r) * q) + off; }
        const int nig = WGM * nN, gid = wgid / nig, fm = gid * WGM, gsz = (nM - fm) < WGM ? (nM - fm) : WGM;
        pm = fm + ((wgid % nig) % gsz); pn = (wgid % nig) / gsz; return true;
    }
};

template <class Epi, class Sched>
__device__ __forceinline__ void gemm_phase(const char* wsb, LAS unsigned char* lds, const int lda, const int ldb, const Sched& S, const Epi& E) {
    int tid_ = threadIdx.x; asm volatile("" : "+v"(tid_));
    const int tid = tid_, wid = __builtin_amdgcn_readfirstlane(tid >> 6), lane = tid & 63, wr = wid >> 2, wc = wid & 3, fr = lane & 15, fq = lane >> 4;
    unsigned voffA, voffB;
    { int R, C; stage_rc(tid * 16, R, C); const int Rb = (R & ~31) + perm32(R & 31);
      voffA = (unsigned)(R * lda + C) * 2u; voffB = (unsigned)(Rb * ldb + C) * 2u; }
    const unsigned hpA = 64u * (unsigned)lda * 2u, hpB = 64u * (unsigned)ldb * 2u;
    const __amdgpu_buffer_rsrc_t rsW = __builtin_amdgcn_make_buffer_rsrc((void*)wsb, (short)0, 0x7fffffff, 0x00020000);
    const size_t kstep = (size_t)(BK * 2);
    const size_t hstepA = (size_t)HALF * lda * 2, hstepB = (size_t)HALF * ldb * 2;
    const unsigned ldsw = (unsigned)wid * 1024u;
    const int aoff = lds_byte(wr * 64 + fr, fq * 8), boff = lds_byte(wc * 32 + fr, fq * 8), aoff1 = aoff ^ 64, boff1 = boff ^ 64;
#define PG8_SA(b, h) (((b) * 2 + (h)) * HTB)
#define PG8_SB(b, h) ((4 + (b) * 2 + (h)) * HTB)
#define PG8_STAGE(bufoff, gbase, voff, hp) do { const unsigned so_ = (unsigned)((const char*)(gbase) - wsb); \
        __builtin_amdgcn_raw_ptr_buffer_load_lds(rsW, (LAS unsigned*)(lds + (bufoff) + ldsw), 16, (voff), so_, 0, 0); \
        __builtin_amdgcn_raw_ptr_buffer_load_lds(rsW, (LAS unsigned*)(lds + (bufoff) + ldsw + 8192), 16, (voff), so_ + (hp), 0, 0); } while (0)
#define PG8_LDA(dst, b, h) do { _Pragma("unroll") for (int m = 0; m < 4; ++m) _Pragma("unroll") for (int k = 0; k < 2; ++k) dst[m][k] = *(const LAS bf16x8*)(lds + PG8_SA(b, h) + (k ? aoff1 : aoff) + m * 2048); } while (0)
#define PG8_LDB(dst, b, h) do { _Pragma("unroll") for (int n = 0; n < 2; ++n) _Pragma("unroll") for (int k = 0; k < 2; ++k) dst[n][k] = *(const LAS bf16x8*)(lds + PG8_SB(b, h) + (k ? boff1 : boff) + n * 2048); } while (0)
#define PG8_MMA(ai, bj, At, Bt) do { __builtin_amdgcn_s_setprio(1); _Pragma("unroll") for (int m = 0; m < 4; ++m) _Pragma("unroll") for (int n = 0; n < 2; ++n) _Pragma("unroll") for (int k = 0; k < 2; ++k) \
        acc[ai][bj][m][n] = __builtin_amdgcn_mfma_f32_16x16x32_bf16(Bt[n][k], At[m][k], acc[ai][bj][m][n], 0, 0, 0); __builtin_amdgcn_s_setprio(0); } while (0)
#define PG8_WAIT_V(n) asm volatile("s_waitcnt vmcnt(" #n ")" ::: "memory")
#define PG8_WAIT_L(n) asm volatile("s_waitcnt lgkmcnt(" #n ")" ::: "memory")
#define PG8_BAR __builtin_amdgcn_s_barrier()
#define PG8_SCHED __builtin_amdgcn_sched_barrier(0)
    Unit cur, nxt; int ui = 0;
    if (!S.next(0, cur)) return;
    f32x4 acc[2][2][4][2];
#pragma unroll
    for (int a = 0; a < 2; ++a)
#pragma unroll
        for (int b = 0; b < 2; ++b)
#pragma unroll
            for (int m = 0; m < 4; ++m)
#pragma unroll
                for (int n = 0; n < 2; ++n) acc[a][b][m][n] = (f32x4){0.f, 0.f, 0.f, 0.f};
    bf16x8 At[4][2], B0[2][2], B1[2][2];
    const char* cA; const char* cB; S.ptrs(cur, cA, cB);
    typename Epi::Pre pre; E.prefetch(cur, wr, fr, pre);
    PG8_STAGE(PG8_SB(0, 0), cB, voffB, hpB); PG8_STAGE(PG8_SB(0, 1), cB + hstepB, voffB, hpB); PG8_STAGE(PG8_SA(0, 0), cA, voffA, hpA); PG8_STAGE(PG8_SA(0, 1), cA + hstepA, voffA, hpA);
    if (wr == 1) PG8_BAR;
    PG8_WAIT_V(2); PG8_BAR;
    PG8_STAGE(PG8_SB(1, 0), cB + kstep, voffB, hpB); PG8_STAGE(PG8_SA(1, 0), cA + kstep, voffA, hpA); PG8_STAGE(PG8_SB(1, 1), cB + hstepB + kstep, voffB, hpB);
    PG8_WAIT_V(6); PG8_BAR;
    for (;;) {
        const bool has_next = S.next(ui + 1, nxt);
        const char* nA = cA + (size_t)(cur.nt - 2) * kstep; const char* nB = cB + (size_t)(cur.nt - 2) * kstep;
        if (has_next) S.ptrs(nxt, nA, nB);
        const int nt = cur.nt;
        for (int t = 0; t < nt; t += 2) {
            const bool last = (t == nt - 2);
            const char* a1 = cA + (size_t)(t + 1) * kstep;
            const char* a2 = last ? nA : cA + (size_t)(t + 2) * kstep; const char* b2 = last ? nB : cB + (size_t)(t + 2) * kstep;
            const char* a3 = a2 + kstep; const char* b3 = b2 + kstep;
            PG8_LDB(B0, 0, 0); PG8_LDB(B1, 0, 1); PG8_SCHED; PG8_LDA(At, 0, 0); PG8_STAGE(PG8_SA(1, 1), a1 + hstepA, voffA, hpA);
            PG8_WAIT_V(8); PG8_WAIT_L(0); PG8_BAR; PG8_MMA(0, 0, At, B0); PG8_MMA(0, 1, At, B1); PG8_BAR; PG8_SCHED;
            PG8_LDA(At, 0, 1); PG8_STAGE(PG8_SB(0, 0), b2, voffB, hpB); PG8_STAGE(PG8_SB(0, 1), b2 + hstepB, voffB, hpB); PG8_STAGE(PG8_SA(0, 0), a2, voffA, hpA);
            PG8_WAIT_V(8); PG8_WAIT_L(0); PG8_BAR; PG8_MMA(1, 0, At, B0); PG8_MMA(1, 1, At, B1); PG8_BAR; PG8_SCHED;
            PG8_LDB(B0, 1, 0); PG8_LDB(B1, 1, 1); PG8_SCHED; PG8_LDA(At, 1, 0); PG8_STAGE(PG8_SA(0, 1), a2 + hstepA, voffA, hpA);
            PG8_WAIT_V(8); PG8_WAIT_L(0); PG8_BAR; PG8_MMA(0, 0, At, B0); PG8_MMA(0, 1, At, B1); PG8_BAR; PG8_SCHED;
            PG8_LDA(At, 1, 1); PG8_STAGE(PG8_SB(1, 0), b3, voffB, hpB); PG8_STAGE(PG8_SB(1, 1), b3 + hstepB, voffB, hpB); PG8_STAGE(PG8_SA(1, 0), a3, voffA, hpA);
            PG8_WAIT_V(8); PG8_WAIT_L(0); PG8_BAR; PG8_MMA(1, 0, At, B0); PG8_MMA(1, 1, At, B1); PG8_BAR; PG8_SCHED;
        }
        if (wr == 0) PG8_BAR;
        { int fr_e = fr, fq_e = fq; asm volatile("" : "+v"(fr_e), "+v"(fq_e));
          E(acc, cur, wr, wc, fr_e, fq_e, pre);
          }
        if (!has_next) break;
        if (!(Sched::PAIR && cur.kind == 0)) {
#pragma unroll
        for (int a = 0; a < 2; ++a)
#pragma unroll
            for (int b = 0; b < 2; ++b)
#pragma unroll
                for (int m = 0; m < 4; ++m)
#pragma unroll
                    for (int n = 0; n < 2; ++n) acc[a][b][m][n] = (f32x4){0.f, 0.f, 0.f, 0.f};
        }
        cur = nxt; cA = nA; cB = nB; ++ui;
        E.prefetch(cur, wr, fr, pre);
        if (wr == 1) PG8_BAR;
    }
    PG8_WAIT_V(0);
    PG8_BAR;
#undef PG8_SA
#undef PG8_SB
#undef PG8_STAGE
#undef PG8_LDA
#undef PG8_LDB
#undef PG8_MMA
#undef PG8_WAIT_V
#undef PG8_WAIT_L
#undef PG8_BAR
#undef PG8_SCHED
}
}
using pg8::Unit;

struct SchedStd { static constexpr bool PAIR = false;
    pg8::TileOrder o; const char* A; const char* B; size_t astep, bstep, bbatch; int nt;
    __device__ bool next(int i, Unit& u) const { u.kind = 0; u.aux = 0; u.nt = nt; return o.tile(i, u.pm, u.pn); }
    __device__ void ptrs(const Unit& u, const char*& a, const char*& b) const { a = A + (size_t)u.pm * astep; b = B + (size_t)u.pn * bstep + (size_t)(u.pm >> 4) * bbatch; }
};
struct SchedPair { static constexpr bool PAIR = true;
    int G, c; const char *A0, *A1, *B0, *B1; int loc, p0;
    __device__ bool next(int i, Unit& u) const {
        u.kind = i & 1; u.aux = 0; u.nt = 16;
        if (loc) { if (i >= 2) return false; u.pm = p0 + (c & 3); u.pn = c >> 2; return true; }
        const int p = (i >> 1) * G + c; if (p >= 256) return false; u.pm = p >> 3; u.pn = p & 7; return true; }
    __device__ void ptrs(const Unit& u, const char*& a, const char*& b) const { a = (u.kind ? A1 : A0) + (size_t)u.pm * (256 * 1024 * 2); b = (u.kind ? B1 : B0) + (size_t)u.pn * (256 * 1024 * 2); }
};
constexpr size_t TSTEP = (size_t)256 * D * 2;
struct SchedUpKv { static constexpr bool PAIR = false;
    pg8::TileOrder o; int G, c; const char *XBp, *W13p, *MEMNp, *WKVp; int loc, p0, xq;
    __device__ bool next(int i, Unit& u) const { const long L = loc ? (long)i * 32 + c : (long)i * G + c; u.aux = 0; u.nt = 32;
        if (loc) {
            if (L < 176) { u.kind = 0; u.pm = p0 + ((int)L & 3); u.pn = (int)L >> 2; return true; }
            if (L < 180) { const int r = xq * 4 + ((int)L - 176); u.kind = 1; u.pm = r & 1; u.pn = r >> 1; return true; }
            return false; }
        if (L < 1408) { u.kind = 0; return o.tileL(L, u.pm, u.pn); }
        if (L < 1440) { const int r = (int)L - 1408; u.kind = 1; u.pm = r & 1; u.pn = r >> 1; return true; }
        return false; }
    __device__ void ptrs(const Unit& u, const char*& a, const char*& b) const { a = (u.kind ? MEMNp : XBp) + (size_t)u.pm * TSTEP; b = (u.kind ? WKVp : W13p) + (size_t)u.pn * TSTEP; }
};
struct SchedInW { static constexpr bool PAIR = false;
    pg8::TileOrder o; int G, c; const char *XBp, *WINp, *Kp, *Vp, *WQp, *WOp; int loc, p0, xq;
    __device__ bool wunit(int r, Unit& u) const { const int rr = r & 63; u.kind = 1 + (r >> 6); u.aux = ((rr >> 5) << 2) | ((rr >> 3) & 3); u.pm = rr & 7; u.pn = 0; u.nt = 8; return true; }
    __device__ bool next(int i, Unit& u) const {
        u.aux = 0; u.nt = 32; u.kind = 0;
        if (loc) {
            const int L = i * 32 + c;
            if (L < 116) { u.pm = p0 + (L & 3); u.pn = L >> 2; return true; }
            if (i == 3) return wunit(xq * 16 + (c - 20), u);
            if (i == 4 && c >= 20 && c < 24) return wunit(xq * 16 + 12 + (c - 20), u);
            return false; }
        if (G == 256) {
            if (i < 3) return o.tileL((long)i * 256 + c, u.pm, u.pn);
            if (i == 3) { if (768 + c < 928) return o.tileL(768 + c, u.pm, u.pn); return wunit(c - 160, u); }
            if (i == 4 && c >= 160 && c < 192) return wunit(96 + c - 160, u);
            return false;
        }
        const long L = (long)i * G + c;
        if (L < 928) return o.tileL(L, u.pm, u.pn);
        if (L < 1056) return wunit((int)L - 928, u);
        return false; }
    __device__ void ptrs(const Unit& u, const char*& a, const char*& b) const {
        const int bb = u.aux >> 2, hh = u.aux & 3;
        if (u.kind == 0) { a = XBp + (size_t)u.pm * TSTEP; b = WINp + (size_t)u.pn * TSTEP; }
        else if (u.kind == 1) { a = Kp + (size_t)bb * TSTEP + hh * 1024; b = WQp + (size_t)u.pm * TSTEP + hh * 1024; }
        else { a = WOp + (size_t)u.pm * TSTEP + hh * 1024; b = Vp + (size_t)bb * TSTEP + hh * 1024; } }
};

#define EPI_ROWS(ai, m) (u.pm * 256 + (ai) * 128 + wr * 64 + (m) * 16 + fr)
#define EPI_COL8(bj) ((bj) * 128 + wc * 32 + 8 * fq)
struct NoPre {};
struct RowPre { u64 s[8]; };
__device__ __forceinline__ void rowpre_load(const u64* ss, const int pm, int wr, int fr, RowPre& p) {
#pragma unroll
    for (int k = 0; k < 8; ++k) p.s[k] = ((const GAS u64*)ss)[pm * 256 + (k >> 2) * 128 + wr * 64 + (k & 3) * 16 + fr]; }
__device__ __forceinline__ float rinv_of(const u64* ss, int row) { return rsqrtf((float)((const GAS u64*)ss)[row] * SS_INV + EPS); }

struct EpiUp {
    struct Pre { u64 s[8]; };
    __device__ __forceinline__ void prefetch(const Unit& u, int wr, int fr, Pre& p) const {
#pragma unroll
        for (int k = 0; k < 8; ++k) p.s[k] = ((const GAS u64*)ss)[u.pm * 256 + (k >> 2) * 128 + wr * 64 + (k & 3) * 16 + fr]; }
    bf16* act; const u64* ss;
    __device__ __forceinline__ void operator()(const f32x4 (&acc)[2][2][4][2], const Unit& u, int wr, int wc, int fr, int fq, const Pre& pre) const {
#ifdef EPI_TWICE
      for (int rep2 = 0; rep2 < 2; ++rep2) { asm volatile("" : "+v"(fr), "+v"(fq));
#endif
#pragma unroll
        for (int ai = 0; ai < 2; ++ai)
#pragma unroll
            for (int m = 0; m < 4; ++m) {
                const int row = EPI_ROWS(ai, m); const float r = rsqrtf((float)pre.s[ai * 4 + m] * SS_INV + EPS);
                float o[8];
#pragma unroll
                for (int n = 0; n < 2; ++n)
#pragma unroll
                    for (int i = 0; i < 4; ++i) { const float a = acc[ai][0][m][n][i] * r, b = acc[ai][1][m][n][i] * r; o[n * 4 + i] = siluf_(a) * b; }
                u32x4 w; w.x = pk2(o[0], o[1]); w.y = pk2(o[2], o[3]); w.z = pk2(o[4], o[5]); w.w = pk2(o[6], o[7]);
                *(GAS u32x4*)(act + (size_t)row * FF + u.pn * 128 + wc * 32 + 8 * fq) = w;
            }
#ifdef EPI_TWICE
      }
#endif
    }
};
template <bool IN_F32>
struct EpiRes {
    typedef NoPre Pre; __device__ __forceinline__ void prefetch(const Unit&, int, int, Pre&) const {}
    const float* xin32; bf16* xb; u64* ssn; float scale;
    __device__ __forceinline__ void operator()(const f32x4 (&acc)[2][2][4][2], const Unit& u, int wr, int wc, int fr, int fq, const Pre& pre) const {
#pragma unroll
        for (int ai = 0; ai < 2; ++ai)
#pragma unroll
            for (int m = 0; m < 4; ++m) {
                const int row = EPI_ROWS(ai, m); float q = 0.f;
#pragma unroll
                for (int bj = 0; bj < 2; ++bj) {
                    const size_t off = (size_t)row * D + u.pn * 256 + EPI_COL8(bj);
                    f32x4 x0, x1;
                    if (IN_F32) { x0 = *(const GAS f32x4*)(xin32 + off); x1 = *(const GAS f32x4*)(xin32 + off + 4); }
                    else { const u32x4 xw = *(const GAS u32x4*)(xb + off); x0[0] = lo_bf(xw.x); x0[1] = hi_bf(xw.x); x0[2] = lo_bf(xw.y); x0[3] = hi_bf(xw.y); x1[0] = lo_bf(xw.z); x1[1] = hi_bf(xw.z); x1[2] = lo_bf(xw.w); x1[3] = hi_bf(xw.w); }
                    const f32x4 o0 = x0 + acc[ai][bj][m][0] * scale, o1 = x1 + acc[ai][bj][m][1] * scale;
                    u32x4 w; w.x = pk2(o0[0], o0[1]); w.y = pk2(o0[2], o0[3]); w.z = pk2(o1[0], o1[1]); w.w = pk2(o1[2], o1[3]); *(GAS u32x4*)(xb + off) = w;
                    q += (o0[0] * o0[0] + o0[1] * o0[1]) + (o0[2] * o0[2] + o0[3] * o0[3]) + (o1[0] * o1[0] + o1[1] * o1[1]) + (o1[2] * o1[2] + o1[3] * o1[3]);
                }
                q += __shfl_xor(q, 16); q += __shfl_xor(q, 32);
                if (fq == 0) atomicAdd((u64*)(ssn + row), (u64)(q * SS_SCALE));
            }
    }
};
struct EpiResFinal {
    typedef NoPre Pre; __device__ __forceinline__ void prefetch(const Unit&, int, int, Pre&) const {}
    const bf16* xin; float* out; const float* gfin; u64* ssn; unsigned* cnt; float scale;
    __device__ __forceinline__ void operator()(f32x4 (&acc)[2][2][4][2], const Unit& u, int wr, int wc, int fr, int fq, const Pre& pre) const {
#pragma unroll
        for (int ai = 0; ai < 2; ++ai)
#pragma unroll
            for (int m = 0; m < 4; ++m) {
                const int row = EPI_ROWS(ai, m); float q = 0.f;
#pragma unroll
                for (int bj = 0; bj < 2; ++bj) {
                    const size_t off = (size_t)row * D + u.pn * 256 + EPI_COL8(bj);
                    const u32x4 xw = *(const GAS u32x4*)(xin + off);
                    f32x4 x0, x1; x0[0] = lo_bf(xw.x); x0[1] = hi_bf(xw.x); x0[2] = lo_bf(xw.y); x0[3] = hi_bf(xw.y); x1[0] = lo_bf(xw.z); x1[1] = hi_bf(xw.z); x1[2] = lo_bf(xw.w); x1[3] = hi_bf(xw.w);
                    const f32x4 o0 = x0 + acc[ai][bj][m][0] * scale, o1 = x1 + acc[ai][bj][m][1] * scale;
                    acc[ai][bj][m][0] = o0; acc[ai][bj][m][1] = o1;
                    q += (o0[0] * o0[0] + o0[1] * o0[1]) + (o0[2] * o0[2] + o0[3] * o0[3]) + (o1[0] * o1[0] + o1[1] * o1[1]) + (o1[2] * o1[2] + o1[3] * o1[3]);
                }
                q += __shfl_xor(q, 16); q += __shfl_xor(q, 32);
                if (fq == 0) atomicAdd((u64*)(ssn + row), (u64)(q * SS_SCALE));
            }
        asm volatile("s_waitcnt vmcnt(0)" ::: "memory");
        unsigned* c = cnt + 64 * u.pm;
        if (fr == 0 && fq == 0) __hip_atomic_fetch_add(c, 1u, __ATOMIC_RELAXED, __HIP_MEMORY_SCOPE_AGENT);
        if (wr == 0 && wc == 0) {
            unsigned spins = 0;
            while ((unsigned)__builtin_amdgcn_readfirstlane(__hip_atomic_load(c, __ATOMIC_RELAXED, __HIP_MEMORY_SCOPE_AGENT)) < 64u) { __builtin_amdgcn_s_sleep(2); if (++spins > (1u << 22)) break; }
            __builtin_amdgcn_fence(__ATOMIC_ACQUIRE, "agent");
            asm volatile("s_waitcnt vmcnt(0)" ::: "memory");
        }
        asm volatile("" ::: "memory"); __builtin_amdgcn_s_barrier(); asm volatile("" ::: "memory");
#pragma unroll
        for (int ai = 0; ai < 2; ++ai)
#pragma unroll
            for (int m = 0; m < 4; ++m) {
                const int row = EPI_ROWS(ai, m);
                const float r = rsqrtf((float)__hip_atomic_load(ssn + row, __ATOMIC_RELAXED, __HIP_MEMORY_SCOPE_AGENT) * SS_INV + EPS);
#pragma unroll
                for (int bj = 0; bj < 2; ++bj) {
                    const size_t off = (size_t)row * D + u.pn * 256 + EPI_COL8(bj); const int col = u.pn * 256 + EPI_COL8(bj);
                    const f32x4 o0 = acc[ai][bj][m][0], o1 = acc[ai][bj][m][1];
                    *(GAS f32x4*)(out + off) = o0 * r * *(const GAS f32x4*)(gfin + col); *(GAS f32x4*)(out + off + 4) = o1 * r * *(const GAS f32x4*)(gfin + col + 4);
                }
            }
    }
};
struct EpiInproj {
    typedef RowPre Pre; __device__ __forceinline__ void prefetch(const Unit& u, int wr, int fr, Pre& p) const { rowpre_load(ss, u.pm, wr, fr, p); }
    unsigned char* ws; const u64* ss; const float* igb; const float* fgb;
    __device__ __forceinline__ void operator()(const f32x4 (&acc)[2][2][4][2], const Unit& u, int wr, int wc, int fr, int fq, const Pre& pre) const {
        if (u.pn == 28) {
            if (wc == 0 && fq == 0) {
                float* gates = (float*)(ws + WS_SMALL + SM_GATES);
#pragma unroll
                for (int ai = 0; ai < 2; ++ai)
#pragma unroll
                    for (int m = 0; m < 4; ++m) {
                        const int row = EPI_ROWS(ai, m); const float r = rsqrtf((float)pre.s[ai * 4 + m] * SS_INV + EPS);
                        f32x4 gi, gf;
#pragma unroll
                        for (int i = 0; i < 4; ++i) {
                            gi[i] = acc[ai][0][m][0][i] * r + igb[i];
                            const float xf = acc[ai][0][m][1][i] * r + fgb[i];
                            gf[i] = fminf(xf, 0.f) - __logf(1.0f + __expf(-fabsf(xf)));
                        }
                        *(GAS f32x4*)(gates + (size_t)row * 8) = gi; *(GAS f32x4*)(gates + (size_t)row * 8 + 4) = gf;
                    }
            }
            return;
        }
        const int ty = u.pn >> 2;
        bf16* base = (bf16*)(ws + (ty == 0 ? AR_QKRAW : ty == 1 ? AR_MV : ty == 2 ? AR_MO : ty == 3 ? AR_HQ : ty == 4 ? AR_HF : ty == 5 ? AR_HI : AR_HG));
#pragma unroll
        for (int ai = 0; ai < 2; ++ai)
#pragma unroll
            for (int m = 0; m < 4; ++m) {
                const int row = EPI_ROWS(ai, m); const float r = rsqrtf((float)pre.s[ai * 4 + m] * SS_INV + EPS);
#pragma unroll
                for (int bj = 0; bj < 2; ++bj) {
                    float o[8];
#pragma unroll
                    for (int n = 0; n < 2; ++n)
#pragma unroll
                        for (int i = 0; i < 4; ++i) {
                            float v = acc[ai][bj][m][n][i] * r;
                            if (ty == 2) v = sigmoidf_(v); else if (ty == 3) v = siluf_(v) * 0.08838834764831845f; else if (ty == 6) v = siluf_(v);
                            o[n * 4 + i] = v;
                        }
                    u32x4 w; w.x = pk2(o[0], o[1]); w.y = pk2(o[2], o[3]); w.z = pk2(o[4], o[5]); w.w = pk2(o[6], o[7]);
                    *(GAS u32x4*)(base + (size_t)row * 1024 + (u.pn & 3) * 256 + EPI_COL8(bj)) = w;
                }
            }
    }
};
struct EpiGates {
    typedef RowPre Pre; __device__ __forceinline__ void prefetch(const Unit& u, int wr, int fr, Pre& p) const { rowpre_load(ss, u.pm, wr, fr, p); }
    bf16* gm; bf16* gh; const u64* ss;
    __device__ __forceinline__ void operator()(const f32x4 (&acc)[2][2][4][2], const Unit& u, int wr, int wc, int fr, int fq, const Pre& pre) const {
        bf16* base = (u.pn < 8) ? gm : gh;
#pragma unroll
        for (int ai = 0; ai < 2; ++ai)
#pragma unroll
            for (int m = 0; m < 4; ++m) {
                const int row = EPI_ROWS(ai, m); const float r = rsqrtf((float)pre.s[ai * 4 + m] * SS_INV + EPS);
#pragma unroll
                for (int bj = 0; bj < 2; ++bj) {
                    float o[8];
#pragma unroll
                    for (int n = 0; n < 2; ++n)
#pragma unroll
                        for (int i = 0; i < 4; ++i) o[n * 4 + i] = sigmoidf_(acc[ai][bj][m][n][i] * r);
                    u32x4 w; w.x = pk2(o[0], o[1]); w.y = pk2(o[2], o[3]); w.z = pk2(o[4], o[5]); w.w = pk2(o[6], o[7]);
                    *(GAS u32x4*)(base + (size_t)row * D + (u.pn & 7) * 256 + EPI_COL8(bj)) = w;
                }
            }
    }
};
struct EpiProj {
    typedef NoPre Pre; __device__ __forceinline__ void prefetch(const Unit&, int, int, Pre&) const {}
    const bf16* gm; const bf16* gh; bf16* merged;
    __device__ __forceinline__ void operator()(f32x4 (&acc)[2][2][4][2], const Unit& u, int wr, int wc, int fr, int fq, const Pre& pre) const {
#pragma unroll
        for (int ai = 0; ai < 2; ++ai)
#pragma unroll
            for (int m = 0; m < 4; ++m) {
                const int row = EPI_ROWS(ai, m);
#pragma unroll
                for (int bj = 0; bj < 2; ++bj) {
                    const size_t off = (size_t)row * D + u.pn * 256 + EPI_COL8(bj);
                    const u32x4 hw = *(const GAS u32x4*)(gh + off);
                    float h8[8] = {lo_bf(hw.x), hi_bf(hw.x), lo_bf(hw.y), hi_bf(hw.y), lo_bf(hw.z), hi_bf(hw.z), lo_bf(hw.w), hi_bf(hw.w)};
                    if (u.kind == 0) {
                        const u32x4 gw = *(const GAS u32x4*)(gm + off);
                        const float g8[8] = {lo_bf(gw.x), hi_bf(gw.x), lo_bf(gw.y), hi_bf(gw.y), lo_bf(gw.z), hi_bf(gw.z), lo_bf(gw.w), hi_bf(gw.w)};
#pragma unroll
                        for (int i = 0; i < 4; ++i) { acc[ai][bj][m][0][i] *= g8[i] * __builtin_amdgcn_rcpf(fmaxf(h8[i], 1e-30f)); acc[ai][bj][m][1][i] *= g8[4 + i] * __builtin_amdgcn_rcpf(fmaxf(h8[4 + i], 1e-30f)); }
                    } else {
                        const f32x4 a = acc[ai][bj][m][0], b = acc[ai][bj][m][1];
                        u32x4 w; w.x = pk2(a[0] * h8[0], a[1] * h8[1]); w.y = pk2(a[2] * h8[2], a[3] * h8[3]); w.z = pk2(b[0] * h8[4], b[1] * h8[5]); w.w = pk2(b[2] * h8[6], b[3] * h8[7]); *(GAS u32x4*)(merged + off) = w;
                    }
                }
            }
    }
};
struct EpiScores {
    typedef RowPre Pre; __device__ __forceinline__ void prefetch(const Unit& u, int wr, int fr, Pre& p) const { rowpre_load(ss, u.pm, wr, fr, p); }
    bf16* p; const u64* ss; LAS float* xch;
    __device__ __forceinline__ void operator()(const f32x4 (&acc)[2][2][4][2], const Unit& u, int wr, int wc, int fr, int fq, const Pre& pre) const {
        float v[2][4][16];
#pragma unroll
        for (int ai = 0; ai < 2; ++ai)
#pragma unroll
            for (int m = 0; m < 4; ++m) {
                const int row = EPI_ROWS(ai, m), rl = ai * 128 + wr * 64 + m * 16 + fr; const float r = rsqrtf((float)pre.s[ai * 4 + m] * SS_INV + EPS) * 0.04419417382415922f;
                float mx = -INFINITY;
#pragma unroll
                for (int bj = 0; bj < 2; ++bj)
#pragma unroll
                    for (int n = 0; n < 2; ++n)
#pragma unroll
                        for (int i = 0; i < 4; ++i) { const float x = acc[ai][bj][m][n][i] * r; v[ai][m][bj * 8 + n * 4 + i] = x; mx = fmaxf(mx, x); }
                mx = fmaxf(mx, __shfl_xor(mx, 16)); mx = fmaxf(mx, __shfl_xor(mx, 32));
                if (fq == 0) xch[rl * 4 + wc] = mx;
            }
        asm volatile("s_waitcnt lgkmcnt(0)" ::: "memory"); __builtin_amdgcn_s_barrier(); asm volatile("" ::: "memory");
#pragma unroll
        for (int ai = 0; ai < 2; ++ai)
#pragma unroll
            for (int m = 0; m < 4; ++m) {
                const int rl = ai * 128 + wr * 64 + m * 16 + fr; const f32x4 pm = *(const LAS f32x4*)(xch + rl * 4);
                const float mx = fmaxf(fmaxf(pm[0], pm[1]), fmaxf(pm[2], pm[3])); float sm = 0.f;
#pragma unroll
                for (int k = 0; k < 16; ++k) { const float e = __expf(v[ai][m][k] - mx); v[ai][m][k] = e; sm += e; }
                sm += __shfl_xor(sm, 16); sm += __shfl_xor(sm, 32);
                if (fq == 0) xch[1024 + rl * 4 + wc] = sm;
            }
        asm volatile("s_waitcnt lgkmcnt(0)" ::: "memory"); __builtin_amdgcn_s_barrier(); asm volatile("" ::: "memory");
#pragma unroll
        for (int ai = 0; ai < 2; ++ai)
#pragma unroll
            for (int m = 0; m < 4; ++m) {
                const int row = EPI_ROWS(ai, m), rl = ai * 128 + wr * 64 + m * 16 + fr; const f32x4 ps = *(const LAS f32x4*)(xch + 1024 + rl * 4);
                const float inv = __builtin_amdgcn_rcpf((ps[0] + ps[1]) + (ps[2] + ps[3]));
#pragma unroll
                for (int bj = 0; bj < 2; ++bj) {
                    const float* e = &v[ai][m][bj * 8];
                    u32x4 w; w.x = pk2(e[0] * inv, e[1] * inv); w.y = pk2(e[2] * inv, e[3] * inv); w.z = pk2(e[4] * inv, e[5] * inv); w.w = pk2(e[6] * inv, e[7] * inv);
                    *(GAS u32x4*)(p + (size_t)row * 1024 + u.pn * 256 + EPI_COL8(bj)) = w;
                }
            }
    }
};
__device__ __forceinline__ void store_tile_bf16(const f32x4 (&acc)[2][2][4][2], bf16* base, int ldc, int wr, int wc, int fr, int fq) {
#pragma unroll
    for (int ai = 0; ai < 2; ++ai)
#pragma unroll
        for (int m = 0; m < 4; ++m) {
            const int rl = ai * 128 + wr * 64 + m * 16 + fr;
#pragma unroll
            for (int bj = 0; bj < 2; ++bj) {
                const f32x4 a = acc[ai][bj][m][0], b = acc[ai][bj][m][1];
                u32x4 w; w.x = pk2(a[0], a[1]); w.y = pk2(a[2], a[3]); w.z = pk2(b[0], b[1]); w.w = pk2(b[2], b[3]);
                *(GAS u32x4*)(base + (size_t)rl * ldc + EPI_COL8(bj)) = w;
            }
        }
}
struct EpiUpKv {
    typedef EpiUp::Pre Pre; __device__ __forceinline__ void prefetch(const Unit& u, int wr, int fr, Pre& p) const { if (u.kind == 0) up.prefetch(u, wr, fr, p); }
    EpiUp up; bf16* kv;
    __device__ __forceinline__ void operator()(const f32x4 (&acc)[2][2][4][2], const Unit& u, int wr, int wc, int fr, int fq, const Pre& pre) const {
        if (u.kind == 0) up(acc, u, wr, wc, fr, fq, pre);
        else store_tile_bf16(acc, kv + (size_t)(u.pn >> 3) * (512 * D) + (size_t)u.pm * (256 * D) + (u.pn & 7) * 256, D, wr, wc, fr, fq);
    }
};
struct EpiInW {
    typedef RowPre Pre; __device__ __forceinline__ void prefetch(const Unit& u, int wr, int fr, Pre& p) const { if (u.kind == 0) inp.prefetch(u, wr, fr, p); }
    EpiInproj inp; bf16* wqkt; bf16* vwot;
    __device__ __forceinline__ void operator()(const f32x4 (&acc)[2][2][4][2], const Unit& u, int wr, int wc, int fr, int fq, const Pre& pre) const {
        const int bb = u.aux >> 2, hh = u.aux & 3;
        if (u.kind == 0) inp(acc, u, wr, wc, fr, fq, pre);
        else if (u.kind == 1) store_tile_bf16(acc, wqkt + (size_t)bb * (1024 * D) + (size_t)hh * (256 * D) + u.pm * 256, D, wr, wc, fr, fq);
        else store_tile_bf16(acc, vwot + (size_t)bb * (2048 * 1024) + (size_t)u.pm * (256 * 1024) + hh * 256, 1024, wr, wc, fr, fq);
    }
};

struct Args { const float* in[28]; float* out; unsigned char* ws; };
enum { I_X = 0, I_MEM, I_NFFN1, I_F1W1, I_F1W3, I_F1W2, I_NMIX, I_WIN, I_CONVW, I_CONVB, I_IGB, I_FGB, I_MHN, I_LBL, I_HHN, I_WPM, I_WPH, I_WOUT, I_NX, I_NMEM, I_WQ, I_WKV, I_WO,
       I_NFFN2, I_F2W1, I_F2W3, I_F2W2, I_NFIN };

struct CvtDesc { const float* src; const float* gain; bf16* dst; int ld_src, ld_dst, col0, nvalid, k0; };
__device__ __forceinline__ void cvt_load(const CvtDesc& d, int lane, f32x4 (&v)[8]) {
    const int kc = lane & 7, ng = lane >> 3; const bool ok = (4 * ng) < d.nvalid;
#pragma unroll
    for (int j = 0; j < 8; ++j) v[j] = ok ? __builtin_nontemporal_load((const GAS f32x4*)(d.src + (size_t)(d.k0 + 8 * kc + j) * d.ld_src + d.col0 + 4 * ng)) : (f32x4){0.f, 0.f, 0.f, 0.f};
}
__device__ __forceinline__ void cvt_store(const CvtDesc& d, int lane, f32x4 (&v)[8]) {
    const int kc = lane & 7, ng = lane >> 3;
    if (d.gain) {
        const f32x4 g0 = *(const f32x4*)(d.gain + d.k0 + 8 * kc), g1 = *(const f32x4*)(d.gain + d.k0 + 8 * kc + 4);
        v[0] *= g0[0]; v[1] *= g0[1]; v[2] *= g0[2]; v[3] *= g0[3]; v[4] *= g1[0]; v[5] *= g1[1]; v[6] *= g1[2]; v[7] *= g1[3];
    }
#pragma unroll
    for (int i = 0; i < 4; ++i) {
        u32x4 w; w.x = pk2(v[0][i], v[1][i]); w.y = pk2(v[2][i], v[3][i]); w.z = pk2(v[4][i], v[5][i]); w.w = pk2(v[6][i], v[7][i]);
        *(u32x4*)(d.dst + (size_t)(4 * ng + i) * d.ld_dst + d.k0 + 8 * kc) = w;
    }
}
__device__ __forceinline__ CvtDesc mk_desc(const float* src, int ld_src, int col0, int nvalid, int k0, const float* gain, bf16* dst, int ld_dst) {
    CvtDesc d; d.src = src; d.gain = gain; d.dst = dst; d.ld_src = ld_src; d.ld_dst = ld_dst; d.col0 = col0; d.nvalid = nvalid; d.k0 = k0; return d; }
__device__ __forceinline__ CvtDesc ffn_desc(int it, const float* w1, const float* w3, const float* w2, const float* gain, bf16* w13, bf16* w2t) {
    if (it < 11264) { const int nb = it % 352, kb = it / 352; const int pn = nb >> 3, bj = (nb >> 2) & 1, cb = nb & 3;
        return mk_desc(bj ? w3 : w1, FF, pn * 128 + cb * 32, 32, kb * 64, gain, w13 + (size_t)nb * 32 * D, D); }
    it -= 11264;
    const int nb = it % 64, kb = it / 64; return mk_desc(w2, D, nb * 32, 32, kb * 64, nullptr, w2t + (size_t)nb * 32 * FF, FF);
}
constexpr int N_FFN_ITEMS = 11264 + 5632;
#ifndef PHASES
#define PHASES 0xFFFFFu
#endif
#define PH(k) ((PHASES >> (k)) & 1u)
#ifndef REPS
#define REPS 0x0u
#endif
#define NREP(k) ((int)PH(k) + (int)((REPS >> (k)) & 1u))

__device__ __forceinline__ bf16x8 ldfrag(const LAS unsigned char* base, int row, int stride, int kbyte) { return *(const LAS bf16x8*)(base + row * stride + kbyte); }
#define MFMA16(a, b, c) __builtin_amdgcn_mfma_f32_16x16x32_bf16((a), (b), (c), 0, 0, 0)
__device__ __forceinline__ float wave_scan_incl(float v, int lane) {
    (void)lane;
#define WS_DPP(ctrl, rmask) v += __builtin_bit_cast(float, __builtin_amdgcn_update_dpp(0, __builtin_bit_cast(int, v), (ctrl), (rmask), 0xf, false))
    WS_DPP(0x111, 0xf); WS_DPP(0x112, 0xf); WS_DPP(0x114, 0xf); WS_DPP(0x118, 0xf);
    WS_DPP(0x142, 0xa);
    WS_DPP(0x143, 0xc);
#undef WS_DPP
    return v;
}
__device__ __forceinline__ void unpack8(const u32x4 w, float (&f)[8]) { f[0] = lo_bf(w.x); f[1] = hi_bf(w.x); f[2] = lo_bf(w.y); f[3] = hi_bf(w.y); f[4] = lo_bf(w.z); f[5] = hi_bf(w.z); f[6] = lo_bf(w.w); f[7] = hi_bf(w.w); }
__device__ __forceinline__ void put_t8(LAS unsigned char* Tt, int col0, int s, const u32x4 vw) {
    LAS bf16* p = (LAS bf16*)(Tt + col0 * 144 + s * 2);
    p[0 * 72] = (bf16)(vw.x & 0xffffu); p[1 * 72] = (bf16)(vw.x >> 16); p[2 * 72] = (bf16)(vw.y & 0xffffu); p[3 * 72] = (bf16)(vw.y >> 16);
    p[4 * 72] = (bf16)(vw.z & 0xffffu); p[5 * 72] = (bf16)(vw.z >> 16); p[6 * 72] = (bf16)(vw.w & 0xffffu); p[7 * 72] = (bf16)(vw.w >> 16);
}

struct MaRegs { u32x4 vr[4], qk[5]; float fl, ip; };
struct HaRegs { u32x4 hr[2], fr[2]; };
__device__ __forceinline__ void ma_load(int item, int tid, const GAS float* gates, const GAS bf16* QKRAW, const GAS bf16* MV, MaRegs& r) {
    const int b = item >> 8, h = (item >> 6) & 3, c = item & 63, R0 = b * T + c * 64;
#pragma unroll
    for (int i = 0; i < 4; ++i) { const int idx = tid + NTHR * i, row = idx >> 5, ch = idx & 31; r.vr[i] = *(const GAS u32x4*)(MV + (size_t)(R0 + row) * 1024 + h * 256 + ch * 8); }
#pragma unroll
    for (int j = 0; j < 5; ++j) { const int idx = tid + NTHR * j, row = idx >> 5, ch = idx & 31, tt = c * 64 - 3 + row;
        r.qk[j] = (idx < 67 * 32 && tt >= 0) ? *(const GAS u32x4*)(QKRAW + (size_t)(b * T + tt) * 1024 + (ch >> 4) * 512 + h * 128 + (ch & 15) * 8) : (u32x4){0u, 0u, 0u, 0u}; }
    r.fl = 0.f; r.ip = 0.f;
    if (tid < 64) { r.fl = gates[(size_t)(R0 + tid) * 8 + 4 + h]; r.ip = gates[(size_t)(R0 + tid) * 8 + h]; }
}
__device__ __forceinline__ void ha_load(int it, int tid, const GAS bf16* HF, const GAS bf16* HI, HaRegs& r) {
    const int b = it >> 9, h = (it >> 6) & 7, c = it & 63, R0 = b * T + c * 64;
#pragma unroll
    for (int i = 0; i < 2; ++i) { const int idx = tid + NTHR * i, row = idx >> 4, ch = idx & 15;
        r.hr[i] = *(const GAS u32x4*)(HI + (size_t)(R0 + row) * 1024 + h * 128 + ch * 8); r.fr[i] = *(const GAS u32x4*)(HF + (size_t)(R0 + row) * 1024 + h * 128 + ch * 8); }
}
__device__ __forceinline__ void mlstm_stage_convw(LAS unsigned char* lds, int h, int tid, const GAS float* convw, const GAS float* convb) {
    LAS float* CW = (LAS float*)(lds + 2048 + 18432 + 36864 + 35376 + 33792);
    if (tid < 320) { const int j = tid >> 6, c4 = tid & 63, col = (c4 >> 5) * 512 + h * 128 + (c4 & 31) * 4;
        *(LAS f32x4*)(CW + j * 256 + c4 * 4) = *(const GAS f32x4*)((j < 4 ? convw + j * 1024 : convb) + col); }
}
__device__ __forceinline__ void mlstm_state_item(LAS unsigned char* lds, int item, int tid, MaRegs& rg, int nxt, const GAS float* gates, const GAS float* convw, const GAS float* convb, const GAS bf16* QKRAW, GAS bf16* QC, GAS bf16* KC,
                                                 const GAS bf16* MV, GAS bf16* MST, GAS float* DN, GAS float* BLAST, GAS float* MLOC) {
    const int lane = tid & 63, w = __builtin_amdgcn_readfirstlane(tid >> 6), l15 = lane & 15, lg = lane >> 4;
    const int b = item >> 8, h = (item >> 6) & 3, c = item & 63, R0 = b * T + c * 64;
    LAS float* sc = (LAS float*)lds;
    LAS unsigned char* KWt = lds + 2048;
    LAS unsigned char* Vt = KWt + 18432;
    LAS unsigned char* RAW = Vt + 36864;
    LAS unsigned char* VR = RAW + 35376;
    const LAS float* CW = (const LAS float*)(VR + 33792);
    const int s = lane;
    if (w == 0) {
        const float bs = wave_scan_incl(rg.fl, lane); const float blast = __shfl(bs, 63);
        const float a = blast - bs + rg.ip; const float ml = wave_max(a);
        sc[128 + lane] = __expf(a - ml);
        if (lane == 0) { BLAST[item] = blast; MLOC[item] = ml; }
    }
#pragma unroll
    for (int i = 0; i < 4; ++i) { const int idx = tid + NTHR * i; *(LAS u32x4*)(VR + (idx >> 5) * 528 + (idx & 31) * 16) = rg.vr[i]; }
#pragma unroll
    for (int j = 0; j < 5; ++j) { const int idx = tid + NTHR * j; if (idx < 67 * 32) *(LAS u32x4*)(RAW + (idx >> 5) * 528 + (idx & 31) * 16) = rg.qk[j]; }
    if (nxt < 512) ma_load(nxt, tid, gates, QKRAW, MV, rg);
    __syncthreads();
#pragma unroll
    for (int i = 0; i < 4; ++i) put_t8(Vt, (w + 8 * i) * 8, s, *(const LAS u32x4*)(VR + s * 528 + (w + 8 * i) * 16));
    const float ws_ = sc[128 + s];
#pragma unroll
    for (int i = 0; i < 4; ++i) {
        const int g = w + 8 * i, isk = g >> 4, d0 = (g & 15) * 8, cc0 = isk * 512 + h * 128 + d0;
        float y[8];
        { const f32x4 b0 = *(const LAS f32x4*)(CW + 1024 + g * 8), b1 = *(const LAS f32x4*)(CW + 1024 + g * 8 + 4); y[0] = b0[0]; y[1] = b0[1]; y[2] = b0[2]; y[3] = b0[3]; y[4] = b1[0]; y[5] = b1[1]; y[6] = b1[2]; y[7] = b1[3]; }
#pragma unroll
        for (int j = 0; j < 4; ++j) { const f32x4 w0 = *(const LAS f32x4*)(CW + j * 256 + g * 8), w1 = *(const LAS f32x4*)(CW + j * 256 + g * 8 + 4); float x[8]; unpack8(*(const LAS u32x4*)(RAW + (s + j) * 528 + g * 16), x);
            y[0] += w0[0] * x[0]; y[1] += w0[1] * x[1]; y[2] += w0[2] * x[2]; y[3] += w0[3] * x[3]; y[4] += w1[0] * x[4]; y[5] += w1[1] * x[5]; y[6] += w1[2] * x[6]; y[7] += w1[3] * x[7]; }
#pragma unroll
        for (int e = 0; e < 8; ++e) y[e] = siluf_(y[e]) * (isk ? 0.08838834764831845f : 1.0f);
        u32x4 o; o.x = pk2(y[0], y[1]); o.y = pk2(y[2], y[3]); o.z = pk2(y[4], y[5]); o.w = pk2(y[6], y[7]);
        if (!isk) *(GAS u32x4*)(QC + (size_t)(R0 + s) * 512 + h * 128 + d0) = o;
        else { *(GAS u32x4*)(KC + (size_t)(R0 + s) * 512 + h * 128 + d0) = o;
            float kr[8]; unpack8(o, kr);
            u32x4 kw; kw.x = pk2(kr[0] * ws_, kr[1] * ws_); kw.y = pk2(kr[2] * ws_, kr[3] * ws_); kw.z = pk2(kr[4] * ws_, kr[5] * ws_); kw.w = pk2(kr[6] * ws_, kr[7] * ws_);
            put_t8(KWt, d0, s, kw); }
    }
    __syncthreads();
    if (tid < 128) {
        float n = 0.f;
#pragma unroll
        for (int j = 0; j < 8; ++j) { const u32x4 kw = *(const LAS u32x4*)(KWt + tid * 144 + j * 16);
            n += (lo_bf(kw.x) + hi_bf(kw.x)) + (lo_bf(kw.y) + hi_bf(kw.y)) + (lo_bf(kw.z) + hi_bf(kw.z)) + (lo_bf(kw.w) + hi_bf(kw.w)); }
        DN[(size_t)item * 128 + tid] = n;
    }
    {
        bf16x8 vf[2][2];
#pragma unroll
        for (int je = 0; je < 2; ++je)
#pragma unroll
            for (int kk = 0; kk < 2; ++kk) vf[je][kk] = ldfrag(Vt, 16 * (2 * w + je) + l15, 144, (32 * kk + 8 * lg) * 2);
#pragma unroll 2
        for (int dt = 0; dt < 8; ++dt) {
            const bf16x8 k0 = ldfrag(KWt, 16 * dt + l15, 144, (8 * lg) * 2), k1 = ldfrag(KWt, 16 * dt + l15, 144, (32 + 8 * lg) * 2);
#pragma unroll
            for (int je = 0; je < 2; ++je) {
                f32x4 a = {0.f, 0.f, 0.f, 0.f};
                a = MFMA16(k0, vf[je][0], a); a = MFMA16(k1, vf[je][1], a);
                u32x2 o; o.x = pk2(a[0], a[1]); o.y = pk2(a[2], a[3]);
                *(GAS u32x2*)(MST + ((size_t)item * 256 + 16 * (2 * w + je) + l15) * 128 + 16 * dt + 4 * lg) = o;
            }
        }
    }
}

__device__ __forceinline__ void hgrn_state_item(LAS unsigned char* lds, int it, int tid, HaRegs& rg, int nxt, const GAS bf16* HF, const GAS bf16* HI, const GAS float* lbl, GAS bf16* HST, GAS float* DEC) {
    const int lane = tid & 63, w = __builtin_amdgcn_readfirstlane(tid >> 6), l15 = lane & 15, lg = lane >> 4;
    const int b = it >> 9, h = (it >> 6) & 7, c = it & 63, R0 = b * T + c * 64;
    LAS float* Gt = (LAS float*)(lds + 2048);
    LAS unsigned char* KDt = lds + 2048 + 34816;
    LAS unsigned char* Vt = KDt + 18432;
    LAS unsigned char* HR = Vt + 18432;
    LAS unsigned char* FR = HR + 17408;
    const int s = lane;
#pragma unroll
    for (int i = 0; i < 2; ++i) { const int idx = tid + NTHR * i; *(LAS u32x4*)(HR + (idx >> 4) * 272 + (idx & 15) * 16) = rg.hr[i]; *(LAS u32x4*)(FR + (idx >> 4) * 272 + (idx & 15) * 16) = rg.fr[i]; }
    if (nxt < 1024) ha_load(nxt, tid, HF, HI, rg);
    __syncthreads();
    u32x4 hv[2], fv[2];
#pragma unroll
    for (int i = 0; i < 2; ++i) { hv[i] = *(const LAS u32x4*)(HR + s * 272 + (w + 8 * i) * 16); fv[i] = *(const LAS u32x4*)(FR + s * 272 + (w + 8 * i) * 16); }
#pragma unroll
    for (int i = 0; i < 2; ++i) {
        put_t8(Vt, (w + 8 * i) * 8, s, hv[i]);
        const int d0 = (w + 8 * i) * 8, dd = h * 128 + d0; float f[8], kd[8], dl[8]; unpack8(fv[i], f);
#pragma unroll
        for (int e = 0; e < 8; ++e) { const float lbv = ((const LAS float*)(FR + 17408))[dd + e]; const float sg = sigmoidf_(f[e]);
            const float Gs = wave_scan_incl(__logf(lbv + (1.f - lbv) * sg), lane); const float Gl = __shfl(Gs, 63);
            kd[e] = (1.f - lbv) * (1.f - sg) * __expf(Gl - Gs); dl[e] = __expf(Gl); }
        u32x4 o; o.x = pk2(kd[0], kd[1]); o.y = pk2(kd[2], kd[3]); o.z = pk2(kd[4], kd[5]); o.w = pk2(kd[6], kd[7]);
        put_t8(KDt, d0, s, o);
        if (lane == 63) { *(GAS f32x4*)(DEC + (size_t)it * 128 + d0) = (f32x4){dl[0], dl[1], dl[2], dl[3]}; *(GAS f32x4*)(DEC + (size_t)it * 128 + d0 + 4) = (f32x4){dl[4], dl[5], dl[6], dl[7]}; }
    }
    __syncthreads();
    {
        const bf16x8 v0 = ldfrag(Vt, 16 * w + l15, 144, (8 * lg) * 2), v1 = ldfrag(Vt, 16 * w + l15, 144, (32 + 8 * lg) * 2);
#pragma unroll 2
        for (int dt = 0; dt < 8; ++dt) {
            f32x4 a = {0.f, 0.f, 0.f, 0.f};
            a = MFMA16(ldfrag(KDt, 16 * dt + l15, 144, (8 * lg) * 2), v0, a); a = MFMA16(ldfrag(KDt, 16 * dt + l15, 144, (32 + 8 * lg) * 2), v1, a);
            u32x2 o; o.x = pk2(a[0], a[1]); o.y = pk2(a[2], a[3]);
            *(GAS u32x2*)(HST + ((size_t)it * 128 + 16 * w + l15) * 128 + 16 * dt + 4 * lg) = o;
        }
    }
}

struct MoRegs { u32x4 vv[4], qq[2], kq[2], cs[8]; float fl, ip, mprev, npv; };
struct HoRegs { u32x4 hv[2], fv[2], qw[2], cs[4]; };
struct OutPtrs { const GAS float* gates; const GAS float* MPREV; const GAS float* NPREV; const GAS bf16* QC; const GAS bf16* KC; const GAS bf16* MV; const GAS bf16* MST; const GAS bf16* HQ; const GAS bf16* HF; const GAS bf16* HI; const GAS bf16* HST; };
__device__ __forceinline__ void mo_load(int item, int tid, const OutPtrs& P, MoRegs& r) {
    const int lane = tid & 63, w = __builtin_amdgcn_readfirstlane(tid >> 6);
    const int b = item >> 8, h = (item >> 6) & 3, c = item & 63, R0 = b * T + c * 64;
#pragma unroll
    for (int j = 0; j < 8; ++j) { const int q = tid + NTHR * j; r.cs[j] = *(const GAS u32x4*)(P.MST + ((size_t)item * 256 + (q >> 4)) * 128 + (q & 15) * 8); }
#pragma unroll
    for (int i = 0; i < 4; ++i) r.vv[i] = *(const GAS u32x4*)(P.MV + (size_t)(R0 + lane) * 1024 + h * 256 + (w + 8 * i) * 8);
#pragma unroll
    for (int i = 0; i < 2; ++i) { const int idx = tid + NTHR * i, s = idx >> 4, ch = idx & 15;
        r.qq[i] = *(const GAS u32x4*)(P.QC + (size_t)(R0 + s) * 512 + h * 128 + ch * 8); r.kq[i] = *(const GAS u32x4*)(P.KC + (size_t)(R0 + s) * 512 + h * 128 + ch * 8); }
    r.fl = 0.f; r.ip = 0.f; r.mprev = 0.f; r.npv = 0.f;
    if (w == 0) { r.fl = P.gates[(size_t)(R0 + lane) * 8 + 4 + h]; r.ip = P.gates[(size_t)(R0 + lane) * 8 + h]; r.mprev = P.MPREV[item]; }
    if (w == 1 || w == 2) r.npv = P.NPREV[(size_t)item * 128 + (w - 1) * 64 + lane];
}
__device__ __forceinline__ void ho_load(int it, int tid, const OutPtrs& P, HoRegs& r) {
    const int lane = tid & 63, w = __builtin_amdgcn_readfirstlane(tid >> 6), d8 = tid & 15, sr = tid >> 4;
    const int b = it >> 9, h = (it >> 6) & 7, c = it & 63, R0 = b * T + c * 64;
#pragma unroll
    for (int j = 0; j < 4; ++j) { const int q = tid + NTHR * j; r.cs[j] = *(const GAS u32x4*)(P.HST + ((size_t)it * 128 + (q >> 4)) * 128 + (q & 15) * 8); }
#pragma unroll
    for (int i = 0; i < 2; ++i) { r.hv[i] = *(const GAS u32x4*)(P.HI + (size_t)(R0 + lane) * 1024 + h * 128 + (w + 8 * i) * 8);
        r.fv[i] = *(const GAS u32x4*)(P.HF + (size_t)(R0 + sr + 32 * i) * 1024 + h * 128 + d8 * 8); r.qw[i] = *(const GAS u32x4*)(P.HQ + (size_t)(R0 + sr + 32 * i) * 1024 + h * 128 + d8 * 8); }
}
__device__ __forceinline__ void mlstm_out_item(LAS unsigned char* lds, int item, int tid, const OutPtrs& P, MoRegs& rm, int nxt,
                                               const GAS bf16* MO, const GAS float* mhn, GAS bf16* YM) {
    const int lane = tid & 63, w = __builtin_amdgcn_readfirstlane(tid >> 6), l15 = lane & 15, lg = lane >> 4;
    const int b = item >> 8, h = (item >> 6) & 3, c = item & 63, R0 = b * T + c * 64;
    LAS float* sc = (LAS float*)lds;
    LAS unsigned char* Qs = lds + 4096;
    LAS unsigned char* Ks = Qs + 17408;
    LAS unsigned char* Ss = Ks + 17408;
    LAS unsigned char* Vt = Ss + 9216;
    LAS unsigned char* Cs = Vt + 36864;
    const int tt = w & 3, hh = w >> 2, t = 16 * tt + l15;
    {
#pragma unroll
        for (int i = 0; i < 2; ++i) { const int idx = tid + NTHR * i, s = idx >> 4, ch = idx & 15; *(LAS u32x4*)(Qs + s * 272 + ch * 16) = rm.qq[i]; *(LAS u32x4*)(Ks + s * 272 + ch * 16) = rm.kq[i]; }
#pragma unroll
        for (int i = 0; i < 4; ++i) put_t8(Vt, (w + 8 * i) * 8, lane, rm.vv[i]);
#pragma unroll
        for (int j = 0; j < 8; ++j) { const int q = tid + NTHR * j; *(LAS u32x4*)(Cs + (q >> 4) * 272 + (q & 15) * 16) = rm.cs[j]; }
        if (w == 0) {
            const float bs = wave_scan_incl(rm.fl, lane); float pm = rm.ip - bs;
#pragma unroll
            for (int o = 1; o < 64; o <<= 1) { const float u = __shfl_up(pm, o); if (lane >= o) pm = fmaxf(pm, u); }
            const float mt = bs + fmaxf(rm.mprev, pm);
            sc[lane] = bs; sc[64 + lane] = rm.ip; sc[128 + lane] = mt; sc[192 + lane] = __expf(bs + rm.mprev - mt);
        }
        if (w == 1 || w == 2) sc[512 + (w - 1) * 64 + lane] = rm.npv;
        if (nxt < 512) mo_load(nxt, tid, P, rm);
    }
    __syncthreads();
    bf16x8 qf[4];
#pragma unroll
    for (int kk = 0; kk < 4; ++kk) qf[kk] = ldfrag(Qs, t, 272, (32 * kk + 8 * lg) * 2);
    f32x4 a2[8];
#pragma unroll
    for (int et = 0; et < 8; ++et) { f32x4 a = {0.f, 0.f, 0.f, 0.f};
#pragma unroll
        for (int kk = 0; kk < 4; ++kk) a = MFMA16(ldfrag(Cs, 128 * hh + 16 * et + l15, 272, (32 * kk + 8 * lg) * 2), qf[kk], a);
        a2[et] = a; }
    float qn;
    {
        float acc = 0.f;
#pragma unroll
        for (int kk = 0; kk < 4; ++kk) { const f32x4 n0 = *(const LAS f32x4*)(sc + 512 + 32 * kk + 8 * lg), n1 = *(const LAS f32x4*)(sc + 512 + 32 * kk + 8 * lg + 4);
            float q8[8]; unpack8(__builtin_bit_cast(u32x4, qf[kk]), q8);
            acc += (q8[0] * n0[0] + q8[1] * n0[1]) + (q8[2] * n0[2] + q8[3] * n0[3]) + (q8[4] * n1[0] + q8[5] * n1[1]) + (q8[6] * n1[2] + q8[7] * n1[3]); }
        acc += __shfl_xor(acc, 16); acc += __shfl_xor(acc, 32); qn = acc;
    }
    {
        const float bt = sc[t], mt = sc[128 + t]; float rs = 0.f;
#pragma unroll
        for (int j = 0; j < 2; ++j) {
            const int st = 2 * hh + j; f32x4 a = {0.f, 0.f, 0.f, 0.f};
            if (st <= tt) {
#pragma unroll
                for (int kk = 0; kk < 4; ++kk) a = MFMA16(ldfrag(Ks, 16 * st + l15, 272, (32 * kk + 8 * lg) * 2), qf[kk], a);
            }
            float o[4];
#pragma unroll
            for (int r = 0; r < 4; ++r) { const int s = 16 * st + 4 * lg + r; o[r] = (s <= t) ? a[r] * __expf(bt - sc[s] + sc[64 + s] - mt) : 0.f; }
            u32x2 wv; wv.x = pk2(o[0], o[1]); wv.y = pk2(o[2], o[3]);
            *(LAS u32x2*)(Ss + t * 144 + (16 * st + 4 * lg) * 2) = wv;
            rs += (lo_bf(wv.x) + hi_bf(wv.x)) + (lo_bf(wv.y) + hi_bf(wv.y));
        }
        rs += __shfl_xor(rs, 16); rs += __shfl_xor(rs, 32);
        if (lg == 0) sc[256 + 64 * hh + t] = rs;
    }
    u32x2 mo[8];
#pragma unroll
    for (int et = 0; et < 8; ++et) mo[et] = *(const GAS u32x2*)(MO + (size_t)(R0 + t) * 1024 + h * 256 + 128 * hh + 16 * et + 4 * lg);
    __syncthreads();
    {
        const bf16x8 s0 = ldfrag(Ss, t, 144, (8 * lg) * 2), s1 = ldfrag(Ss, t, 144, (32 + 8 * lg) * 2);
        const float wi = sc[192 + t];
        const float den = (sc[256 + t] + sc[320 + t]) + wi * qn; const float dinv = 1.0f / fmaxf(fabsf(den), __expf(-sc[128 + t]));
        float q2 = 0.f;
#pragma unroll
        for (int et = 0; et < 8; ++et) {
            const int e0 = 128 * hh + 16 * et; f32x4 a1 = {0.f, 0.f, 0.f, 0.f};
            a1 = MFMA16(ldfrag(Vt, e0 + l15, 144, (8 * lg) * 2), s0, a1); a1 = MFMA16(ldfrag(Vt, e0 + l15, 144, (32 + 8 * lg) * 2), s1, a1);
#pragma unroll
            for (int r = 0; r < 4; ++r) { const float hv = (a1[r] + wi * a2[et][r]) * dinv; a2[et][r] = hv; q2 += hv * hv; }
        }
        q2 += __shfl_xor(q2, 16); q2 += __shfl_xor(q2, 32);
        if (lg == 0) sc[384 + 64 * hh + t] = q2;
        __syncthreads();
        const float rn = rsqrtf((sc[384 + t] + sc[448 + t]) * (1.0f / 256.0f) + EPS);
#pragma unroll
        for (int et = 0; et < 8; ++et) {
            const int e = 128 * hh + 16 * et + 4 * lg; const f32x4 g4 = *(const LAS f32x4*)(Cs + 69632 + e * 4);
            u32x2 o; o.x = pk2(a2[et][0] * rn * g4[0] * lo_bf(mo[et].x), a2[et][1] * rn * g4[1] * hi_bf(mo[et].x)); o.y = pk2(a2[et][2] * rn * g4[2] * lo_bf(mo[et].y), a2[et][3] * rn * g4[3] * hi_bf(mo[et].y));
            *(GAS u32x2*)(YM + (size_t)(R0 + t) * 1024 + h * 256 + e) = o;
        }
    }
    __syncthreads();
}

__device__ __forceinline__ void hgrn_out_item(LAS unsigned char* lds, int it, int tid, const OutPtrs& P, HoRegs& rh, int nxt, const GAS bf16* HG, const GAS float* lbl, const GAS float* hhn, GAS bf16* YH) {
    const int lane = tid & 63, w = __builtin_amdgcn_readfirstlane(tid >> 6), l15 = lane & 15, lg = lane >> 4;
    const int b = it >> 9, h = (it >> 6) & 7, c = it & 63, R0 = b * T + c * 64;
    LAS float* sc = (LAS float*)lds;
    LAS float* Gs = (LAS float*)(lds + 4096);
    LAS unsigned char* Qt = lds + 4096 + 32768;
    LAS unsigned char* Kt = Qt + 17408;
    LAS unsigned char* Qe = Kt + 17408;
    LAS unsigned char* As = Qe + 17408;
    LAS unsigned char* Vt = As + 9216;
    LAS unsigned char* Cs = Vt + 18432;
    const int d8 = tid & 15, sr = tid >> 4;
    const int tt = w & 3, hh = w >> 2, t = 16 * tt + l15;
    float qv[2][8], kv[2][8];
    {
#pragma unroll
        for (int j = 0; j < 4; ++j) { const int q = tid + NTHR * j; *(LAS u32x4*)(Cs + (q >> 4) * 272 + (q & 15) * 16) = rh.cs[j]; }
        float lbv[8];
        { const LAS float* LBV = (const LAS float*)(Cs + 34816); const int dd = h * 128 + d8 * 8; const f32x4 a0 = *(const LAS f32x4*)(LBV + dd), a1 = *(const LAS f32x4*)(LBV + dd + 4);
#pragma unroll
          for (int e = 0; e < 4; ++e) { lbv[e] = a0[e]; lbv[4 + e] = a1[e]; } }
#pragma unroll
        for (int i = 0; i < 2; ++i) {
            put_t8(Vt, (w + 8 * i) * 8, lane, rh.hv[i]);
            float f[8]; unpack8(rh.fv[i], f); unpack8(rh.qw[i], qv[i]); f32x4 g0, g1;
#pragma unroll
            for (int e = 0; e < 8; ++e) { const float sg = sigmoidf_(f[e]); const float g = __logf(lbv[e] + (1.f - lbv[e]) * sg); kv[i][e] = (1.f - lbv[e]) * (1.f - sg); if (e < 4) g0[e] = g; else g1[e - 4] = g; }
            *(LAS f32x4*)(Gs + (sr + 32 * i) * 128 + d8 * 8) = g0; *(LAS f32x4*)(Gs + (sr + 32 * i) * 128 + d8 * 8 + 4) = g1;
        }
    }
    u32x2 hg[4];
#pragma unroll
    for (int et = 0; et < 4; ++et) hg[et] = *(const GAS u32x2*)(HG + (size_t)(R0 + t) * 1024 + h * 128 + 64 * hh + 16 * et + 4 * lg);
    if (nxt < 512 + 1024) ho_load(nxt - 512, tid, P, rh);
    __syncthreads();
    {
        const int d = tid & 127, seg = tid >> 7; float g[16]; float Gc = 0.f;
#pragma unroll
        for (int j = 0; j < 16; ++j) g[j] = Gs[(16 * seg + j) * 128 + d];
#pragma unroll
        for (int j = 0; j < 16; ++j) { Gc += g[j]; Gs[(16 * seg + j) * 128 + d] = Gc; }
        sc[128 + seg * 128 + d] = Gc;
    }
    __syncthreads();
    {
        float t0[8], t1[8], t2[8], gm[8];
        { const f32x4 a0 = *(const LAS f32x4*)(sc + 128 + d8 * 8), a1 = *(const LAS f32x4*)(sc + 128 + d8 * 8 + 4), b0 = *(const LAS f32x4*)(sc + 256 + d8 * 8), b1 = *(const LAS f32x4*)(sc + 256 + d8 * 8 + 4),
                      c0 = *(const LAS f32x4*)(sc + 384 + d8 * 8), c1 = *(const LAS f32x4*)(sc + 384 + d8 * 8 + 4), m0 = *(const LAS f32x4*)(Gs + 31 * 128 + d8 * 8), m1 = *(const LAS f32x4*)(Gs + 31 * 128 + d8 * 8 + 4);
#pragma unroll
          for (int e = 0; e < 4; ++e) { t0[e] = a0[e]; t0[4 + e] = a1[e]; t1[e] = b0[e]; t1[4 + e] = b1[e]; t2[e] = c0[e]; t2[4 + e] = c1[e]; gm[e] = m0[e] + a0[e]; gm[4 + e] = m1[e] + a1[e]; } }
#pragma unroll
        for (int i = 0; i < 2; ++i) { const int s = sr + 32 * i, seg = s >> 4;
            const f32x4 g0 = *(const LAS f32x4*)(Gs + s * 128 + d8 * 8), g1 = *(const LAS f32x4*)(Gs + s * 128 + d8 * 8 + 4);
            float g[8] = {g0[0], g0[1], g0[2], g0[3], g1[0], g1[1], g1[2], g1[3]};
            float a[8], bq[8], cq[8];
#pragma unroll
            for (int e = 0; e < 8; ++e) { g[e] += (seg > 0 ? t0[e] : 0.f) + (seg > 1 ? t1[e] : 0.f) + (seg > 2 ? t2[e] : 0.f);
                a[e] = qv[i][e] * __expf(g[e] - gm[e]); bq[e] = kv[i][e] * __expf(gm[e] - g[e]); cq[e] = qv[i][e] * __expf(g[e]); }
            u32x4 o; o.x = pk2(a[0], a[1]); o.y = pk2(a[2], a[3]); o.z = pk2(a[4], a[5]); o.w = pk2(a[6], a[7]); *(LAS u32x4*)(Qt + s * 272 + d8 * 16) = o;
            o.x = pk2(bq[0], bq[1]); o.y = pk2(bq[2], bq[3]); o.z = pk2(bq[4], bq[5]); o.w = pk2(bq[6], bq[7]); *(LAS u32x4*)(Kt + s * 272 + d8 * 16) = o;
            o.x = pk2(cq[0], cq[1]); o.y = pk2(cq[2], cq[3]); o.z = pk2(cq[4], cq[5]); o.w = pk2(cq[6], cq[7]); *(LAS u32x4*)(Qe + s * 272 + d8 * 16) = o; }
    }
    __syncthreads();
    {
        bf16x8 qf[4];
#pragma unroll
        for (int kk = 0; kk < 4; ++kk) qf[kk] = ldfrag(Qt, t, 272, (32 * kk + 8 * lg) * 2);
#pragma unroll
        for (int j = 0; j < 2; ++j) {
            const int st = 2 * hh + j; f32x4 a = {0.f, 0.f, 0.f, 0.f};
            if (st <= tt) {
#pragma unroll
                for (int kk = 0; kk < 4; ++kk) a = MFMA16(ldfrag(Kt, 16 * st + l15, 272, (32 * kk + 8 * lg) * 2), qf[kk], a);
            }
            float o[4];
#pragma unroll
            for (int r = 0; r < 4; ++r) { const int s = 16 * st + 4 * lg + r; o[r] = (s <= t) ? a[r] : 0.f; }
            u32x2 wv; wv.x = pk2(o[0], o[1]); wv.y = pk2(o[2], o[3]);
            *(LAS u32x2*)(As + t * 144 + (16 * st + 4 * lg) * 2) = wv;
        }
    }
    f32x4 oacc[4];
    {
        bf16x8 qe[4];
#pragma unroll
        for (int kk = 0; kk < 4; ++kk) qe[kk] = ldfrag(Qe, t, 272, (32 * kk + 8 * lg) * 2);
#pragma unroll
        for (int et = 0; et < 4; ++et) { f32x4 a = {0.f, 0.f, 0.f, 0.f};
#pragma unroll
            for (int kk = 0; kk < 4; ++kk) a = MFMA16(ldfrag(Cs, 64 * hh + 16 * et + l15, 272, (32 * kk + 8 * lg) * 2), qe[kk], a);
            oacc[et] = a; }
    }
    __syncthreads();
    {
        const bf16x8 a0 = ldfrag(As, t, 144, (8 * lg) * 2), a1 = ldfrag(As, t, 144, (32 + 8 * lg) * 2);
        float q2 = 0.f;
#pragma unroll
        for (int et = 0; et < 4; ++et) {
            const int e0 = 64 * hh + 16 * et; f32x4 a = oacc[et];
            a = MFMA16(ldfrag(Vt, e0 + l15, 144, (8 * lg) * 2), a0, a); a = MFMA16(ldfrag(Vt, e0 + l15, 144, (32 + 8 * lg) * 2), a1, a);
            oacc[et] = a; q2 += (a[0] * a[0] + a[1] * a[1]) + (a[2] * a[2] + a[3] * a[3]);
        }
        q2 += __shfl_xor(q2, 16); q2 += __shfl_xor(q2, 32);
        if (lg == 0) sc[64 * hh + t] = q2;
        __syncthreads();
        const float rn = rsqrtf((sc[t] + sc[64 + t]) * (1.0f / 128.0f) + EPS);
#pragma unroll
        for (int et = 0; et < 4; ++et) {
            const int e = 64 * hh + 16 * et + 4 * lg; const f32x4 g4 = *(const LAS f32x4*)(Cs + 34816 + 4096 + (h * 128 + e) * 4);
            u32x2 o; o.x = pk2(oacc[et][0] * rn * g4[0] * lo_bf(hg[et].x), oacc[et][1] * rn * g4[1] * hi_bf(hg[et].x)); o.y = pk2(oacc[et][2] * rn * g4[2] * lo_bf(hg[et].y), oacc[et][3] * rn * g4[3] * hi_bf(hg[et].y));
            *(GAS u32x2*)(YH + (size_t)(R0 + t) * 1024 + h * 128 + e) = o;
        }
    }
    __syncthreads();
}

typedef const volatile unsigned long long __attribute__((address_space(4)))* KArgs;
#define KINP(i) ((const float*)kargs[(i)])
constexpr int I0 = N_FFN_ITEMS, I1 = I0 + 7424, I2 = I1 + 4096, I3 = I2 + 1024, I4 = I3 + 1024, I5 = I4 + 2048, I6 = I5 + 4096, I7 = I6 + 2048;
__device__ __forceinline__ CvtDesc w_desc(KArgs kargs, unsigned char* ws, int it) {
    if (it < I0) return ffn_desc(it, KINP(I_F1W1), KINP(I_F1W3), KINP(I_F1W2), KINP(I_NFFN1), (bf16*)(ws + WS_W13), (bf16*)(ws + WS_W2T));
    if (it < I1) { const int r = it - I0, nb = r % 232, kb = r / 232;
        const int col0 = nb < 96 ? nb * 32 : (nb < 224 ? nb * 32 + 8 : 3072); const int nv = nb < 224 ? 32 : (nb == 224 ? 8 : 0);
        return mk_desc(KINP(I_WIN), DIN, col0, nv, kb * 64, KINP(I_NMIX), (bf16*)(ws + WS_WIN) + (size_t)nb * 32 * D, D); }
    if (it < I2) { const int r = it - I1, nb = r % 128, kb = r / 128; return mk_desc(KINP(I_WIN), DIN, 7176 + nb * 32, 32, kb * 64, KINP(I_NMIX), (bf16*)(ws + WS_WG) + (size_t)nb * 32 * D, D); }
    if (it < I3) { const int r = it - I2, nb = r % 64, kb = r / 64; return mk_desc(KINP(I_WPM), D, nb * 32, 32, kb * 64, nullptr, (bf16*)(ws + WS_WPM) + (size_t)nb * 32 * 1024, 1024); }
    if (it < I4) { const int r = it - I3, nb = r % 64, kb = r / 64; return mk_desc(KINP(I_WPH), D, nb * 32, 32, kb * 64, nullptr, (bf16*)(ws + WS_WPH) + (size_t)nb * 32 * 1024, 1024); }
    if (it < I5) { const int r = it - I4, nb = r % 64, kb = r / 64; return mk_desc(KINP(I_WOUT), D, nb * 32, 32, kb * 64, nullptr, (bf16*)(ws + WS_WOUT) + (size_t)nb * 32 * D, D); }
    if (it < I6) { const int r = it - I5, nb = r % 128, kb = r / 128; return mk_desc(KINP(I_WKV), 2 * D, nb * 32, 32, kb * 64, nullptr, (bf16*)(ws + WS_WKV) + (size_t)nb * 32 * D, D); }
    { const int r = it - I6, nb = r % 64, kb = r / 64; return mk_desc(KINP(I_WO), D, nb * 32, 32, kb * 64, nullptr, (bf16*)(ws + WS_WO) + (size_t)nb * 32 * D, D); }
}
constexpr int WIN_P0 = 3712;
template <bool EARLY>
__device__ __forceinline__ void copy_items(KArgs kargs, unsigned char* ws, int first, int count, int cw, int ncw) {
    int ln = threadIdx.x & 63; asm volatile("" : "+v"(ln));
#pragma unroll 1
    for (int base = cw; base < count; base += 4 * ncw) {
        CvtDesc d[4]; f32x4 v[4][8];
#pragma unroll
        for (int u = 0; u < 4; ++u) { const int j = base + u * ncw; if (j < count) { d[u] = w_desc(kargs, ws, EARLY ? (j < 11264 ? j : (j < 11264 + WIN_P0 ? (I1 - WIN_P0) + (j - 11264) : I4 + (j - 11264 - WIN_P0))) : first + j); cvt_load(d[u], ln, v[u]); } }
#pragma unroll
        for (int u = 0; u < 4; ++u) { const int j = base + u * ncw; if (j < count) cvt_store(d[u], ln, v[u]); }
    }
}
__device__ __forceinline__ void wq_row(KArgs kargs, unsigned char* ws, int d, int lane) {
    const float g = KINP(I_NX)[d]; const f32x4* src = (const f32x4*)(KINP(I_WQ) + (size_t)d * D) + lane; bf16* dst = (bf16*)(ws + WS_WQ) + (size_t)d * D;
    f32x4 v[8];
#pragma unroll
    for (int j = 0; j < 8; ++j) v[j] = __builtin_nontemporal_load(src + 64 * j);
#pragma unroll
    for (int j = 0; j < 8; ++j) { const f32x4 o = v[j] * g; u32x2 w; w.x = pk2(o[0], o[1]); w.y = pk2(o[2], o[3]); *(GAS u32x2*)(dst + 256 * j + 4 * lane) = w; }
}

__global__ void __launch_bounds__(NTHR, 2) fwd_kernel(Args args) {
    extern __shared__ __attribute__((aligned(16))) unsigned char lds_raw[];
    LAS unsigned char* lds = (LAS unsigned char*)lds_raw;
    volatile LAS unsigned* MISC = (volatile LAS unsigned*)(lds + MISC_OFF);
    const int tid = threadIdx.x, lane = tid & 63, wave = __builtin_amdgcn_readfirstlane(tid >> 6);
    const int G = gridDim.x, bid = blockIdx.x;
    KArgs kargs = (KArgs)__builtin_amdgcn_kernarg_segment_ptr();
#define INP(i) ((const float*)kargs[(i)])
    unsigned char* ws = (unsigned char*)kargs[29];
    unsigned* ctl = (unsigned*)(ws + WS_CTL);
    if (tid < 64) MISC[tid] = 0u;
    __syncthreads();
    XcdBarrier bar = xcd_barrier_post(ctl + CW_BAR, MISC + 8);
    u64* ss = (u64*)(ws + WS_CTL + CTL_SS);
    const int gw = bid * NWAVES + wave, NGW = G * NWAVES;
    float* X = (float*)(ws + WS_X); bf16* XB = (bf16*)(ws + WS_XB);
    float* smallf = (float*)(ws + WS_SMALL);

    const bool split = (G == 256);
    constexpr int NEARLY = 11264 + WIN_P0 + (I7 - I4), NMID = (I1 - WIN_P0) - 11264, NLATE = I4 - I1;

    for (int rep_ = 0; rep_ < NREP(0); ++rep_) if (rep_ == 0 || (xcd_barrier(bar), true))
    {
        if (split) copy_items<true>(kargs, ws, 0, NEARLY, gw, NGW); else copy_items<false>(kargs, ws, 0, I7, gw, NGW);
#pragma unroll 1
        for (int d = gw; d < D; d += NGW) wq_row(kargs, ws, d, lane);
#pragma unroll 1
        for (int it = gw; it < 8192 + 512; it += NGW) {
            if (it < 8192) { const int row = it;
                const f32x4* src = (const f32x4*)(INP(I_X) + (size_t)row * D) + lane; bf16* dst = XB + (size_t)row * D; float s = 0.f;
                f32x4 v[8];
#pragma unroll
                for (int j = 0; j < 8; ++j) v[j] = __builtin_nontemporal_load(src + 64 * j);
#pragma unroll
                for (int j = 0; j < 8; ++j) { s += (v[j][0] * v[j][0] + v[j][1] * v[j][1]) + (v[j][2] * v[j][2] + v[j][3] * v[j][3]); u32x2 w; w.x = pk2(v[j][0], v[j][1]); w.y = pk2(v[j][2], v[j][3]); *(u32x2*)(dst + 256 * j + 4 * lane) = w; }
                s = wave_sum(s); if (lane == 0) ss[row] = (u64)(s * SS_SCALE); }
            else { const int row = it - 8192;
                const f32x4* src = (const f32x4*)(INP(I_MEM) + (size_t)row * D) + lane; const f32x4* gp = (const f32x4*)INP(I_NMEM) + lane; bf16* dst = (bf16*)(ws + WS_MEMN) + (size_t)row * D;
                f32x4 v[8]; float s = 0.f;
#pragma unroll
                for (int j = 0; j < 8; ++j) { v[j] = __builtin_nontemporal_load(src + 64 * j); s += (v[j][0] * v[j][0] + v[j][1] * v[j][1]) + (v[j][2] * v[j][2] + v[j][3] * v[j][3]); }
                const float r = rsqrtf(wave_sum(s) * (1.0f / D) + EPS);
#pragma unroll
                for (int j = 0; j < 8; ++j) { const f32x4 o = v[j] * r * gp[64 * j]; u32x2 w; w.x = pk2(o[0], o[1]); w.y = pk2(o[2], o[3]); *(u32x2*)(dst + 256 * j + 4 * lane) = w; } }
        }
    }
    xcd_barrier(bar);

    const bool LOCF = (MISC[11] != 0u);
    const int lrf = (int)MISC[10], xf = (int)bar.x;
    unsigned* rdyMID = ctl + 12416; unsigned* rdyKV = ctl + 12480;
#define FRONT_BARRIER() do { if (LOCF) xcd_local_barrier(bar, lrf & 3, ctl + 13312); else xcd_barrier(bar); } while (0)
    for (int rep_ = 0; rep_ < NREP(1); ++rep_) if (rep_ == 0 || (xcd_barrier(bar), true))
    { SchedUpKv S; S.o.init(32, 44, G, bid); S.G = G; S.c = bid; S.XBp = (const char*)XB; S.W13p = (const char*)(ws + WS_W13); S.MEMNp = (const char*)(ws + WS_MEMN); S.WKVp = (const char*)(ws + WS_WKV);
      S.loc = 0; S.p0 = 0; S.xq = 0; if (LOCF) { S.loc = 1; S.p0 = 4 * xf; S.xq = xf; S.c = lrf; }
      EpiUpKv E{EpiUp{(bf16*)(ws + AR_ACT), ss + 0 * M}, (bf16*)(ws + WS_KV)};
      pg8::gemm_phase((const char*)ws, lds, D, D, S, E);
      if (LOCF) {
          if (lrf >= 16 && lrf < 20) publish_count(rdyKV);
          if (lrf >= 20) { copy_items<false>(kargs, ws, 11264, NMID, (xf * 12 + lrf - 20) * NWAVES + wave, 96 * NWAVES); publish_count(rdyMID); }
      } else if (split && bid >= 160) copy_items<false>(kargs, ws, 11264, NMID, (bid - 160) * NWAVES + wave, 96 * NWAVES); }
    FRONT_BARRIER();
    if (LOCF) await_count(rdyMID, 96u, bar.bar);
    for (int rep_ = 0; rep_ < NREP(2); ++rep_) if (rep_ == 0 || (xcd_barrier(bar), true))
    { SchedStd S; S.o.init(32, 8, G, bid); if (LOCF) S.o.init_loc(8, 4 * xf, lrf);
      S.A = (const char*)(ws + AR_ACT); S.B = (const char*)(ws + WS_W2T); S.astep = (size_t)256 * FF * 2; S.bstep = (size_t)256 * FF * 2; S.bbatch = 0; S.nt = FF / 64;
      EpiRes<true> E{INP(I_X), XB, ss + 1 * M, 0.5f};
      pg8::gemm_phase((const char*)ws, lds, FF, FF, S, E); }
    FRONT_BARRIER();
    if (LOCF) await_count(rdyKV, 32u, bar.bar);
    for (int rep_ = 0; rep_ < NREP(3); ++rep_) if (rep_ == 0 || (xcd_barrier(bar), true))
    { SchedInW S; S.o.init(32, 29, G, bid); S.G = G; S.c = bid; S.XBp = (const char*)XB; S.WINp = (const char*)(ws + WS_WIN); S.Kp = (const char*)(ws + WS_KV); S.Vp = (const char*)(ws + WS_KV) + (size_t)512 * D * 2;
      S.WQp = (const char*)(ws + WS_WQ); S.WOp = (const char*)(ws + WS_WO);
      S.loc = 0; S.p0 = 0; S.xq = 0; if (LOCF) { S.loc = 1; S.p0 = 4 * xf; S.xq = xf; S.c = lrf; }
      EpiInW E{EpiInproj{ws, ss + 1 * M, INP(I_IGB), INP(I_FGB)}, (bf16*)(ws + WS_WQKT), (bf16*)(ws + WS_VWOT)};
      pg8::gemm_phase((const char*)ws, lds, D, D, S, E);
      if (LOCF) { if (lrf >= 24) copy_items<false>(kargs, ws, I1, NLATE, (xf * 8 + lrf - 24) * NWAVES + wave, 64 * NWAVES); }
      else if (split && bid >= 192) copy_items<false>(kargs, ws, I1, NLATE, (bid - 192) * NWAVES + wave, 64 * NWAVES); }
    xcd_barrier(bar);

    const bool LOCM = (MISC[11] != 0u);
    const int lrk = (int)MISC[10], xq = (int)bar.x;
    const int ms = LOCM ? 32 : G;
    const int m0 = LOCM ? xq * 64 + lrk : bid, m1 = LOCM ? xq * 64 + 64 : 512;
    const int h0 = LOCM ? xq * 128 + lrk : (bid + G - 512 % G) % G, h1 = LOCM ? xq * 128 + 128 : 1024;
#define MIX_BARRIER() do { if (LOCM) xcd_local_barrier(bar); else xcd_barrier(bar); } while (0)
    for (int rep_ = 0; rep_ < NREP(7); ++rep_) if (rep_ == 0 || (xcd_barrier(bar), true))
    {
        const GAS float* convw = (const GAS float*)INP(I_CONVW); const GAS float* convb = (const GAS float*)INP(I_CONVB); const GAS float* lbl = (const GAS float*)INP(I_LBL);
        const GAS float* gates = (const GAS float*)(smallf + SM_GATES / 4);
        GAS float* BLAST = (GAS float*)(smallf + SM_BLAST / 4); GAS float* MLOC = (GAS float*)(smallf + SM_MLOC / 4); GAS float* DN = (GAS float*)(smallf + SM_DN / 4); GAS float* DEC = (GAS float*)(smallf + SM_DEC / 4);
        int tid7 = threadIdx.x; asm volatile("" : "+v"(tid7));
        {   MaRegs rm; const GAS bf16* QKRAW = (const GAS bf16*)(ws + AR_QKRAW); const GAS bf16* MV = (const GAS bf16*)(ws + AR_MV);
            if (m0 < m1) { mlstm_stage_convw(lds, (m0 >> 6) & 3, tid7, convw, convb); ma_load(m0, tid7, gates, QKRAW, MV, rm); }
#pragma unroll 1
            for (int item = m0; item < m1; item += ms)
                mlstm_state_item(lds, item, tid7, rm, (item + ms < m1) ? item + ms : (1 << 20), gates, convw, convb, QKRAW, (GAS bf16*)(ws + AR_QC), (GAS bf16*)(ws + AR_KC), MV, (GAS bf16*)(ws + AR_MST), DN, BLAST, MLOC);
        }
        __syncthreads();
        {   HaRegs rh;
            const GAS bf16* HF = (const GAS bf16*)(ws + AR_HF); const GAS bf16* HI = (const GAS bf16*)(ws + AR_HI);
            if (h0 < h1) { LAS float* LBV = (LAS float*)(lds + 2048 + 34816 + 18432 + 18432 + 17408 * 2);
                LBV[tid7] = sigmoidf_(lbl[1024 + tid7] - lbl[tid7]); LBV[512 + tid7] = sigmoidf_(lbl[1536 + tid7] - lbl[512 + tid7]);
                ha_load(h0, tid7, HF, HI, rh); }
#pragma unroll 1
            for (int it = h0; it < h1; it += ms)
                hgrn_state_item(lds, it, tid7, rh, (it + ms < h1) ? it + ms : (1 << 20), HF, HI, lbl, (GAS bf16*)(ws + AR_HST), DEC);
        }
    }
    MIX_BARRIER();

    for (int rep_ = 0; rep_ < NREP(8); ++rep_) if (rep_ == 0 || (xcd_barrier(bar), true))
    {
        const float* BLAST = smallf + SM_BLAST / 4; const float* MLOC = smallf + SM_MLOC / 4; float* MPREV = smallf + SM_MPREV / 4; float* DN = smallf + SM_DN / 4; const float* DEC = smallf + SM_DEC / 4;
        bf16* MST = (bf16*)(ws + AR_MST); bf16* HST = (bf16*)(ws + AR_HST);
        const int q8 = LOCM ? (lrk < 16 ? (xq << 13) + lrk * NTHR + tid : 65536 + ((2 * xq + ((lrk - 16) >> 3)) << 12) + ((lrk - 16) & 7) * NTHR + tid) : bid * NTHR + tid;
        const int q8s = LOCM ? (1 << 24) : G * NTHR;
#pragma unroll 1
        for (int q = q8; q < 131072; q += q8s) {
            if (q < 65536) {
                const int bh = q >> 13, qi = q & 8191; float m = 0.f; f32x4 C = {0.f, 0.f, 0.f, 0.f};
#define P8_LDM(c0, dw, bl, ml) _Pragma("unroll") for (int j = 0; j < 8; ++j) { const int item = bh * 64 + (c0) + j; dw[j] = *(const u32x2*)(MST + (size_t)item * 32768 + qi * 4); bl[j] = BLAST[item]; ml[j] = MLOC[item]; }
#define P8_PRM(c0, dw, bl, ml) _Pragma("unroll") for (int j = 0; j < 8; ++j) { \
                        const int item = bh * 64 + (c0) + j; u32x2 cw; cw.x = pk2(C[0], C[1]); cw.y = pk2(C[2], C[3]); *(u32x2*)(MST + (size_t)item * 32768 + qi * 4) = cw; \
                        if (qi == 0) MPREV[item] = m; \
                        const float mn = fmaxf(bl[j] + m, ml[j]), dec = __expf(bl[j] + m - mn), wl = __expf(ml[j] - mn); \
                        C[0] = dec * C[0] + wl * lo_bf(dw[j].x); C[1] = dec * C[1] + wl * hi_bf(dw[j].x); C[2] = dec * C[2] + wl * lo_bf(dw[j].y); C[3] = dec * C[3] + wl * hi_bf(dw[j].y); m = mn; }
                u32x2 dwA[8], dwB[8]; float blA[8], mlA[8], blB[8], mlB[8];
                P8_LDM(0, dwA, blA, mlA); P8_LDM(8, dwB, blB, mlB);
                P8_PRM(0, dwA, blA, mlA); P8_LDM(16, dwA, blA, mlA); P8_PRM(8, dwB, blB, mlB); P8_LDM(24, dwB, blB, mlB); P8_PRM(16, dwA, blA, mlA); P8_LDM(32, dwA, blA, mlA); P8_PRM(24, dwB, blB, mlB); P8_LDM(40, dwB, blB, mlB);
                P8_PRM(32, dwA, blA, mlA); P8_LDM(48, dwA, blA, mlA); P8_PRM(40, dwB, blB, mlB); P8_LDM(56, dwB, blB, mlB); P8_PRM(48, dwA, blA, mlA); P8_PRM(56, dwB, blB, mlB);
#undef P8_LDM
#undef P8_PRM
            } else {
                const int q2 = q - 65536, bh = q2 >> 12, qi = q2 & 4095, d = (qi * 4) & 127; f32x4 Sx = {0.f, 0.f, 0.f, 0.f};
#define P8_LDH(c0, dw, dc) _Pragma("unroll") for (int j = 0; j < 8; ++j) { const int it = bh * 64 + (c0) + j; dw[j] = *(const u32x2*)(HST + (size_t)it * 16384 + qi * 4); dc[j] = *(const f32x4*)(DEC + (size_t)it * 128 + d); }
#define P8_PRH(c0, dw, dc) _Pragma("unroll") for (int j = 0; j < 8; ++j) { \
                        const int it = bh * 64 + (c0) + j; u32x2 cw; cw.x = pk2(Sx[0], Sx[1]); cw.y = pk2(Sx[2], Sx[3]); *(u32x2*)(HST + (size_t)it * 16384 + qi * 4) = cw; \
                        Sx[0] = dc[j][0] * Sx[0] + lo_bf(dw[j].x); Sx[1] = dc[j][1] * Sx[1] + hi_bf(dw[j].x); Sx[2] = dc[j][2] * Sx[2] + lo_bf(dw[j].y); Sx[3] = dc[j][3] * Sx[3] + hi_bf(dw[j].y); }
                u32x2 dwA[8], dwB[8]; f32x4 dcA[8], dcB[8];
                P8_LDH(0, dwA, dcA); P8_LDH(8, dwB, dcB);
                P8_PRH(0, dwA, dcA); P8_LDH(16, dwA, dcA); P8_PRH(8, dwB, dcB); P8_LDH(24, dwB, dcB); P8_PRH(16, dwA, dcA); P8_LDH(32, dwA, dcA); P8_PRH(24, dwB, dcB); P8_LDH(40, dwB, dcB);
                P8_PRH(32, dwA, dcA); P8_LDH(48, dwA, dcA); P8_PRH(40, dwB, dcB); P8_LDH(56, dwB, dcB); P8_PRH(48, dwA, dcA); P8_PRH(56, dwB, dcB);
#undef P8_LDH
#undef P8_PRH
            }
        }
#pragma unroll 1
        for (int q = LOCM ? ((lrk == 0 && tid < 128) ? xq * 128 + tid : 1024) : bid * NTHR + tid; q < 1024; q += q8s) {
            const int bh = q >> 7, d = q & 127; float m = 0.f, n = 0.f;
#pragma unroll 1
            for (int c0 = 0; c0 < 64; c0 += 16) {
                float dn[16], bl[16], ml[16];
#pragma unroll
                for (int j = 0; j < 16; ++j) { const int item = bh * 64 + c0 + j; dn[j] = DN[(size_t)item * 128 + d]; bl[j] = BLAST[item]; ml[j] = MLOC[item]; }
#pragma unroll
                for (int j = 0; j < 16; ++j) { const int item = bh * 64 + c0 + j; DN[(size_t)item * 128 + d] = n;
                    const float mn = fmaxf(bl[j] + m, ml[j]), dec = __expf(bl[j] + m - mn), wl = __expf(ml[j] - mn); n = dec * n + wl * dn[j]; m = mn; }
            }
        }
    }
    MIX_BARRIER();
    for (int rep_ = 0; rep_ < NREP(9); ++rep_) if (rep_ == 0 || (xcd_barrier(bar), true))
    {
        const GAS float* lbl = (const GAS float*)INP(I_LBL); const GAS float* mhn = (const GAS float*)INP(I_MHN); const GAS float* hhn = (const GAS float*)INP(I_HHN);
        const GAS float* gates = (const GAS float*)(smallf + SM_GATES / 4); const GAS float* MPREV = (const GAS float*)(smallf + SM_MPREV / 4); const GAS float* NPREV = (const GAS float*)(smallf + SM_DN / 4);
        int tid9 = threadIdx.x; asm volatile("" : "+v"(tid9));
        const OutPtrs OP{gates, MPREV, NPREV, (const GAS bf16*)(ws + AR_QC), (const GAS bf16*)(ws + AR_KC), (const GAS bf16*)(ws + AR_MV), (const GAS bf16*)(ws + AR_MST),
                         (const GAS bf16*)(ws + AR_HQ), (const GAS bf16*)(ws + AR_HF), (const GAS bf16*)(ws + AR_HI), (const GAS bf16*)(ws + AR_HST)};
        {   MoRegs rm;
            if (m0 < m1) { if (tid9 < 64) *(LAS f32x4*)(lds + 4096 + 17408 * 2 + 9216 + 36864 + 69632 + tid9 * 16) = *(const GAS f32x4*)(mhn + ((m0 >> 6) & 3) * 256 + tid9 * 4);
                             mo_load(m0, tid9, OP, rm); }
#pragma unroll 1
            for (int item = m0; item < m1; item += ms)
                mlstm_out_item(lds, item, tid9, OP, rm, (item + ms < m1) ? item + ms : (1 << 20), (const GAS bf16*)(ws + AR_MO), mhn, (GAS bf16*)(ws + AR_YM));
        }
        {   HoRegs rh; const int first = 512 + h0;
            if (h0 < h1) {
                LAS float* LBV = (LAS float*)(lds + 4096 + 32768 + 17408 * 3 + 9216 + 18432 + 34816);
                LBV[tid9] = sigmoidf_(lbl[1024 + tid9] - lbl[tid9]); LBV[512 + tid9] = sigmoidf_(lbl[1536 + tid9] - lbl[512 + tid9]);
                LBV[1024 + tid9] = hhn[tid9]; LBV[1536 + tid9] = hhn[512 + tid9];
                __syncthreads();
                ho_load(first - 512, tid9, OP, rh); }
#pragma unroll 1
            for (int item = first; item < 512 + h1; item += ms)
                hgrn_out_item(lds, item - 512, tid9, OP, rh, (item + ms < 512 + h1) ? item + ms : (1 << 20), (const GAS bf16*)(ws + AR_HG), lbl, hhn, (GAS bf16*)(ws + AR_YH));
        }
    }

    for (int rep_ = 0; rep_ < NREP(10); ++rep_) if (rep_ == 0 || (xcd_barrier(bar), true))
    { SchedStd S; S.o.init(32, 16, G, bid); if (LOCM) S.o.init_loc(16, 4 * xq, lrk);
      S.A = (const char*)XB; S.B = (const char*)(ws + WS_WG); S.astep = 256 * D * 2; S.bstep = 256 * D * 2; S.bbatch = 0; S.nt = 32;
      EpiGates E{(bf16*)(ws + AR_GM), (bf16*)(ws + AR_GH), ss + 1 * M};
      pg8::gemm_phase((const char*)ws, lds, D, D, S, E); }
    xcd_barrier(bar);
    const bool LOC = (MISC[11] != 0u);
    const int lrank = (int)MISC[10], lp0 = 4 * (int)bar.x;
    unsigned* rdyW13 = ctl + 12288; unsigned* rdyW2T = ctl + 12352;
#define PHASE_BARRIER() do { if (LOC) xcd_local_barrier(bar, lrank & 3, ctl + 13312); else xcd_barrier(bar); } while (0)
    for (int rep_ = 0; rep_ < NREP(11); ++rep_) if (rep_ == 0 || (xcd_barrier(bar), true))
    { SchedPair S{G, bid, (const char*)(ws + AR_YM), (const char*)(ws + AR_YH), (const char*)(ws + WS_WPM), (const char*)(ws + WS_WPH), 0, 0};
      if (LOC) { S.loc = 1; S.p0 = lp0; S.c = lrank; }
      EpiProj E{(const bf16*)(ws + AR_GM), (const bf16*)(ws + AR_GH), (bf16*)(ws + AR_MERGED)};
      pg8::gemm_phase((const char*)ws, lds, 1024, 1024, S, E); }
    PHASE_BARRIER();
    for (int rep_ = 0; rep_ < NREP(12); ++rep_) if (rep_ == 0 || (xcd_barrier(bar), true))
    { SchedStd S; S.o.init(32, 8, G, bid); if (LOC) S.o.init_loc(8, lp0, lrank);
      S.A = (const char*)(ws + AR_MERGED); S.B = (const char*)(ws + WS_WOUT); S.astep = 256 * D * 2; S.bstep = 256 * D * 2; S.bbatch = 0; S.nt = 32;
      EpiRes<false> E{nullptr, XB, ss + 2 * M, 1.0f};
      pg8::gemm_phase((const char*)ws, lds, D, D, S, E); }
    PHASE_BARRIER();
    for (int rep_ = 0; rep_ < NREP(13); ++rep_) if (rep_ == 0 || (xcd_barrier(bar), true))
    { SchedStd S; S.o.init(32, 4, G, bid); if (LOC) S.o.init_loc(4, lp0, lrank);
      S.A = (const char*)XB; S.B = (const char*)(ws + WS_WQKT); S.astep = 256 * D * 2; S.bstep = 256 * D * 2; S.bbatch = (size_t)1024 * D * 2; S.nt = 32;
      EpiScores E{(bf16*)(ws + AR_P), ss + 2 * M, (LAS float*)(lds + RING_BYTES)};
      pg8::gemm_phase((const char*)ws, lds, D, D, S, E);
      const int cfirst = (G > 128) ? 128 : 0, nconv = (G - cfirst) * NWAVES;
      const bool copier = LOC ? (lrank >= 16) : (bid >= cfirst); const int cidx = LOC ? ((int)bar.x * 16 + lrank - 16) : (bid - cfirst);
      if (copier) {
          const float* w1 = INP(I_F2W1); const float* w3 = INP(I_F2W3); const float* w2 = INP(I_F2W2); const float* gn = INP(I_NFFN2);
          const int nit = (G == 256) ? 11264 : N_FFN_ITEMS;
#pragma unroll 1
          for (int base = cidx * NWAVES + wave; base < nit; base += 4 * nconv) {
              CvtDesc d[4]; f32x4 v[4][8];
#pragma unroll
              for (int u = 0; u < 4; ++u) { const int it = base + u * nconv; if (it < nit) { d[u] = ffn_desc(it, w1, w3, w2, gn, (bf16*)(ws + WS_W13), (bf16*)(ws + WS_W2T)); cvt_load(d[u], lane, v[u]); } }
#pragma unroll
              for (int u = 0; u < 4; ++u) { const int it = base + u * nconv; if (it < nit) cvt_store(d[u], lane, v[u]); }
          }
          if (LOC) publish_count(rdyW13);
      } }
    PHASE_BARRIER();
    for (int rep_ = 0; rep_ < NREP(15); ++rep_) if (rep_ == 0 || (xcd_barrier(bar), true))
    { SchedStd S; S.o.init(32, 8, G, bid); if (LOC) S.o.init_loc(8, lp0, lrank);
      S.A = (const char*)(ws + AR_P); S.B = (const char*)(ws + WS_VWOT); S.astep = 256 * 1024 * 2; S.bstep = 256 * 1024 * 2; S.bbatch = (size_t)2048 * 1024 * 2; S.nt = 16;
      EpiRes<false> E{nullptr, XB, ss + 3 * M, 1.0f};
      pg8::gemm_phase((const char*)ws, lds, 1024, 1024, S, E); }
    PHASE_BARRIER();
    if (LOC) await_count(rdyW13, 128u, bar.bar);
    for (int rep_ = 0; rep_ < NREP(16); ++rep_) if (rep_ == 0 || (xcd_barrier(bar), true))
    { SchedStd S; S.o.init(32, 44, G, bid); if (LOC) S.o.init_loc(44, lp0, lrank);
      S.A = (const char*)XB; S.B = (const char*)(ws + WS_W13); S.astep = 256 * D * 2; S.bstep = 256 * D * 2; S.bbatch = 0; S.nt = 32;
      EpiUp E{(bf16*)(ws + AR_ACT), ss + 3 * M};
      pg8::gemm_phase((const char*)ws, lds, D, D, S, E);
      const bool copier16 = LOC ? (lrank >= 16) : (bid >= 128); const int cidx16 = LOC ? ((int)bar.x * 16 + lrank - 16) : (bid - 128);
      if (G == 256 && copier16) {
          const float* w1 = INP(I_F2W1); const float* w3 = INP(I_F2W3); const float* w2 = INP(I_F2W2); const float* gn = INP(I_NFFN2); const int nconv = 128 * NWAVES;
          int ln16 = threadIdx.x & 63; asm volatile("" : "+v"(ln16));
#pragma unroll 1
          for (int base = 11264 + cidx16 * NWAVES + wave; base < N_FFN_ITEMS; base += 4 * nconv) {
              CvtDesc d[4]; f32x4 v[4][8];
#pragma unroll
              for (int u = 0; u < 4; ++u) { const int it = base + u * nconv; if (it < N_FFN_ITEMS) { d[u] = ffn_desc(it, w1, w3, w2, gn, (bf16*)(ws + WS_W13), (bf16*)(ws + WS_W2T)); cvt_load(d[u], ln16, v[u]); } }
#pragma unroll
              for (int u = 0; u < 4; ++u) { const int it = base + u * nconv; if (it < N_FFN_ITEMS) cvt_store(d[u], ln16, v[u]); }
          }
          if (LOC) publish_count(rdyW2T);
      } }
    PHASE_BARRIER();
    if (LOC) await_count(rdyW2T, 128u, bar.bar);
    if (G == 256) {
        SchedStd S; S.o.init(32, 8, G, bid); if (LOC) S.o.init_loc(8, lp0, lrank); S.A = (const char*)(ws + AR_ACT); S.B = (const char*)(ws + WS_W2T); S.astep = (size_t)256 * FF * 2; S.bstep = (size_t)256 * FF * 2; S.bbatch = 0; S.nt = FF / 64;
        EpiResFinal E{XB, (float*)kargs[28], INP(I_NFIN), ss + 4 * M, ctl + CW_PANEL, 0.5f};
        pg8::gemm_phase((const char*)ws, lds, FF, FF, S, E);
    } else {
        { SchedStd S; S.o.init(32, 8, G, bid); S.A = (const char*)(ws + AR_ACT); S.B = (const char*)(ws + WS_W2T); S.astep = (size_t)256 * FF * 2; S.bstep = (size_t)256 * FF * 2; S.bbatch = 0; S.nt = FF / 64;
          EpiRes<false> E{nullptr, XB, ss + 4 * M, 0.5f};
          pg8::gemm_phase((const char*)ws, lds, FF, FF, S, E); }
        xcd_barrier(bar);
        for (int row = gw; row < M; row += NGW) {
            const float r = rinv_of(ss + 4 * M, row);
            const u32x2* src = (const u32x2*)(XB + (size_t)row * D) + lane; const f32x4* gp = (const f32x4*)INP(I_NFIN) + lane; f32x4* dst = (f32x4*)((float*)kargs[28] + (size_t)row * D) + lane;
#pragma unroll
            for (int j = 0; j < 8; ++j) { const u32x2 xw = src[64 * j]; const f32x4 xv = {lo_bf(xw.x), hi_bf(xw.x), lo_bf(xw.y), hi_bf(xw.y)}; dst[64 * j] = xv * r * gp[64 * j]; }
        }
    }
}

extern "C" void kernel_launch(void* const* d_in, const int* in_sizes, int n_in, void* d_out, int out_size, void* d_ws, size_t ws_size, hipStream_t stream) {
    static int grid = 0;
    if (grid == 0) {
        if (n_in != 28 || in_sizes[0] != M * D || out_size != M * D || ws_size < WS_END) {
            fprintf(stderr, "kernel_launch: unexpected problem: n_in %d in0 %d out %d ws %zu (need %zu)\n", n_in, n_in > 0 ? in_sizes[0] : -1, out_size, ws_size, (size_t)WS_END); grid = -1; return; }
        int dev = 0, cus = 0;
        if (hipGetDevice(&dev) != hipSuccess || hipDeviceGetAttribute(&cus, hipDeviceAttributeMultiprocessorCount, dev) != hipSuccess) { fprintf(stderr, "kernel_launch: device query failed\n"); grid = -1; return; }
        if (hipFuncSetAttribute((const void*)fwd_kernel, hipFuncAttributeMaxDynamicSharedMemorySize, LDS_BYTES) != hipSuccess) { fprintf(stderr, "kernel_launch: hipFuncSetAttribute failed\n"); grid = -1; return; }
        int per_cu = 0;
        if (hipOccupancyMaxActiveBlocksPerMultiprocessor(&per_cu, (const void*)fwd_kernel, NTHR, LDS_BYTES) != hipSuccess || per_cu < 1) fprintf(stderr, "kernel_launch: note: occupancy query reports %d\n", per_cu);
        (void)hipGetLastError();
        grid = cus;
    }
    if (grid < 0) return;
    if (hipMemsetAsync((char*)d_ws + WS_CTL, 0, CTL_ZERO_BYTES, stream) != hipSuccess) { fprintf(stderr, "kernel_launch: memset failed\n"); return; }
    Args a{};
    for (int i = 0; i < 28; ++i) a.in[i] = (const float*)d_in[i];
    a.out = (float*)d_out; a.ws = (unsigned char*)d_ws;
    hipLaunchKernelGGL(fwd_kernel, dim3(grid), dim3(NTHR), LDS_BYTES, stream, a);
}
```

```cpp
#include <hip/hip_runtime.h>
#include <cstdio>
#include <cstdint>

#define LAS __attribute__((address_space(3)))
#define GAS __attribute__((address_space(1)))
typedef unsigned short bf16;
typedef short bf16x8 __attribute__((ext_vector_type(8)));
typedef float f32x4 __attribute__((ext_vector_type(4)));
typedef float f32x2 __attribute__((ext_vector_type(2)));
typedef unsigned u32x4 __attribute__((ext_vector_type(4)));
typedef unsigned u32x2 __attribute__((ext_vector_type(2)));
typedef unsigned long long u64;

constexpr int NB = 2, T = 4096, D = 2048, FF = 5632, M = NB * T;
constexpr int MEM = 256, DIN = 11272;
constexpr float EPS = 1e-6f;
constexpr int NWAVES = 8, NTHR = 512;

constexpr size_t MiB = 1u << 20;
constexpr size_t WS_CTL = 0, CTL_ZERO_BYTES = 1 * MiB;
constexpr size_t WS_SMALL = 1 * MiB;
constexpr size_t WS_MEMN = 3 * MiB;
constexpr size_t WS_KV = 5 * MiB;
constexpr size_t WS_WQKT = 9 * MiB;
constexpr size_t WS_VWOT = 17 * MiB;
constexpr size_t WS_W13 = 25 * MiB;
constexpr size_t WS_W2T = 69 * MiB;
constexpr size_t WS_WIN = 91 * MiB;
constexpr size_t WS_WG = 120 * MiB;
constexpr size_t WS_WPM = 136 * MiB, WS_WPH = 140 * MiB;
constexpr size_t WS_WOUT = 144 * MiB;
constexpr size_t WS_WQ = 152 * MiB;
constexpr size_t WS_WKV = 160 * MiB;
constexpr size_t WS_WO = 176 * MiB;
constexpr size_t WS_X = 184 * MiB;
constexpr size_t WS_XB = 248 * MiB;
constexpr size_t WS_AR = 280 * MiB;
constexpr size_t WS_END = 512 * MiB;
constexpr size_t AR_ACT = WS_AR;
constexpr size_t AR_QKRAW = WS_AR, AR_QC = WS_AR + 16 * MiB, AR_KC = WS_AR + 24 * MiB, AR_MV = WS_AR + 32 * MiB, AR_MO = WS_AR + 48 * MiB;
constexpr size_t AR_HQ = WS_AR + 64 * MiB, AR_HF = WS_AR + 80 * MiB, AR_HI = WS_AR + 96 * MiB, AR_HG = WS_AR + 112 * MiB;
constexpr size_t AR_MST = WS_AR + 128 * MiB;
constexpr size_t AR_HST = WS_AR + 160 * MiB;
constexpr size_t AR_YM = WS_AR + 192 * MiB, AR_YH = WS_AR + 208 * MiB;
constexpr size_t AR_GM = WS_X, AR_GH = WS_X + 32 * MiB;
constexpr size_t AR_TMP = WS_AR;
constexpr size_t AR_MERGED = WS_AR + 64 * MiB;
constexpr size_t AR_SC = WS_AR;
constexpr size_t AR_P = WS_AR + 32 * MiB;
static_assert(AR_YH + 16 * MiB <= WS_END, "arena");
constexpr size_t SM_GATES = 0;
constexpr size_t SM_BLAST = 256 * 1024;
constexpr size_t SM_MLOC = SM_BLAST + 2048;
constexpr size_t SM_MPREV = SM_MLOC + 2048;
constexpr size_t SM_DN = 512 * 1024;
constexpr size_t SM_DEC = 768 * 1024;
constexpr int CW_BAR = 4096;
constexpr int CW_PANEL = 8192;
constexpr size_t CTL_SS = 64 * 1024;
constexpr float SS_SCALE = 16777216.0f, SS_INV = 1.0f / (16777216.0f * 2048.0f);

constexpr int LDS_BYTES = 163840, RING_BYTES = 131072, MISC_OFF = LDS_BYTES - 256;

#define RLX_AGENT __ATOMIC_RELAXED, __HIP_MEMORY_SCOPE_AGENT
__device__ __forceinline__ unsigned f2bf(float f) { unsigned u = __builtin_bit_cast(unsigned, f); return (u + 0x7fffu + ((u >> 16) & 1u)) >> 16; }
__device__ __forceinline__ float bf2f(unsigned h) { return __builtin_bit_cast(float, (h & 0xffffu) << 16); }
typedef float f32x2_t __attribute__((ext_vector_type(2))); typedef __bf16 bf16x2_t __attribute__((ext_vector_type(2)));
__device__ __forceinline__ unsigned pk2(float lo, float hi) { f32x2_t v = {lo, hi}; bf16x2_t b = __builtin_convertvector(v, bf16x2_t); return __builtin_bit_cast(unsigned, b); }
__device__ __forceinline__ float lo_bf(unsigned w) { return __builtin_bit_cast(float, w << 16); }
__device__ __forceinline__ float hi_bf(unsigned w) { return __builtin_bit_cast(float, w & 0xffff0000u); }
__device__ __forceinline__ float sigmoidf_(float x) { return __builtin_amdgcn_rcpf(1.0f + __expf(-x)); }
__device__ __forceinline__ float siluf_(float x) { return x * __builtin_amdgcn_rcpf(1.0f + __expf(-x)); }
__device__ __forceinline__ float wave_sum(float v) {
#pragma unroll
    for (int o = 1; o < 64; o <<= 1) v += __shfl_xor(v, o);
    return v;
}
__device__ __forceinline__ float wave_max(float v) {
#pragma unroll
    for (int o = 1; o < 64; o <<= 1) v = fmaxf(v, __shfl_xor(v, o));
    return v;
}

#define XB_TMO      128
#define XB_XCNT(j)  (256  + 64 * (j))
#define XB_XSUB(j)  (1280 + 64 * (j))
#define XB_XGEN(j)  (2304 + 64 * (j))
#define XB_TOP      3328
#define XB_TOPGEN   3392
#define XCD_BAR_WORDS 3456
#define XB_LSUB(j)  (3456 + 32 * (j))
#define XB_LGEN(j)  (3712 + 32 * (j))
#define XB_SPIN_CAP (1u << 18)
__device__ __forceinline__ unsigned xb_ld(unsigned* p)              { return __hip_atomic_load(p, __ATOMIC_RELAXED, __HIP_MEMORY_SCOPE_AGENT); }
__device__ __forceinline__ unsigned xb_add(unsigned* p, unsigned v) { return __hip_atomic_fetch_add(p, v, __ATOMIC_RELAXED, __HIP_MEMORY_SCOPE_AGENT); }
__device__ __forceinline__ unsigned xb_xcc_id() { return (unsigned)__builtin_amdgcn_s_getreg((3 << 11) | 20) & 0xFu; }
#define XB_SPIN(cond, bar) do { unsigned _sp = 0; while (cond) { __builtin_amdgcn_s_sleep(1); \
    if ((++_sp & 255u) == 0u) { if (xb_ld(&(bar)[XB_TMO])) break; if (_sp > XB_SPIN_CAP) { atomicAdd(&(bar)[XB_TMO], 1u); break; } } } } while (0)
struct XcdBarrier { unsigned* bar; unsigned x; volatile LAS unsigned* st; };
__device__ __forceinline__ XcdBarrier xcd_barrier_post(unsigned* bar, volatile LAS unsigned* st) {
    XcdBarrier b; b.bar = bar; b.x = xb_xcc_id(); b.st = st;
    if (threadIdx.x == 0) st[2] = xb_add(&bar[XB_XCNT(b.x)], 1u);
    return b;
}
__device__ __forceinline__ void xcd_barrier_complete(unsigned* bar, unsigned x, unsigned& nloc, unsigned& nx, unsigned& uniform) {
    const unsigned G = gridDim.x * gridDim.y * gridDim.z;
    unsigned sum, cnt, mine, sp = 0u;
    for (;;) {
        sum = 0u; cnt = 0u; mine = 0u;
#pragma unroll
        for (unsigned j = 0; j < 16; ++j) { const unsigned c = xb_ld(&bar[XB_XCNT(j)]); sum += c; cnt += (c > 0u) ? 1u : 0u; mine = (j == x) ? c : mine; }
        if (sum == G) break;
        __builtin_amdgcn_s_sleep(1);
        if ((++sp & 255u) == 0u) { if (xb_ld(&bar[XB_TMO])) break; if (sp > XB_SPIN_CAP) { atomicAdd(&bar[XB_TMO], 1u); break; } }
    }
    nloc = mine > 0u ? mine : 1u; nx = cnt > 0u ? cnt : 1u;
    uniform = (G == 256u && cnt == 8u) ? 1u : 0u;
#pragma unroll
    for (unsigned j = 0; j < 8; ++j) if (xb_ld(&bar[XB_XCNT(j)]) != 32u) uniform = 0u;
}
__device__ __forceinline__ void xcd_barrier(const XcdBarrier& b) {
    asm volatile("s_waitcnt vmcnt(0)" ::: "memory");
    __syncthreads();
    if (threadIdx.x == 0) {
        unsigned* bar = b.bar;
        __builtin_amdgcn_s_waitcnt(0);
        unsigned nloc = b.st[0], nx = b.st[1];
        if (nloc == 0u) { unsigned uni; xcd_barrier_complete(bar, b.x, nloc, nx, uni); b.st[0] = nloc; b.st[1] = nx; b.st[3] = uni; }
        const unsigned old = xb_add(&bar[XB_XSUB(b.x)], 1u);
        const unsigned gen = old / nloc;
        if (old + 1u == (gen + 1u) * nloc) {
            __builtin_amdgcn_fence(__ATOMIC_RELEASE, "agent");
            asm volatile("s_waitcnt vmcnt(0)" ::: "memory");
            const unsigned og = xb_add(&bar[XB_TOP], 1u);
            const unsigned tg = og / nx;
            if (og + 1u == (tg + 1u) * nx) xb_add(&bar[XB_TOPGEN], 1u);
            else XB_SPIN(xb_ld(&bar[XB_TOPGEN]) == tg, bar);
            __builtin_amdgcn_fence(__ATOMIC_ACQUIRE, "agent");
            xb_add(&bar[XB_XGEN(b.x)], 1u);
            asm volatile("s_waitcnt vmcnt(0)" ::: "memory");
        } else {
            XB_SPIN(xb_ld(&bar[XB_XGEN(b.x)]) == gen, bar);
            __builtin_amdgcn_fence(__ATOMIC_ACQUIRE, "agent");
            asm volatile("s_waitcnt vmcnt(0)" ::: "memory");
        }
    }
    __syncthreads();
}

__device__ __forceinline__ void xcd_local_barrier(const XcdBarrier& b, const int pg = -1, unsigned* pgw = nullptr) {
    asm volatile("s_waitcnt vmcnt(0)" ::: "memory");
    __syncthreads();
    if (threadIdx.x == 0) {
        unsigned* bar = b.bar;
        __builtin_amdgcn_s_waitcnt(0);
        const unsigned nloc = pg < 0 ? b.st[0] : 8u;
        unsigned* sub = pg < 0 ? &bar[XB_LSUB(b.x)] : pgw + 64 * (4 * (int)b.x + pg); unsigned* gnp = pg < 0 ? &bar[XB_LGEN(b.x)] : pgw + 64 * (4 * (int)b.x + pg) + 32;
        const unsigned old = xb_add(sub, 1u);
        asm volatile("buffer_inv sc1" ::: "memory");
        const unsigned gen = old / nloc;
        if (old + 1u == (gen + 1u) * nloc) xb_add(gnp, 1u);
        else XB_SPIN(xb_ld(gnp) == gen, bar);
        asm volatile("s_waitcnt vmcnt(0)" ::: "memory");
    }
    __syncthreads();
}
__device__ __forceinline__ void publish_count(unsigned* ctr) {
    asm volatile("s_waitcnt vmcnt(0)" ::: "memory");
    __syncthreads();
    if (threadIdx.x == 0) { __builtin_amdgcn_fence(__ATOMIC_RELEASE, "agent"); asm volatile("s_waitcnt vmcnt(0)" ::: "memory"); xb_add(ctr, 1u); }
}
__device__ __forceinline__ void await_count(unsigned* ctr, unsigned n, unsigned* bar) {
    if (threadIdx.x == 0) { XB_SPIN(xb_ld(ctr) < n, bar); __builtin_amdgcn_fence(__ATOMIC_ACQUIRE, "agent"); asm volatile("s_waitcnt vmcnt(0)" ::: "memory"); }
    __syncthreads();
}

namespace pg8 {
constexpr int BM = 256, BK = 64, HALF = 128, HTB = HALF * BK * 2, STAGE_BYTES = 8 * HTB, NXCD = 8, WGM = 8;
__host__ __device__ __forceinline__ int lds_byte(int r, int c) { return r * 128 + (((c >> 3) ^ (r & 7)) * 16) + (c & 7) * 2; }
__host__ __device__ __forceinline__ void stage_rc(int b, int& R, int& C) { const int pc = b / 1024, sb = b % 1024, r8 = sb / 128, pos = (sb % 128) / 16; R = pc * 8 + r8; C = (pos ^ r8) * 8; }
__host__ __device__ __forceinline__ int perm32(int rho) { const int n = rho >> 4, i = rho & 15; return 8 * (i >> 2) + 4 * n + (i & 3); }

struct Unit { int pm, pn, kind, aux, nt; };

struct TileOrder {
    int nM, nN, nwg, G, c, loc, p0;
    __device__ void init(int nM_, int nN_, int G_, int c_) { nM = nM_; nN = nN_; nwg = nM * nN; G = G_; c = c_; loc = 0; p0 = 0; }
    __device__ void init_loc(int nN_, int p0_, int lrank) { nM = 4; nN = nN_; nwg = 4 * nN_; G = 32; c = lrank; loc = 1; p0 = p0_; }
    __device__ bool tile(int i, int& pm, int& pn) const {
        if (loc) { const int L = i * 32 + c; if (L >= nwg) return false; pm = p0 + (L & 3); pn = L >> 2; return true; }
        return tileL((long)i * G + c, pm, pn); }
    __device__ bool tileL(long L, int& pm, int& pn) const {
        if (L >= nwg) return false;
        int wgid = (int)L; { const int q = nwg / NXCD, r = nwg % NXCD, xcd = wgid % NXCD, off = wgid / NXCD; wgid = (xcd < r ? xcd * (q + 1) : r * (q + 1) + (xcd - r) * q) + off; }
        const int nig = WGM * nN, gid = wgid / nig, fm = gid * WGM, gsz = (nM - fm) < WGM ? (nM - fm) : WGM;
        pm = fm + ((wgid % nig) % gsz); pn = (wgid % nig) / gsz; return true;
    }
};

template <class Epi, class Sched>
__device__ __forceinline__ void gemm_phase(const char* wsb, LAS unsigned char* lds, const int lda, const int ldb, const Sched& S, const Epi& E) {
    int tid_ = threadIdx.x; asm volatile("" : "+v"(tid_));
    const int tid = tid_, wid = __builtin_amdgcn_readfirstlane(tid >> 6), lane = tid & 63, wr = wid >> 2, wc = wid & 3, fr = lane & 15, fq = lane >> 4;
    unsigned voffA, voffB;
    { int R, C; stage_rc(tid * 16, R, C); const int Rb = (R & ~31) + perm32(R & 31);
      voffA = (unsigned)(R * lda + C) * 2u; voffB = (unsigned)(Rb * ldb + C) * 2u; }
    const unsigned hpA = 64u * (unsigned)lda * 2u, hpB = 64u * (unsigned)ldb * 2u;
    const __amdgpu_buffer_rsrc_t rsW = __builtin_amdgcn_make_buffer_rsrc((void*)wsb, (short)0, 0x7fffffff, 0x00020000);
    const size_t kstep = (size_t)(BK * 2);
    const size_t hstepA = (size_t)HALF * lda * 2, hstepB = (size_t)HALF * ldb * 2;
    const unsigned ldsw = (unsigned)wid * 1024u;
    const int aoff = lds_byte(wr * 64 + fr, fq * 8), boff = lds_byte(wc * 32 + fr, fq * 8), aoff1 = aoff ^ 64, boff1 = boff ^ 64;
#define PG8_SA(b, h) (((b) * 2 + (h)) * HTB)
#define PG8_SB(b, h) ((4 + (b) * 2 + (h)) * HTB)
#define PG8_STAGE(bufoff, gbase, voff, hp) do { const unsigned so_ = (unsigned)((const char*)(gbase) - wsb); \
        __builtin_amdgcn_raw_ptr_buffer_load_lds(rsW, (LAS unsigned*)(lds + (bufoff) + ldsw), 16, (voff), so_, 0, 0); \
        __builtin_amdgcn_raw_ptr_buffer_load_lds(rsW, (LAS unsigned*)(lds + (bufoff) + ldsw + 8192), 16, (voff), so_ + (hp), 0, 0); } while (0)
#define PG8_LDA(dst, b, h) do { _Pragma("unroll") for (int m = 0; m < 4; ++m) _Pragma("unroll") for (int k = 0; k < 2; ++k) dst[m][k] = *(const LAS bf16x8*)(lds + PG8_SA(b, h) + (k ? aoff1 : aoff) + m * 2048); } while (0)
#define PG8_LDB(dst, b, h) do { _Pragma("unroll") for (int n = 0; n < 2; ++n) _Pragma("unroll") for (int k = 0; k < 2; ++k) dst[n][k] = *(const LAS bf16x8*)(lds + PG8_SB(b, h) + (k ? boff1 : boff) + n * 2048); } while (0)
#define PG8_MMA(ai, bj, At, Bt) do { __builtin_amdgcn_s_setprio(1); _Pragma("unroll") for (int m = 0; m < 4; ++m) _Pragma("unroll") for (int n = 0; n < 2; ++n) _Pragma("unroll") for (int k = 0; k < 2; ++k) \
        acc[ai][bj][m][n] = __builtin_amdgcn_mfma_f32_16x16x32_bf16(Bt[n][k], At[m][k], acc[ai][bj][m][n], 0, 0, 0); __builtin_amdgcn_s_setprio(0); } while (0)
#define PG8_WAIT_V(n) asm volatile("s_waitcnt vmcnt(" #n ")" ::: "memory")
#define PG8_WAIT_L(n) asm volatile("s_waitcnt lgkmcnt(" #n ")" ::: "memory")
#define PG8_BAR __builtin_amdgcn_s_barrier()
#define PG8_SCHED __builtin_amdgcn_sched_barrier(0)
    Unit cur, nxt; int ui = 0;
    if (!S.next(0, cur)) return;
    f32x4 acc[2][2][4][2];
#pragma unroll
    for (int a = 0; a < 2; ++a)
#pragma unroll
        for (int b = 0; b < 2; ++b)
#pragma unroll
            for (int m = 0; m < 4; ++m)
#pragma unroll
                for (int n = 0; n < 2; ++n) acc[a][b][m][n] = (f32x4){0.f, 0.f, 0.f, 0.f};
    bf16x8 At[4][2], B0[2][2], B1[2][2];
    const char* cA; const char* cB; S.ptrs(cur, cA, cB);
    typename Epi::Pre pre; E.prefetch(cur, wr, fr, pre);
    PG8_STAGE(PG8_SB(0, 0), cB, voffB, hpB); PG8_STAGE(PG8_SB(0, 1), cB + hstepB, voffB, hpB); PG8_STAGE(PG8_SA(0, 0), cA, voffA, hpA); PG8_STAGE(PG8_SA(0, 1), cA + hstepA, voffA, hpA);
    if (wr == 1) PG8_BAR;
    PG8_WAIT_V(2); PG8_BAR;
    PG8_STAGE(PG8_SB(1, 0), cB + kstep, voffB, hpB); PG8_STAGE(PG8_SA(1, 0), cA + kstep, voffA, hpA); PG8_STAGE(PG8_SB(1, 1), cB + hstepB + kstep, voffB, hpB);
    PG8_WAIT_V(6); PG8_BAR;
    for (;;) {
        const bool has_next = S.next(ui + 1, nxt);
        const char* nA = cA + (size_t)(cur.nt - 2) * kstep; const char* nB = cB + (size_t)(cur.nt - 2) * kstep;
        if (has_next) S.ptrs(nxt, nA, nB);
        const int nt = cur.nt;
        for (int t = 0; t < nt; t += 2) {
            const bool last = (t == nt - 2);
            const char* a1 = cA + (size_t)(t + 1) * kstep;
            const char* a2 = last ? nA : cA + (size_t)(t + 2) * kstep; const char* b2 = last ? nB : cB + (size_t)(t + 2) * kstep;
            const char* a3 = a2 + kstep; const char* b3 = b2 + kstep;
            PG8_LDB(B0, 0, 0); PG8_LDB(B1, 0, 1); PG8_SCHED; PG8_LDA(At, 0, 0); PG8_STAGE(PG8_SA(1, 1), a1 + hstepA, voffA, hpA);
            PG8_WAIT_V(8); PG8_WAIT_L(0); PG8_BAR; PG8_MMA(0, 0, At, B0); PG8_MMA(0, 1, At, B1); PG8_BAR; PG8_SCHED;
            PG8_LDA(At, 0, 1); PG8_STAGE(PG8_SB(0, 0), b2, voffB, hpB); PG8_STAGE(PG8_SB(0, 1), b2 + hstepB, voffB, hpB); PG8_STAGE(PG8_SA(0, 0), a2, voffA, hpA);
            PG8_WAIT_V(8); PG8_WAIT_L(0); PG8_BAR; PG8_MMA(1, 0, At, B0); PG8_MMA(1, 1, At, B1); PG8_BAR; PG8_SCHED;
            PG8_LDB(B0, 1, 0); PG8_LDB(B1, 1, 1); PG8_SCHED; PG8_LDA(At, 1, 0); PG8_STAGE(PG8_SA(0, 1), a2 + hstepA, voffA, hpA);
            PG8_WAIT_V(8); PG8_WAIT_L(0); PG8_BAR; PG8_MMA(0, 0, At, B0); PG8_MMA(0, 1, At, B1); PG8_BAR; PG8_SCHED;
            PG8_LDA(At, 1, 1); PG8_STAGE(PG8_SB(1, 0), b3, voffB, hpB); PG8_STAGE(PG8_SB(1, 1), b3 + hstepB, voffB, hpB); PG8_STAGE(PG8_SA(1, 0), a3, voffA, hpA);
            PG8_WAIT_V(8); PG8_WAIT_L(0); PG8_BAR; PG8_MMA(1, 0, At, B0); PG8_MMA(1, 1, At, B1); PG8_BAR; PG8_SCHED;
        }
        if (wr == 0) PG8_BAR;
        { int fr_e = fr, fq_e = fq; asm volatile("" : "+v"(fr_e), "+v"(fq_e));
          E(acc, cur, wr, wc, fr_e, fq_e, pre);
          }
        if (!has_next) break;
        if (!(Sched::PAIR && cur.kind == 0)) {
#pragma unroll
        for (int a = 0; a < 2; ++a)
#pragma unroll
            for (int b = 0; b < 2; ++b)
#pragma unroll
                for (int m = 0; m < 4; ++m)
#pragma unroll
                    for (int n = 0; n < 2; ++n) acc[a][b][m][n] = (f32x4){0.f, 0.f, 0.f, 0.f};
        }
        cur = nxt; cA = nA; cB = nB; ++ui;
        E.prefetch(cur, wr, fr, pre);
        if (wr == 1) PG8_BAR;
    }
    PG8_WAIT_V(0);
    PG8_BAR;
#undef PG8_SA
#undef PG8_SB
#undef PG8_STAGE
#undef PG8_LDA
#undef PG8_LDB
#undef PG8_MMA
#undef PG8_WAIT_V
#undef PG8_WAIT_L
#undef PG8_BAR
#undef PG8_SCHED
}
}
using pg8::Unit;

struct SchedStd { static constexpr bool PAIR = false;
    pg8::TileOrder o; const char* A; const char* B; size_t astep, bstep, bbatch; int nt;
    __device__ bool next(int i, Unit& u) const { u.kind = 0; u.aux = 0; u.nt = nt; return o.tile(i, u.pm, u.pn); }
    __device__ void ptrs(const Unit& u, const char*& a, const char*& b) const { a = A + (size_t)u.pm * astep; b = B + (size_t)u.pn * bstep + (size_t)(u.pm >> 4) * bbatch; }
};
struct SchedPair { static constexpr bool PAIR = true;
    int G, c; const char *A0, *A1, *B0, *B1; int loc, p0;
    __device__ bool next(int i, Unit& u) const {
        u.kind = i & 1; u.aux = 0; u.nt = 16;
        if (loc) { if (i >= 2) return false; u.pm = p0 + (c & 3); u.pn = c >> 2; return true; }
        const int p = (i >> 1) * G + c; if (p >= 256) return false; u.pm = p >> 3; u.pn = p & 7; return true; }
    __device__ void ptrs(const Unit& u, const char*& a, const char*& b) const { a = (u.kind ? A1 : A0) + (size_t)u.pm * (256 * 1024 * 2); b = (u.kind ? B1 : B0) + (size_t)u.pn * (256 * 1024 * 2); }
};
constexpr size_t TSTEP = (size_t)256 * D * 2;
struct SchedUpKv { static constexpr bool PAIR = false;
    pg8::TileOrder o; int G, c; const char *XBp, *W13p, *MEMNp, *WKVp; int loc, p0, xq;
    __device__ bool next(int i, Unit& u) const { const long L = loc ? (long)i * 32 + c : (long)i * G + c; u.aux = 0; u.nt = 32;
        if (loc) {
            if (L < 176) { u.kind = 0; u.pm = p0 + ((int)L & 3); u.pn = (int)L >> 2; return true; }
            if (L < 180) { const int r = xq * 4 + ((int)L - 176); u.kind = 1; u.pm = r & 1; u.pn = r >> 1; return true; }
            return false; }
        if (L < 1408) { u.kind = 0; return o.tileL(L, u.pm, u.pn); }
        if (L < 1440) { const int r = (int)L - 1408; u.kind = 1; u.pm = r & 1; u.pn = r >> 1; return true; }
        return false; }
    __device__ void ptrs(const Unit& u, const char*& a, const char*& b) const { a = (u.kind ? MEMNp : XBp) + (size_t)u.pm * TSTEP; b = (u.kind ? WKVp : W13p) + (size_t)u.pn * TSTEP; }
};
struct SchedInW { static constexpr bool PAIR = false;
    pg8::TileOrder o; int G, c; const char *XBp, *WINp, *Kp, *Vp, *WQp, *WOp; int loc, p0, xq;
    __device__ bool wunit(int r, Unit& u) const { const int rr = r & 63; u.kind = 1 + (r >> 6); u.aux = ((rr >> 5) << 2) | ((rr >> 3) & 3); u.pm = rr & 7; u.pn = 0; u.nt = 8; return true; }
    __device__ bool next(int i, Unit& u) const {
        u.aux = 0; u.nt = 32; u.kind = 0;
        if (loc) {
            const int L = i * 32 + c;
            if (L < 116) { u.pm = p0 + (L & 3); u.pn = L >> 2; return true; }
            if (i == 3) return wunit(xq * 16 + (c - 20), u);
            if (i == 4 && c >= 20 && c < 24) return wunit(xq * 16 + 12 + (c - 20), u);
            return false; }
        if (G == 256) {
            if (i < 3) return o.tileL((long)i * 256 + c, u.pm, u.pn);
            if (i == 3) { if (768 + c < 928) return o.tileL(768 + c, u.pm, u.pn); return wunit(c - 160, u); }
            if (i == 4 && c >= 160 && c < 192) return wunit(96 + c - 160, u);
            return false;
        }
        const long L = (long)i * G + c;
        if (L < 928) return o.tileL(L, u.pm, u.pn);
        if (L < 1056) return wunit((int)L - 928, u);
        return false; }
    __device__ void ptrs(const Unit& u, const char*& a, const char*& b) const {
        const int bb = u.aux >> 2, hh = u.aux & 3;
        if (u.kind == 0) { a = XBp + (size_t)u.pm * TSTEP; b = WINp + (size_t)u.pn * TSTEP; }
        else if (u.kind == 1) { a = Kp + (size_t)bb * TSTEP + hh * 1024; b = WQp + (size_t)u.pm * TSTEP + hh * 1024; }
        else { a = WOp + (size_t)u.pm * TSTEP + hh * 1024; b = Vp + (size_t)bb * TSTEP + hh * 1024; } }
};

#define EPI_ROWS(ai, m) (u.pm * 256 + (ai) * 128 + wr * 64 + (m) * 16 + fr)
#define EPI_COL8(bj) ((bj) * 128 + wc * 32 + 8 * fq)
struct NoPre {};
struct RowPre { u64 s[8]; };
__device__ __forceinline__ void rowpre_load(const u64* ss, const int pm, int wr, int fr, RowPre& p) {
#pragma unroll
    for (int k = 0; k < 8; ++k) p.s[k] = ((const GAS u64*)ss)[pm * 256 + (k >> 2) * 128 + wr * 64 + (k & 3) * 16 + fr]; }
__device__ __forceinline__ float rinv_of(const u64* ss, int row) { return rsqrtf((float)((const GAS u64*)ss)[row] * SS_INV + EPS); }

struct EpiUp {
    struct Pre { u64 s[8]; };
    __device__ __forceinline__ void prefetch(const Unit& u, int wr, int fr, Pre& p) const {
#pragma unroll
        for (int k = 0; k < 8; ++k) p.s[k] = ((const GAS u64*)ss)[u.pm * 256 + (k >> 2) * 128 + wr * 64 + (k & 3) * 16 + fr]; }
    bf16* act; const u64* ss;
    __device__ __forceinline__ void operator()(const f32x4 (&acc)[2][2][4][2], const Unit& u, int wr, int wc, int fr, int fq, const Pre& pre) const {
#ifdef EPI_TWICE
      for (int rep2 = 0; rep2 < 2; ++rep2) { asm volatile("" : "+v"(fr), "+v"(fq));
#endif
#pragma unroll
        for (int ai = 0; ai < 2; ++ai)
#pragma unroll
            for (int m = 0; m < 4; ++m) {
                const int row = EPI_ROWS(ai, m); const float r = rsqrtf((float)pre.s[ai * 4 + m] * SS_INV + EPS);
                float o[8];
#pragma unroll
                for (int n = 0; n < 2; ++n)
#pragma unroll
                    for (int i = 0; i < 4; ++i) { const float a = acc[ai][0][m][n][i] * r, b = acc[ai][1][m][n][i] * r; o[n * 4 + i] = siluf_(a) * b; }
                u32x4 w; w.x = pk2(o[0], o[1]); w.y = pk2(o[2], o[3]); w.z = pk2(o[4], o[5]); w.w = pk2(o[6], o[7]);
                *(GAS u32x4*)(act + (size_t)row * FF + u.pn * 128 + wc * 32 + 8 * fq) = w;
            }
#ifdef EPI_TWICE
      }
#endif
    }
};
template <bool IN_F32>
struct EpiRes {
    typedef NoPre Pre; __device__ __forceinline__ void prefetch(const Unit&, int, int, Pre&) const {}
    const float* xin32; bf16* xb; u64* ssn; float scale;
    __device__ __forceinline__ void operator()(const f32x4 (&acc)[2][2][4][2], const Unit& u, int wr, int wc, int fr, int fq, const Pre& pre) const {
#pragma unroll
        for (int ai = 0; ai < 2; ++ai)
#pragma unroll
            for (int m = 0; m < 4; ++m) {
                const int row = EPI_ROWS(ai, m); float q = 0.f;
#pragma unroll
                for (int bj = 0; bj < 2; ++bj) {
                    const size_t off = (size_t)row * D + u.pn * 256 + EPI_COL8(bj);
                    f32x4 x0, x1;
                    if (IN_F32) { x0 = *(const GAS f32x4*)(xin32 + off); x1 = *(const GAS f32x4*)(xin32 + off + 4); }
                    else { const u32x4 xw = *(const GAS u32x4*)(xb + off); x0[0] = lo_bf(xw.x); x0[1] = hi_bf(xw.x); x0[2] = lo_bf(xw.y); x0[3] = hi_bf(xw.y); x1[0] = lo_bf(xw.z); x1[1] = hi_bf(xw.z); x1[2] = lo_bf(xw.w); x1[3] = hi_bf(xw.w); }
                    const f32x4 o0 = x0 + acc[ai][bj][m][0] * scale, o1 = x1 + acc[ai][bj][m][1] * scale;
                    u32x4 w; w.x = pk2(o0[0], o0[1]); w.y = pk2(o0[2], o0[3]); w.z = pk2(o1[0], o1[1]); w.w = pk2(o1[2], o1[3]); *(GAS u32x4*)(xb + off) = w;
                    q += (o0[0] * o0[0] + o0[1] * o0[1]) + (o0[2] * o0[2] + o0[3] * o0[3]) + (o1[0] * o1[0] + o1[1] * o1[1]) + (o1[2] * o1[2] + o1[3] * o1[3]);
                }
                q += __shfl_xor(q, 16); q += __shfl_xor(q, 32);
                if (fq == 0) atomicAdd((u64*)(ssn + row), (u64)(q * SS_SCALE));
            }
    }
};
struct EpiResFinal {
    typedef NoPre Pre; __device__ __forceinline__ void prefetch(const Unit&, int, int, Pre&) const {}
    const bf16* xin; float* out; const float* gfin; u64* ssn; unsigned* cnt; float scale;
    __device__ __forceinline__ void operator()(f32x4 (&acc)[2][2][4][2], const Unit& u, int wr, int wc, int fr, int fq, const Pre& pre) const {
#pragma unroll
        for (int ai = 0; ai < 2; ++ai)
#pragma unroll
            for (int m = 0; m < 4; ++m) {
                const int row = EPI_ROWS(ai, m); float q = 0.f;
#pragma unroll
                for (int bj = 0; bj < 2; ++bj) {
                    const size_t off = (size_t)row * D + u.pn * 256 + EPI_COL8(bj);
                    const u32x4 xw = *(const GAS u32x4*)(xin + off);
                    f32x4 x0, x1; x0[0] = lo_bf(xw.x); x0[1] = hi_bf(xw.x); x0[2] = lo_bf(xw.y); x0[3] = hi_bf(xw.y); x1[0] = lo_bf(xw.z); x1[1] = hi_bf(xw.z); x1[2] = lo_bf(xw.w); x1[3] = hi_bf(xw.w);
                    const f32x4 o0 = x0 + acc[ai][bj][m][0] * scale, o1 = x1 + acc[ai][bj][m][1] * scale;
                    acc[ai][bj][m][0] = o0; acc[ai][bj][m][1] = o1;
                    q += (o0[0] * o0[0] + o0[1] * o0[1]) + (o0[2] * o0[2] + o0[3] * o0[3]) + (o1[0] * o1[0] + o1[1] * o1[1]) + (o1[2] * o1[2] + o1[3] * o1[3]);
                }
                q += __shfl_xor(q, 16); q += __shfl_xor(q, 32);
                if (fq == 0) atomicAdd((u64*)(ssn + row), (u64)(q * SS_SCALE));
            }
        asm volatile("s_waitcnt vmcnt(0)" ::: "memory");
        unsigned* c = cnt + 64 * u.pm;
        if (fr == 0 && fq == 0) __hip_atomic_fetch_add(c, 1u, __ATOMIC_RELAXED, __HIP_MEMORY_SCOPE_AGENT);
        if (wr == 0 && wc == 0) {
            unsigned spins = 0;
            while ((unsigned)__builtin_amdgcn_readfirstlane(__hip_atomic_load(c, __ATOMIC_RELAXED, __HIP_MEMORY_SCOPE_AGENT)) < 64u) { __builtin_amdgcn_s_sleep(2); if (++spins > (1u << 22)) break; }
            __builtin_amdgcn_fence(__ATOMIC_ACQUIRE, "agent");
            asm volatile("s_waitcnt vmcnt(0)" ::: "memory");
        }
        asm volatile("" ::: "memory"); __builtin_amdgcn_s_barrier(); asm volatile("" ::: "memory");
#pragma unroll
        for (int ai = 0; ai < 2; ++ai)
#pragma unroll
            for (int m = 0; m < 4; ++m) {
                const int row = EPI_ROWS(ai, m);
                const float r = rsqrtf((float)__hip_atomic_load(ssn + row, __ATOMIC_RELAXED, __HIP_MEMORY_SCOPE_AGENT) * SS_INV + EPS);
#pragma unroll
                for (int bj = 0; bj < 2; ++bj) {
                    const size_t off = (size_t)row * D + u.pn * 256 + EPI_COL8(bj); const int col = u.pn * 256 + EPI_COL8(bj);
                    const f32x4 o0 = acc[ai][bj][m][0], o1 = acc[ai][bj][m][1];
                    *(GAS f32x4*)(out + off) = o0 * r * *(const GAS f32x4*)(gfin + col); *(GAS f32x4*)(out + off + 4) = o1 * r * *(const GAS f32x4*)(gfin + col + 4);
                }
            }
    }
};
struct EpiInproj {
    typedef RowPre Pre; __device__ __forceinline__ void prefetch(const Unit& u, int wr, int fr, Pre& p) const { rowpre_load(ss, u.pm, wr, fr, p); }
    unsigned char* ws; const u64* ss; const float* igb; const float* fgb;
    __device__ __forceinline__ void operator()(const f32x4 (&acc)[2][2][4][2], const Unit& u, int wr, int wc, int fr, int fq, const Pre& pre) const {
        if (u.pn == 28) {
            if (wc == 0 && fq == 0) {
                float* gates = (float*)(ws + WS_SMALL + SM_GATES);
#pragma unroll
                for (int ai = 0; ai < 2; ++ai)
#pragma unroll
                    for (int m = 0; m < 4; ++m) {
                        const int row = EPI_ROWS(ai, m); const float r = rsqrtf((float)pre.s[ai * 4 + m] * SS_INV + EPS);
                        f32x4 gi, gf;
#pragma unroll
                        for (int i = 0; i < 4; ++i) {
                            gi[i] = acc[ai][0][m][0][i] * r + igb[i];
                            const float xf = acc[ai][0][m][1][i] * r + fgb[i];
                            gf[i] = fminf(xf, 0.f) - __logf(1.0f + __expf(-fabsf(xf)));
                        }
                        *(GAS f32x4*)(gates + (size_t)row * 8) = gi; *(GAS f32x4*)(gates + (size_t)row * 8 + 4) = gf;
                    }
            }
            return;
        }
        const int ty = u.pn >> 2;
        bf16* base = (bf16*)(ws + (ty == 0 ? AR_QKRAW : ty == 1 ? AR_MV : ty == 2 ? AR_MO : ty == 3 ? AR_HQ : ty == 4 ? AR_HF : ty == 5 ? AR_HI : AR_HG));
#pragma unroll
        for (int ai = 0; ai < 2; ++ai)
#pragma unroll
            for (int m = 0; m < 4; ++m) {
                const int row = EPI_ROWS(ai, m); const float r = rsqrtf((float)pre.s[ai * 4 + m] * SS_INV + EPS);
#pragma unroll
                for (int bj = 0; bj < 2; ++bj) {
                    float o[8];
#pragma unroll
                    for (int n = 0; n < 2; ++n)
#pragma unroll
                        for (int i = 0; i < 4; ++i) {
                            float v = acc[ai][bj][m][n][i] * r;
                            if (ty == 2) v = sigmoidf_(v); else if (ty == 3) v = siluf_(v) * 0.08838834764831845f; else if (ty == 6) v = siluf_(v);
                            o[n * 4 + i] = v;
                        }
                    u32x4 w; w.x = pk2(o[0], o[1]); w.y = pk2(o[2], o[3]); w.z = pk2(o[4], o[5]); w.w = pk2(o[6], o[7]);
                    *(GAS u32x4*)(base + (size_t)row * 1024 + (u.pn & 3) * 256 + EPI_COL8(bj)) = w;
                }
            }
    }
};
struct EpiGates {
    typedef RowPre Pre; __device__ __forceinline__ void prefetch(const Unit& u, int wr, int fr, Pre& p) const { rowpre_load(ss, u.pm, wr, fr, p); }
    bf16* gm; bf16* gh; const u64* ss;
    __device__ __forceinline__ void operator()(const f32x4 (&acc)[2][2][4][2], const Unit& u, int wr, int wc, int fr, int fq, const Pre& pre) const {
        bf16* base = (u.pn < 8) ? gm : gh;
#pragma unroll
        for (int ai = 0; ai < 2; ++ai)
#pragma unroll
            for (int m = 0; m < 4; ++m) {
                const int row = EPI_ROWS(ai, m); const float r = rsqrtf((float)pre.s[ai * 4 + m] * SS_INV + EPS);
#pragma unroll
                for (int bj = 0; bj < 2; ++bj) {
                    float o[8];
#pragma unroll
                    for (int n = 0; n < 2; ++n)
#pragma unroll
                        for (int i = 0; i < 4; ++i) o[n * 4 + i] = sigmoidf_(acc[ai][bj][m][n][i] * r);
                    u32x4 w; w.x = pk2(o[0], o[1]); w.y = pk2(o[2], o[3]); w.z = pk2(o[4], o[5]); w.w = pk2(o[6], o[7]);
                    *(GAS u32x4*)(base + (size_t)row * D + (u.pn & 7) * 256 + EPI_COL8(bj)) = w;
                }
            }
    }
};
struct EpiProj {
    typedef NoPre Pre; __device__ __forceinline__ void prefetch(const Unit&, int, int, Pre&) const {}
    const bf16* gm; const bf16* gh; bf16* merged;
    __device__ __forceinline__ void operator()(f32x4 (&acc)[2][2][4][2], const Unit& u, int wr, int wc, int fr, int fq, const Pre& pre) const {
#pragma unroll
        for (int ai = 0; ai < 2; ++ai)
#pragma unroll
            for (int m = 0; m < 4; ++m) {
                const int row = EPI_ROWS(ai, m);
#pragma unroll
                for (int bj = 0; bj < 2; ++bj) {
                    const size_t off = (size_t)row * D + u.pn * 256 + EPI_COL8(bj);
                    const u32x4 hw = *(const GAS u32x4*)(gh + off);
                    float h8[8] = {lo_bf(hw.x), hi_bf(hw.x), lo_bf(hw.y), hi_bf(hw.y), lo_bf(hw.z), hi_bf(hw.z), lo_bf(hw.w), hi_bf(hw.w)};
                    if (u.kind == 0) {
                        const u32x4 gw = *(const GAS u32x4*)(gm + off);
                        const float g8[8] = {lo_bf(gw.x), hi_bf(gw.x), lo_bf(gw.y), hi_bf(gw.y), lo_bf(gw.z), hi_bf(gw.z), lo_bf(gw.w), hi_bf(gw.w)};
#pragma unroll
                        for (int i = 0; i < 4; ++i) { acc[ai][bj][m][0][i] *= g8[i] * __builtin_amdgcn_rcpf(fmaxf(h8[i], 1e-30f)); acc[ai][bj][m][1][i] *= g8[4 + i] * __builtin_amdgcn_rcpf(fmaxf(h8[4 + i], 1e-30f)); }
                    } else {
                        const f32x4 a = acc[ai][bj][m][0], b = acc[ai][bj][m][1];
                        u32x4 w; w.x = pk2(a[0] * h8[0], a[1] * h8[1]); w.y = pk2(a[2] * h8[2], a[3] * h8[3]); w.z = pk2(b[0] * h8[4], b[1] * h8[5]); w.w = pk2(b[2] * h8[6], b[3] * h8[7]); *(GAS u32x4*)(merged + off) = w;
                    }
                }
            }
    }
};
struct EpiScores {
    typedef RowPre Pre; __device__ __forceinline__ void prefetch(const Unit& u, int wr, int fr, Pre& p) const { rowpre_load(ss, u.pm, wr, fr, p); }
    bf16* p; const u64* ss; LAS float* xch;
    __device__ __forceinline__ void operator()(const f32x4 (&acc)[2][2][4][2], const Unit& u, int wr, int wc, int fr, int fq, const Pre& pre) const {
        float v[2][4][16];
#pragma unroll
        for (int ai = 0; ai < 2; ++ai)
#pragma unroll
            for (int m = 0; m < 4; ++m) {
                const int row = EPI_ROWS(ai, m), rl = ai * 128 + wr * 64 + m * 16 + fr; const float r = rsqrtf((float)pre.s[ai * 4 + m] * SS_INV + EPS) * 0.04419417382415922f;
                float mx = -INFINITY;
#pragma unroll
                for (int bj = 0; bj < 2; ++bj)
#pragma unroll
                    for (int n = 0; n < 2; ++n)
#pragma unroll
                        for (int i = 0; i < 4; ++i) { const float x = acc[ai][bj][m][n][i] * r; v[ai][m][bj * 8 + n * 4 + i] = x; mx = fmaxf(mx, x); }
                mx = fmaxf(mx, __shfl_xor(mx, 16)); mx = fmaxf(mx, __shfl_xor(mx, 32));
                if (fq == 0) xch[rl * 4 + wc] = mx;
            }
        asm volatile("s_waitcnt lgkmcnt(0)" ::: "memory"); __builtin_amdgcn_s_barrier(); asm volatile("" ::: "memory");
#pragma unroll
        for (int ai = 0; ai < 2; ++ai)
#pragma unroll
            for (int m = 0; m < 4; ++m) {
                const int rl = ai * 128 + wr * 64 + m * 16 + fr; const f32x4 pm = *(const LAS f32x4*)(xch + rl * 4);
                const float mx = fmaxf(fmaxf(pm[0], pm[1]), fmaxf(pm[2], pm[3])); float sm = 0.f;
#pragma unroll
                for (int k = 0; k < 16; ++k) { const float e = __expf(v[ai][m][k] - mx); v[ai][m][k] = e; sm += e; }
                sm += __shfl_xor(sm, 16); sm += __shfl_xor(sm, 32);
                if (fq == 0) xch[1024 + rl * 4 + wc] = sm;
            }
        asm volatile("s_waitcnt lgkmcnt(0)" ::: "memory"); __builtin_amdgcn_s_barrier(); asm volatile("" ::: "memory");
#pragma unroll
        for (int ai = 0; ai < 2; ++ai)
#pragma unroll
            for (int m = 0; m < 4; ++m) {
                const int row = EPI_ROWS(ai, m), rl = ai * 128 + wr * 64 + m * 16 + fr; const f32x4 ps = *(const LAS f32x4*)(xch + 1024 + rl * 4);
                const float inv = __builtin_amdgcn_rcpf((ps[0] + ps[1]) + (ps[2] + ps[3]));
#pragma unroll
                for (int bj = 0; bj < 2; ++bj) {
                    const float* e = &v[ai][m][bj * 8];
                    u32x4 w; w.x = pk2(e[0] * inv, e[1] * inv); w.y = pk2(e[2] * inv, e[3] * inv); w.z = pk2(e[4] * inv, e[5] * inv); w.w = pk2(e[6] * inv, e[7] * inv);
                    *(GAS u32x4*)(p + (size_t)row * 1024 + u.pn * 256 + EPI_COL8(bj)) = w;
                }
            }
    }
};
__device__ __forceinline__ void store_tile_bf16(const f32x4 (&acc)[2][2][4][2], bf16* base, int ldc, int wr, int wc, int fr, int fq) {
#pragma unroll
    for (int ai = 0; ai < 2; ++ai)
#pragma unroll
        for (int m = 0; m < 4; ++m) {
            const int rl = ai * 128 + wr * 64 + m * 16 + fr;
#pragma unroll
            for (int bj = 0; bj < 2; ++bj) {
                const f32x4 a = acc[ai][bj][m][0], b = acc[ai][bj][m][1];
                u32x4 w; w.x = pk2(a[0], a[1]); w.y = pk2(a[2], a[3]); w.z = pk2(b[0], b[1]); w.w = pk2(b[2], b[3]);
                *(GAS u32x4*)(base + (size_t)rl * ldc + EPI_COL8(bj)) = w;
            }
        }
}
struct EpiUpKv {
    typedef EpiUp::Pre Pre; __device__ __forceinline__ void prefetch(const Unit& u, int wr, int fr, Pre& p) const { if (u.kind == 0) up.prefetch(u, wr, fr, p); }
    EpiUp up; bf16* kv;
    __device__ __forceinline__ void operator()(const f32x4 (&acc)[2][2][4][2], const Unit& u, int wr, int wc, int fr, int fq, const Pre& pre) const {
        if (u.kind == 0) up(acc, u, wr, wc, fr, fq, pre);
        else store_tile_bf16(acc, kv + (size_t)(u.pn >> 3) * (512 * D) + (size_t)u.pm * (256 * D) + (u.pn & 7) * 256, D, wr, wc, fr, fq);
    }
};
struct EpiInW {
    typedef RowPre Pre; __device__ __forceinline__ void prefetch(const Unit& u, int wr, int fr, Pre& p) const { if (u.kind == 0) inp.prefetch(u, wr, fr, p); }
    EpiInproj inp; bf16* wqkt; bf16* vwot;
    __device__ __forceinline__ void operator()(const f32x4 (&acc)[2][2][4][2], const Unit& u, int wr, int wc, int fr, int fq, const Pre& pre) const {
        const int bb = u.aux >> 2, hh = u.aux & 3;
        if (u.kind == 0) inp(acc, u, wr, wc, fr, fq, pre);
        else if (u.kind == 1) store_tile_bf16(acc, wqkt + (size_t)bb * (1024 * D) + (size_t)hh * (256 * D) + u.pm * 256, D, wr, wc, fr, fq);
        else store_tile_bf16(acc, vwot + (size_t)bb * (2048 * 1024) + (size_t)u.pm * (256 * 1024) + hh * 256, 1024, wr, wc, fr, fq);
    }
};

struct Args { const float* in[28]; float* out; unsigned char* ws; };
enum { I_X = 0, I_MEM, I_NFFN1, I_F1W1, I_F1W3, I_F1W2, I_NMIX, I_WIN, I_CONVW, I_CONVB, I_IGB, I_FGB, I_MHN, I_LBL, I_HHN, I_WPM, I_WPH, I_WOUT, I_NX, I_NMEM, I_WQ, I_WKV, I_WO,
       I_NFFN2, I_F2W1, I_F2W3, I_F2W2, I_NFIN };

struct CvtDesc { const float* src; const float* gain; bf16* dst; int ld_src, ld_dst, col0, nvalid, k0; };
__device__ __forceinline__ void cvt_load(const CvtDesc& d, int lane, f32x4 (&v)[8]) {
    const int kc = lane & 7, ng = lane >> 3; const bool ok = (4 * ng) < d.nvalid;
#pragma unroll
    for (int j = 0; j < 8; ++j) v[j] = ok ? __builtin_nontemporal_load((const GAS f32x4*)(d.src + (size_t)(d.k0 + 8 * kc + j) * d.ld_src + d.col0 + 4 * ng)) : (f32x4){0.f, 0.f, 0.f, 0.f};
}
__device__ __forceinline__ void cvt_store(const CvtDesc& d, int lane, f32x4 (&v)[8]) {
    const int kc = lane & 7, ng = lane >> 3;
    if (d.gain) {
        const f32x4 g0 = *(const f32x4*)(d.gain + d.k0 + 8 * kc), g1 = *(const f32x4*)(d.gain + d.k0 + 8 * kc + 4);
        v[0] *= g0[0]; v[1] *= g0[1]; v[2] *= g0[2]; v[3] *= g0[3]; v[4] *= g1[0]; v[5] *= g1[1]; v[6] *= g1[2]; v[7] *= g1[3];
    }
#pragma unroll
    for (int i = 0; i < 4; ++i) {
        u32x4 w; w.x = pk2(v[0][i], v[1][i]); w.y = pk2(v[2][i], v[3][i]); w.z = pk2(v[4][i], v[5][i]); w.w = pk2(v[6][i], v[7][i]);
        *(u32x4*)(d.dst + (size_t)(4 * ng + i) * d.ld_dst + d.k0 + 8 * kc) = w;
    }
}
__device__ __forceinline__ CvtDesc mk_desc(const float* src, int ld_src, int col0, int nvalid, int k0, const float* gain, bf16* dst, int ld_dst) {
    CvtDesc d; d.src = src; d.gain = gain; d.dst = dst; d.ld_src = ld_src; d.ld_dst = ld_dst; d.col0 = col0; d.nvalid = nvalid; d.k0 = k0; return d; }
__device__ __forceinline__ CvtDesc ffn_desc(int it, const float* w1, const float* w3, const float* w2, const float* gain, bf16* w13, bf16* w2t) {
    if (it < 11264) { const int nb = it % 352, kb = it / 352; const int pn = nb >> 3, bj = (nb >> 2) & 1, cb = nb & 3;
        return mk_desc(bj ? w3 : w1, FF, pn * 128 + cb * 32, 32, kb * 64, gain, w13 + (size_t)nb * 32 * D, D); }
    it -= 11264;
    const int nb = it % 64, kb = it / 64; return mk_desc(w2, D, nb * 32, 32, kb * 64, nullptr, w2t + (size_t)nb * 32 * FF, FF);
}
constexpr int N_FFN_ITEMS = 11264 + 5632;
#ifndef PHASES
#define PHASES 0xFFFFFu
#endif
#define PH(k) ((PHASES >> (k)) & 1u)
#ifndef REPS
#define REPS 0x0u
#endif
#define NREP(k) ((int)PH(k) + (int)((REPS >> (k)) & 1u))

__device__ __forceinline__ bf16x8 ldfrag(const LAS unsigned char* base, int row, int stride, int kbyte) { return *(const LAS bf16x8*)(base + row * stride + kbyte); }
#define MFMA16(a, b, c) __builtin_amdgcn_mfma_f32_16x16x32_bf16((a), (b), (c), 0, 0, 0)
__device__ __forceinline__ float wave_scan_incl(float v, int lane) {
    (void)lane;
#define WS_DPP(ctrl, rmask) v += __builtin_bit_cast(float, __builtin_amdgcn_update_dpp(0, __builtin_bit_cast(int, v), (ctrl), (rmask), 0xf, false))
    WS_DPP(0x111, 0xf); WS_DPP(0x112, 0xf); WS_DPP(0x114, 0xf); WS_DPP(0x118, 0xf);
    WS_DPP(0x142, 0xa);
    WS_DPP(0x143, 0xc);
#undef WS_DPP
    return v;
}
__device__ __forceinline__ void unpack8(const u32x4 w, float (&f)[8]) { f[0] = lo_bf(w.x); f[1] = hi_bf(w.x); f[2] = lo_bf(w.y); f[3] = hi_bf(w.y); f[4] = lo_bf(w.z); f[5] = hi_bf(w.z); f[6] = lo_bf(w.w); f[7] = hi_bf(w.w); }
__device__ __forceinline__ void put_t8(LAS unsigned char* Tt, int col0, int s, const u32x4 vw) {
    LAS bf16* p = (LAS bf16*)(Tt + col0 * 144 + s * 2);
    p[0 * 72] = (bf16)(vw.x & 0xffffu); p[1 * 72] = (bf16)(vw.x >> 16); p[2 * 72] = (bf16)(vw.y & 0xffffu); p[3 * 72] = (bf16)(vw.y >> 16);
    p[4 * 72] = (bf16)(vw.z & 0xffffu); p[5 * 72] = (bf16)(vw.z >> 16); p[6 * 72] = (bf16)(vw.w & 0xffffu); p[7 * 72] = (bf16)(vw.w >> 16);
}

struct MaRegs { u32x4 vr[4], qk[5]; float fl, ip; };
struct HaRegs { u32x4 hr[2], fr[2]; };
__device__ __forceinline__ void ma_load(int item, int tid, const GAS float* gates, const GAS bf16* QKRAW, const GAS bf16* MV, MaRegs& r) {
    const int b = item >> 8, h = (item >> 6) & 3, c = item & 63, R0 = b * T + c * 64;
#pragma unroll
    for (int i = 0; i < 4; ++i) { const int idx = tid + NTHR * i, row = idx >> 5, ch = idx & 31; r.vr[i] = *(const GAS u32x4*)(MV + (size_t)(R0 + row) * 1024 + h * 256 + ch * 8); }
#pragma unroll
    for (int j = 0; j < 5; ++j) { const int idx = tid + NTHR * j, row = idx >> 5, ch = idx & 31, tt = c * 64 - 3 + row;
        r.qk[j] = (idx < 67 * 32 && tt >= 0) ? *(const GAS u32x4*)(QKRAW + (size_t)(b * T + tt) * 1024 + (ch >> 4) * 512 + h * 128 + (ch & 15) * 8) : (u32x4){0u, 0u, 0u, 0u}; }
    r.fl = 0.f; r.ip = 0.f;
    if (tid < 64) { r.fl = gates[(size_t)(R0 + tid) * 8 + 4 + h]; r.ip = gates[(size_t)(R0 + tid) * 8 + h]; }
}
__device__ __forceinline__ void ha_load(int it, int tid, const GAS bf16* HF, const GAS bf16* HI, HaRegs& r) {
    const int b = it >> 9, h = (it >> 6) & 7, c = it & 63, R0 = b * T + c * 64;
#pragma unroll
    for (int i = 0; i < 2; ++i) { const int idx = tid + NTHR * i, row = idx >> 4, ch = idx & 15;
        r.hr[i] = *(const GAS u32x4*)(HI + (size_t)(R0 + row) * 1024 + h * 128 + ch * 8); r.fr[i] = *(const GAS u32x4*)(HF + (size_t)(R0 + row) * 1024 + h * 128 + ch * 8); }
}
__device__ __forceinline__ void mlstm_stage_convw(LAS unsigned char* lds, int h, int tid, const GAS float* convw, const GAS float* convb) {
    LAS float* CW = (LAS float*)(lds + 2048 + 18432 + 36864 + 35376 + 33792);
    if (tid < 320) { const int j = tid >> 6, c4 = tid & 63, col = (c4 >> 5) * 512 + h * 128 + (c4 & 31) * 4;
        *(LAS f32x4*)(CW + j * 256 + c4 * 4) = *(const GAS f32x4*)((j < 4 ? convw + j * 1024 : convb) + col); }
}
__device__ __forceinline__ void mlstm_state_item(LAS unsigned char* lds, int item, int tid, MaRegs& rg, int nxt, const GAS float* gates, const GAS float* convw, const GAS float* convb, const GAS bf16* QKRAW, GAS bf16* QC, GAS bf16* KC,
                                                 const GAS bf16* MV, GAS bf16* MST, GAS float* DN, GAS float* BLAST, GAS float* MLOC) {
    const int lane = tid & 63, w = __builtin_amdgcn_readfirstlane(tid >> 6), l15 = lane & 15, lg = lane >> 4;
    const int b = item >> 8, h = (item >> 6) & 3, c = item & 63, R0 = b * T + c * 64;
    LAS float* sc = (LAS float*)lds;
    LAS unsigned char* KWt = lds + 2048;
    LAS unsigned char* Vt = KWt + 18432;
    LAS unsigned char* RAW = Vt + 36864;
    LAS unsigned char* VR = RAW + 35376;
    const LAS float* CW = (const LAS float*)(VR + 33792);
    const int s = lane;
    if (w == 0) {
        const float bs = wave_scan_incl(rg.fl, lane); const float blast = __shfl(bs, 63);
        const float a = blast - bs + rg.ip; const float ml = wave_max(a);
        sc[128 + lane] = __expf(a - ml);
        if (lane == 0) { BLAST[item] = blast; MLOC[item] = ml; }
    }
#pragma unroll
    for (int i = 0; i < 4; ++i) { const int idx = tid + NTHR * i; *(LAS u32x4*)(VR + (idx >> 5) * 528 + (idx & 31) * 16) = rg.vr[i]; }
#pragma unroll
    for (int j = 0; j < 5; ++j) { const int idx = tid + NTHR * j; if (idx < 67 * 32) *(LAS u32x4*)(RAW + (idx >> 5) * 528 + (idx & 31) * 16) = rg.qk[j]; }
    if (nxt < 512) ma_load(nxt, tid, gates, QKRAW, MV, rg);
    __syncthreads();
#pragma unroll
    for (int i = 0; i < 4; ++i) put_t8(Vt, (w + 8 * i) * 8, s, *(const LAS u32x4*)(VR + s * 528 + (w + 8 * i) * 16));
    const float ws_ = sc[128 + s];
#pragma unroll
    for (int i = 0; i < 4; ++i) {
        const int g = w + 8 * i, isk = g >> 4, d0 = (g & 15) * 8, cc0 = isk * 512 + h * 128 + d0;
        float y[8];
        { const f32x4 b0 = *(const LAS f32x4*)(CW + 1024 + g * 8), b1 = *(const LAS f32x4*)(CW + 1024 + g * 8 + 4); y[0] = b0[0]; y[1] = b0[1]; y[2] = b0[2]; y[3] = b0[3]; y[4] = b1[0]; y[5] = b1[1]; y[6] = b1[2]; y[7] = b1[3]; }
#pragma unroll
        for (int j = 0; j < 4; ++j) { const f32x4 w0 = *(const LAS f32x4*)(CW + j * 256 + g * 8), w1 = *(const LAS f32x4*)(CW + j * 256 + g * 8 + 4); float x[8]; unpack8(*(const LAS u32x4*)(RAW + (s + j) * 528 + g * 16), x);
            y[0] += w0[0] * x[0]; y[1] += w0[1] * x[1]; y[2] += w0[2] * x[2]; y[3] += w0[3] * x[3]; y[4] += w1[0] * x[4]; y[5] += w1[1] * x[5]; y[6] += w1[2] * x[6]; y[7] += w1[3] * x[7]; }
#pragma unroll
        for (int e = 0; e < 8; ++e) y[e] = siluf_(y[e]) * (isk ? 0.08838834764831845f : 1.0f);
        u32x4 o; o.x = pk2(y[0], y[1]); o.y = pk2(y[2], y[3]); o.z = pk2(y[4], y[5]); o.w = pk2(y[6], y[7]);
        if (!isk) *(GAS u32x4*)(QC + (size_t)(R0 + s) * 512 + h * 128 + d0) = o;
        else { *(GAS u32x4*)(KC + (size_t)(R0 + s) * 512 + h * 128 + d0) = o;
            float kr[8]; unpack8(o, kr);
            u32x4 kw; kw.x = pk2(kr[0] * ws_, kr[1] * ws_); kw.y = pk2(kr[2] * ws_, kr[3] * ws_); kw.z = pk2(kr[4] * ws_, kr[5] * ws_); kw.w = pk2(kr[6] * ws_, kr[7] * ws_);
            put_t8(KWt, d0, s, kw); }
    }
    __syncthreads();
    if (tid < 128) {
        float n = 0.f;
#pragma unroll
        for (int j = 0; j < 8; ++j) { const u32x4 kw = *(const LAS u32x4*)(KWt + tid * 144 + j * 16);
            n += (lo_bf(kw.x) + hi_bf(kw.x)) + (lo_bf(kw.y) + hi_bf(kw.y)) + (lo_bf(kw.z) + hi_bf(kw.z)) + (lo_bf(kw.w) + hi_bf(kw.w)); }
        DN[(size_t)item * 128 + tid] = n;
    }
    {
        bf16x8 vf[2][2];
#pragma unroll
        for (int je = 0; je < 2; ++je)
#pragma unroll
            for (int kk = 0; kk < 2; ++kk) vf[je][kk] = ldfrag(Vt, 16 * (2 * w + je) + l15, 144, (32 * kk + 8 * lg) * 2);
#pragma unroll 2
        for (int dt = 0; dt < 8; ++dt) {
            const bf16x8 k0 = ldfrag(KWt, 16 * dt + l15, 144, (8 * lg) * 2), k1 = ldfrag(KWt, 16 * dt + l15, 144, (32 + 8 * lg) * 2);
#pragma unroll
            for (int je = 0; je < 2; ++je) {
                f32x4 a = {0.f, 0.f, 0.f, 0.f};
                a = MFMA16(k0, vf[je][0], a); a = MFMA16(k1, vf[je][1], a);
                u32x2 o; o.x = pk2(a[0], a[1]); o.y = pk2(a[2], a[3]);
                *(GAS u32x2*)(MST + ((size_t)item * 256 + 16 * (2 * w + je) + l15) * 128 + 16 * dt + 4 * lg) = o;
            }
        }
    }
    __syncthreads();
}

__device__ __forceinline__ void hgrn_state_item(LAS unsigned char* lds, int it, int tid, HaRegs& rg, int nxt, const GAS bf16* HF, const GAS bf16* HI, const GAS float* lbl, GAS bf16* HST, GAS float* DEC) {
    const int lane = tid & 63, w = __builtin_amdgcn_readfirstlane(tid >> 6), l15 = lane & 15, lg = lane >> 4;
    const int b = it >> 9, h = (it >> 6) & 7, c = it & 63, R0 = b * T + c * 64;
    LAS float* Gt = (LAS float*)(lds + 2048);
    LAS unsigned char* KDt = lds + 2048 + 34816;
    LAS unsigned char* Vt = KDt + 18432;
    LAS unsigned char* HR = Vt + 18432;
    LAS unsigned char* FR = HR + 17408;
    const int s = lane;
#pragma unroll
    for (int i = 0; i < 2; ++i) { const int idx = tid + NTHR * i; *(LAS u32x4*)(HR + (idx >> 4) * 272 + (idx & 15) * 16) = rg.hr[i]; *(LAS u32x4*)(FR + (idx >> 4) * 272 + (idx & 15) * 16) = rg.fr[i]; }
    if (nxt < 1024) ha_load(nxt, tid, HF, HI, rg);
    __syncthreads();
    u32x4 hv[2], fv[2];
#pragma unroll
    for (int i = 0; i < 2; ++i) { hv[i] = *(const LAS u32x4*)(HR + s * 272 + (w + 8 * i) * 16); fv[i] = *(const LAS u32x4*)(FR + s * 272 + (w + 8 * i) * 16); }
#pragma unroll
    for (int i = 0; i < 2; ++i) {
        put_t8(Vt, (w + 8 * i) * 8, s, hv[i]);
        const int d0 = (w + 8 * i) * 8, dd = h * 128 + d0; float f[8], kd[8], dl[8]; unpack8(fv[i], f);
#pragma unroll
        for (int e = 0; e < 8; ++e) { const float lbv = ((const LAS float*)(FR + 17408))[dd + e]; const float sg = sigmoidf_(f[e]);
            const float Gs = wave_scan_incl(__logf(lbv + (1.f - lbv) * sg), lane); const float Gl = __shfl(Gs, 63);
            kd[e] = (1.f - lbv) * (1.f - sg) * __expf(Gl - Gs); dl[e] = __expf(Gl); }
        u32x4 o; o.x = pk2(kd[0], kd[1]); o.y = pk2(kd[2], kd[3]); o.z = pk2(kd[4], kd[5]); o.w = pk2(kd[6], kd[7]);
        put_t8(KDt, d0, s, o);
        if (lane == 63) { *(GAS f32x4*)(DEC + (size_t)it * 128 + d0) = (f32x4){dl[0], dl[1], dl[2], dl[3]}; *(GAS f32x4*)(DEC + (size_t)it * 128 + d0 + 4) = (f32x4){dl[4], dl[5], dl[6], dl[7]}; }
    }
    __syncthreads();
    {
        const bf16x8 v0 = ldfrag(Vt, 16 * w + l15, 144, (8 * lg) * 2), v1 = ldfrag(Vt, 16 * w + l15, 144, (32 + 8 * lg) * 2);
#pragma unroll 2
        for (int dt = 0; dt < 8; ++dt) {
            f32x4 a = {0.f, 0.f, 0.f, 0.f};
            a = MFMA16(ldfrag(KDt, 16 * dt + l15, 144, (8 * lg) * 2), v0, a); a = MFMA16(ldfrag(KDt, 16 * dt + l15, 144, (32 + 8 * lg) * 2), v1, a);
            u32x2 o; o.x = pk2(a[0], a[1]); o.y = pk2(a[2], a[3]);
            *(GAS u32x2*)(HST + ((size_t)it * 128 + 16 * w + l15) * 128 + 16 * dt + 4 * lg) = o;
        }
    }
    __syncthreads();
}

struct MoRegs { u32x4 vv[4], qq[2], kq[2], cs[8]; float fl, ip, mprev, npv; };
struct HoRegs { u32x4 hv[2], fv[2], qw[2], cs[4]; };
struct OutPtrs { const GAS float* gates; const GAS float* MPREV; const GAS float* NPREV; const GAS bf16* QC; const GAS bf16* KC; const GAS bf16* MV; const GAS bf16* MST; const GAS bf16* HQ; const GAS bf16* HF; const GAS bf16* HI; const GAS bf16* HST; };
__device__ __forceinline__ void mo_load(int item, int tid, const OutPtrs& P, MoRegs& r) {
    const int lane = tid & 63, w = __builtin_amdgcn_readfirstlane(tid >> 6);
    const int b = item >> 8, h = (item >> 6) & 3, c = item & 63, R0 = b * T + c * 64;
#pragma unroll
    for (int j = 0; j < 8; ++j) { const int q = tid + NTHR * j; r.cs[j] = *(const GAS u32x4*)(P.MST + ((size_t)item * 256 + (q >> 4)) * 128 + (q & 15) * 8); }
#pragma unroll
    for (int i = 0; i < 4; ++i) r.vv[i] = *(const GAS u32x4*)(P.MV + (size_t)(R0 + lane) * 1024 + h * 256 + (w + 8 * i) * 8);
#pragma unroll
    for (int i = 0; i < 2; ++i) { const int idx = tid + NTHR * i, s = idx >> 4, ch = idx & 15;
        r.qq[i] = *(const GAS u32x4*)(P.QC + (size_t)(R0 + s) * 512 + h * 128 + ch * 8); r.kq[i] = *(const GAS u32x4*)(P.KC + (size_t)(R0 + s) * 512 + h * 128 + ch * 8); }
    r.fl = 0.f; r.ip = 0.f; r.mprev = 0.f; r.npv = 0.f;
    if (w == 0) { r.fl = P.gates[(size_t)(R0 + lane) * 8 + 4 + h]; r.ip = P.gates[(size_t)(R0 + lane) * 8 + h]; r.mprev = P.MPREV[item]; }
    if (w == 1 || w == 2) r.npv = P.NPREV[(size_t)item * 128 + (w - 1) * 64 + lane];
}
__device__ __forceinline__ void ho_load(int it, int tid, const OutPtrs& P, HoRegs& r) {
    const int lane = tid & 63, w = __builtin_amdgcn_readfirstlane(tid >> 6), d8 = tid & 15, sr = tid >> 4;
    const int b = it >> 9, h = (it >> 6) & 7, c = it & 63, R0 = b * T + c * 64;
#pragma unroll
    for (int j = 0; j < 4; ++j) { const int q = tid + NTHR * j; r.cs[j] = *(const GAS u32x4*)(P.HST + ((size_t)it * 128 + (q >> 4)) * 128 + (q & 15) * 8); }
#pragma unroll
    for (int i = 0; i < 2; ++i) { r.hv[i] = *(const GAS u32x4*)(P.HI + (size_t)(R0 + lane) * 1024 + h * 128 + (w + 8 * i) * 8);
        r.fv[i] = *(const GAS u32x4*)(P.HF + (size_t)(R0 + sr + 32 * i) * 1024 + h * 128 + d8 * 8); r.qw[i] = *(const GAS u32x4*)(P.HQ + (size_t)(R0 + sr + 32 * i) * 1024 + h * 128 + d8 * 8); }
}
__device__ __forceinline__ void mlstm_out_item(LAS unsigned char* lds, int item, int tid, const OutPtrs& P, MoRegs& rm, int nxt,
                                               const GAS bf16* MO, const GAS float* mhn, GAS bf16* YM) {
    const int lane = tid & 63, w = __builtin_amdgcn_readfirstlane(tid >> 6), l15 = lane & 15, lg = lane >> 4;
    const int b = item >> 8, h = (item >> 6) & 3, c = item & 63, R0 = b * T + c * 64;
    LAS float* sc = (LAS float*)lds;
    LAS unsigned char* Qs = lds + 4096;
    LAS unsigned char* Ks = Qs + 17408;
    LAS unsigned char* Ss = Ks + 17408;
    LAS unsigned char* Vt = Ss + 9216;
    LAS unsigned char* Cs = Vt + 36864;
    const int tt = w & 3, hh = w >> 2, t = 16 * tt + l15;
    {
#pragma unroll
        for (int i = 0; i < 2; ++i) { const int idx = tid + NTHR * i, s = idx >> 4, ch = idx & 15; *(LAS u32x4*)(Qs + s * 272 + ch * 16) = rm.qq[i]; *(LAS u32x4*)(Ks + s * 272 + ch * 16) = rm.kq[i]; }
#pragma unroll
        for (int i = 0; i < 4; ++i) put_t8(Vt, (w + 8 * i) * 8, lane, rm.vv[i]);
#pragma unroll
        for (int j = 0; j < 8; ++j) { const int q = tid + NTHR * j; *(LAS u32x4*)(Cs + (q >> 4) * 272 + (q & 15) * 16) = rm.cs[j]; }
        if (w == 0) {
            const float bs = wave_scan_incl(rm.fl, lane); float pm = rm.ip - bs;
#pragma unroll
            for (int o = 1; o < 64; o <<= 1) { const float u = __shfl_up(pm, o); if (lane >= o) pm = fmaxf(pm, u); }
            const float mt = bs + fmaxf(rm.mprev, pm);
            sc[lane] = bs; sc[64 + lane] = rm.ip; sc[128 + lane] = mt; sc[192 + lane] = __expf(bs + rm.mprev - mt);
        }
        if (w == 1 || w == 2) sc[512 + (w - 1) * 64 + lane] = rm.npv;
        if (nxt < 512) mo_load(nxt, tid, P, rm);
    }
    __syncthreads();
    bf16x8 qf[4];
#pragma unroll
    for (int kk = 0; kk < 4; ++kk) qf[kk] = ldfrag(Qs, t, 272, (32 * kk + 8 * lg) * 2);
    f32x4 a2[8];
#pragma unroll
    for (int et = 0; et < 8; ++et) { f32x4 a = {0.f, 0.f, 0.f, 0.f};
#pragma unroll
        for (int kk = 0; kk < 4; ++kk) a = MFMA16(ldfrag(Cs, 128 * hh + 16 * et + l15, 272, (32 * kk + 8 * lg) * 2), qf[kk], a);
        a2[et] = a; }
    float qn;
    {
        float acc = 0.f;
#pragma unroll
        for (int kk = 0; kk < 4; ++kk) { const f32x4 n0 = *(const LAS f32x4*)(sc + 512 + 32 * kk + 8 * lg), n1 = *(const LAS f32x4*)(sc + 512 + 32 * kk + 8 * lg + 4);
            float q8[8]; unpack8(__builtin_bit_cast(u32x4, qf[kk]), q8);
            acc += (q8[0] * n0[0] + q8[1] * n0[1]) + (q8[2] * n0[2] + q8[3] * n0[3]) + (q8[4] * n1[0] + q8[5] * n1[1]) + (q8[6] * n1[2] + q8[7] * n1[3]); }
        acc += __shfl_xor(acc, 16); acc += __shfl_xor(acc, 32); qn = acc;
    }
    {
        const float bt = sc[t], mt = sc[128 + t]; float rs = 0.f;
#pragma unroll
        for (int j = 0; j < 2; ++j) {
            const int st = 2 * hh + j; f32x4 a = {0.f, 0.f, 0.f, 0.f};
            if (st <= tt) {
#pragma unroll
                for (int kk = 0; kk < 4; ++kk) a = MFMA16(ldfrag(Ks, 16 * st + l15, 272, (32 * kk + 8 * lg) * 2), qf[kk], a);
            }
            float o[4];
#pragma unroll
            for (int r = 0; r < 4; ++r) { const int s = 16 * st + 4 * lg + r; o[r] = (s <= t) ? a[r] * __expf(bt - sc[s] + sc[64 + s] - mt) : 0.f; }
            u32x2 wv; wv.x = pk2(o[0], o[1]); wv.y = pk2(o[2], o[3]);
            *(LAS u32x2*)(Ss + t * 144 + (16 * st + 4 * lg) * 2) = wv;
            rs += (lo_bf(wv.x) + hi_bf(wv.x)) + (lo_bf(wv.y) + hi_bf(wv.y));
        }
        rs += __shfl_xor(rs, 16); rs += __shfl_xor(rs, 32);
        if (lg == 0) sc[256 + 64 * hh + t] = rs;
    }
    u32x2 mo[8];
#pragma unroll
    for (int et = 0; et < 8; ++et) mo[et] = *(const GAS u32x2*)(MO + (size_t)(R0 + t) * 1024 + h * 256 + 128 * hh + 16 * et + 4 * lg);
    __syncthreads();
    {
        const bf16x8 s0 = ldfrag(Ss, t, 144, (8 * lg) * 2), s1 = ldfrag(Ss, t, 144, (32 + 8 * lg) * 2);
        const float wi = sc[192 + t];
        const float den = (sc[256 + t] + sc[320 + t]) + wi * qn; const float dinv = 1.0f / fmaxf(fabsf(den), __expf(-sc[128 + t]));
        float q2 = 0.f;
#pragma unroll
        for (int et = 0; et < 8; ++et) {
            const int e0 = 128 * hh + 16 * et; f32x4 a1 = {0.f, 0.f, 0.f, 0.f};
            a1 = MFMA16(ldfrag(Vt, e0 + l15, 144, (8 * lg) * 2), s0, a1); a1 = MFMA16(ldfrag(Vt, e0 + l15, 144, (32 + 8 * lg) * 2), s1, a1);
#pragma unroll
            for (int r = 0; r < 4; ++r) { const float hv = (a1[r] + wi * a2[et][r]) * dinv; a2[et][r] = hv; q2 += hv * hv; }
        }
        q2 += __shfl_xor(q2, 16); q2 += __shfl_xor(q2, 32);
        if (lg == 0) sc[384 + 64 * hh + t] = q2;
        __syncthreads();
        const float rn = rsqrtf((sc[384 + t] + sc[448 + t]) * (1.0f / 256.0f) + EPS);
#pragma unroll
        for (int et = 0; et < 8; ++et) {
            const int e = 128 * hh + 16 * et + 4 * lg; const f32x4 g4 = *(const LAS f32x4*)(Cs + 69632 + e * 4);
            u32x2 o; o.x = pk2(a2[et][0] * rn * g4[0] * lo_bf(mo[et].x), a2[et][1] * rn * g4[1] * hi_bf(mo[et].x)); o.y = pk2(a2[et][2] * rn * g4[2] * lo_bf(mo[et].y), a2[et][3] * rn * g4[3] * hi_bf(mo[et].y));
            *(GAS u32x2*)(YM + (size_t)(R0 + t) * 1024 + h * 256 + e) = o;
        }
    }
    __syncthreads();
}

__device__ __forceinline__ void hgrn_out_item(LAS unsigned char* lds, int it, int tid, const OutPtrs& P, HoRegs& rh, int nxt, const GAS bf16* HG, const GAS float* lbl, const GAS float* hhn, GAS bf16* YH) {
    const int lane = tid & 63, w = __builtin_amdgcn_readfirstlane(tid >> 6), l15 = lane & 15, lg = lane >> 4;
    const int b = it >> 9, h = (it >> 6) & 7, c = it & 63, R0 = b * T + c * 64;
    LAS float* sc = (LAS float*)lds;
    LAS float* Gs = (LAS float*)(lds + 4096);
    LAS unsigned char* Qt = lds + 4096 + 32768;
    LAS unsigned char* Kt = Qt + 17408;
    LAS unsigned char* Qe = Kt + 17408;
    LAS unsigned char* As = Qe + 17408;
    LAS unsigned char* Vt = As + 9216;
    LAS unsigned char* Cs = Vt + 18432;
    const int d8 = tid & 15, sr = tid >> 4;
    const int tt = w & 3, hh = w >> 2, t = 16 * tt + l15;
    float qv[2][8], kv[2][8];
    {
#pragma unroll
        for (int j = 0; j < 4; ++j) { const int q = tid + NTHR * j; *(LAS u32x4*)(Cs + (q >> 4) * 272 + (q & 15) * 16) = rh.cs[j]; }
        float lbv[8];
        { const LAS float* LBV = (const LAS float*)(Cs + 34816); const int dd = h * 128 + d8 * 8; const f32x4 a0 = *(const LAS f32x4*)(LBV + dd), a1 = *(const LAS f32x4*)(LBV + dd + 4);
#pragma unroll
          for (int e = 0; e < 4; ++e) { lbv[e] = a0[e]; lbv[4 + e] = a1[e]; } }
#pragma unroll
        for (int i = 0; i < 2; ++i) {
            put_t8(Vt, (w + 8 * i) * 8, lane, rh.hv[i]);
            float f[8]; unpack8(rh.fv[i], f); unpack8(rh.qw[i], qv[i]); f32x4 g0, g1;
#pragma unroll
            for (int e = 0; e < 8; ++e) { const float sg = sigmoidf_(f[e]); const float g = __logf(lbv[e] + (1.f - lbv[e]) * sg); kv[i][e] = (1.f - lbv[e]) * (1.f - sg); if (e < 4) g0[e] = g; else g1[e - 4] = g; }
            *(LAS f32x4*)(Gs + (sr + 32 * i) * 128 + d8 * 8) = g0; *(LAS f32x4*)(Gs + (sr + 32 * i) * 128 + d8 * 8 + 4) = g1;
        }
    }
    u32x2 hg[4];
#pragma unroll
    for (int et = 0; et < 4; ++et) hg[et] = *(const GAS u32x2*)(HG + (size_t)(R0 + t) * 1024 + h * 128 + 64 * hh + 16 * et + 4 * lg);
    if (nxt < 512 + 1024) ho_load(nxt - 512, tid, P, rh);
    __syncthreads();
    {
        const int d = tid & 127, seg = tid >> 7; float g[16]; float Gc = 0.f;
#pragma unroll
        for (int j = 0; j < 16; ++j) g[j] = Gs[(16 * seg + j) * 128 + d];
#pragma unroll
        for (int j = 0; j < 16; ++j) { Gc += g[j]; Gs[(16 * seg + j) * 128 + d] = Gc; }
        sc[128 + seg * 128 + d] = Gc;
    }
    __syncthreads();
    {
        float t0[8], t1[8], t2[8], gm[8];
        { const f32x4 a0 = *(const LAS f32x4*)(sc + 128 + d8 * 8), a1 = *(const LAS f32x4*)(sc + 128 + d8 * 8 + 4), b0 = *(const LAS f32x4*)(sc + 256 + d8 * 8), b1 = *(const LAS f32x4*)(sc + 256 + d8 * 8 + 4),
                      c0 = *(const LAS f32x4*)(sc + 384 + d8 * 8), c1 = *(const LAS f32x4*)(sc + 384 + d8 * 8 + 4), m0 = *(const LAS f32x4*)(Gs + 31 * 128 + d8 * 8), m1 = *(const LAS f32x4*)(Gs + 31 * 128 + d8 * 8 + 4);
#pragma unroll
          for (int e = 0; e < 4; ++e) { t0[e] = a0[e]; t0[4 + e] = a1[e]; t1[e] = b0[e]; t1[4 + e] = b1[e]; t2[e] = c0[e]; t2[4 + e] = c1[e]; gm[e] = m0[e] + a0[e]; gm[4 + e] = m1[e] + a1[e]; } }
#pragma unroll
        for (int i = 0; i < 2; ++i) { const int s = sr + 32 * i, seg = s >> 4;
            const f32x4 g0 = *(const LAS f32x4*)(Gs + s * 128 + d8 * 8), g1 = *(const LAS f32x4*)(Gs + s * 128 + d8 * 8 + 4);
            float g[8] = {g0[0], g0[1], g0[2], g0[3], g1[0], g1[1], g1[2], g1[3]};
            float a[8], bq[8], cq[8];
#pragma unroll
            for (int e = 0; e < 8; ++e) { g[e] += (seg > 0 ? t0[e] : 0.f) + (seg > 1 ? t1[e] : 0.f) + (seg > 2 ? t2[e] : 0.f);
                a[e] = qv[i][e] * __expf(g[e] - gm[e]); bq[e] = kv[i][e] * __expf(gm[e] - g[e]); cq[e] = qv[i][e] * __expf(g[e]); }
            u32x4 o; o.x = pk2(a[0], a[1]); o.y = pk2(a[2], a[3]); o.z = pk2(a[4], a[5]); o.w = pk2(a[6], a[7]); *(LAS u32x4*)(Qt + s * 272 + d8 * 16) = o;
            o.x = pk2(bq[0], bq[1]); o.y = pk2(bq[2], bq[3]); o.z = pk2(bq[4], bq[5]); o.w = pk2(bq[6], bq[7]); *(LAS u32x4*)(Kt + s * 272 + d8 * 16) = o;
            o.x = pk2(cq[0], cq[1]); o.y = pk2(cq[2], cq[3]); o.z = pk2(cq[4], cq[5]); o.w = pk2(cq[6], cq[7]); *(LAS u32x4*)(Qe + s * 272 + d8 * 16) = o; }
    }
    __syncthreads();
    {
        bf16x8 qf[4];
#pragma unroll
        for (int kk = 0; kk < 4; ++kk) qf[kk] = ldfrag(Qt, t, 272, (32 * kk + 8 * lg) * 2);
#pragma unroll
        for (int j = 0; j < 2; ++j) {
            const int st = 2 * hh + j; f32x4 a = {0.f, 0.f, 0.f, 0.f};
            if (st <= tt) {
#pragma unroll
                for (int kk = 0; kk < 4; ++kk) a = MFMA16(ldfrag(Kt, 16 * st + l15, 272, (32 * kk + 8 * lg) * 2), qf[kk], a);
            }
            float o[4];
#pragma unroll
            for (int r = 0; r < 4; ++r) { const int s = 16 * st + 4 * lg + r; o[r] = (s <= t) ? a[r] : 0.f; }
            u32x2 wv; wv.x = pk2(o[0], o[1]); wv.y = pk2(o[2], o[3]);
            *(LAS u32x2*)(As + t * 144 + (16 * st + 4 * lg) * 2) = wv;
        }
    }
    f32x4 oacc[4];
    {
        bf16x8 qe[4];
#pragma unroll
        for (int kk = 0; kk < 4; ++kk) qe[kk] = ldfrag(Qe, t, 272, (32 * kk + 8 * lg) * 2);
#pragma unroll
        for (int et = 0; et < 4; ++et) { f32x4 a = {0.f, 0.f, 0.f, 0.f};
#pragma unroll
            for (int kk = 0; kk < 4; ++kk) a = MFMA16(ldfrag(Cs, 64 * hh + 16 * et + l15, 272, (32 * kk + 8 * lg) * 2), qe[kk], a);
            oacc[et] = a; }
    }
    __syncthreads();
    {
        const bf16x8 a0 = ldfrag(As, t, 144, (8 * lg) * 2), a1 = ldfrag(As, t, 144, (32 + 8 * lg) * 2);
        float q2 = 0.f;
#pragma unroll
        for (int et = 0; et < 4; ++et) {
            const int e0 = 64 * hh + 16 * et; f32x4 a = oacc[et];
            a = MFMA16(ldfrag(Vt, e0 + l15, 144, (8 * lg) * 2), a0, a); a = MFMA16(ldfrag(Vt, e0 + l15, 144, (32 + 8 * lg) * 2), a1, a);
            oacc[et] = a; q2 += (a[0] * a[0] + a[1] * a[1]) + (a[2] * a[2] + a[3] * a[3]);
        }
        q2 += __shfl_xor(q2, 16); q2 += __shfl_xor(q2, 32);
        if (lg == 0) sc[64 * hh + t] = q2;
        __syncthreads();
        const float rn = rsqrtf((sc[t] + sc[64 + t]) * (1.0f / 128.0f) + EPS);
#pragma unroll
        for (int et = 0; et < 4; ++et) {
            const int e = 64 * hh + 16 * et + 4 * lg; const f32x4 g4 = *(const LAS f32x4*)(Cs + 34816 + 4096 + (h * 128 + e) * 4);
            u32x2 o; o.x = pk2(oacc[et][0] * rn * g4[0] * lo_bf(hg[et].x), oacc[et][1] * rn * g4[1] * hi_bf(hg[et].x)); o.y = pk2(oacc[et][2] * rn * g4[2] * lo_bf(hg[et].y), oacc[et][3] * rn * g4[3] * hi_bf(hg[et].y));
            *(GAS u32x2*)(YH + (size_t)(R0 + t) * 1024 + h * 128 + e) = o;
        }
    }
    __syncthreads();
}

typedef const volatile unsigned long long __attribute__((address_space(4)))* KArgs;
#define KINP(i) ((const float*)kargs[(i)])
constexpr int I0 = N_FFN_ITEMS, I1 = I0 + 7424, I2 = I1 + 4096, I3 = I2 + 1024, I4 = I3 + 1024, I5 = I4 + 2048, I6 = I5 + 4096, I7 = I6 + 2048;
__device__ __forceinline__ CvtDesc w_desc(KArgs kargs, unsigned char* ws, int it) {
    if (it < I0) return ffn_desc(it, KINP(I_F1W1), KINP(I_F1W3), KINP(I_F1W2), KINP(I_NFFN1), (bf16*)(ws + WS_W13), (bf16*)(ws + WS_W2T));
    if (it < I1) { const int r = it - I0, nb = r % 232, kb = r / 232;
        const int col0 = nb < 96 ? nb * 32 : (nb < 224 ? nb * 32 + 8 : 3072); const int nv = nb < 224 ? 32 : (nb == 224 ? 8 : 0);
        return mk_desc(KINP(I_WIN), DIN, col0, nv, kb * 64, KINP(I_NMIX), (bf16*)(ws + WS_WIN) + (size_t)nb * 32 * D, D); }
    if (it < I2) { const int r = it - I1, nb = r % 128, kb = r / 128; return mk_desc(KINP(I_WIN), DIN, 7176 + nb * 32, 32, kb * 64, KINP(I_NMIX), (bf16*)(ws + WS_WG) + (size_t)nb * 32 * D, D); }
    if (it < I3) { const int r = it - I2, nb = r % 64, kb = r / 64; return mk_desc(KINP(I_WPM), D, nb * 32, 32, kb * 64, nullptr, (bf16*)(ws + WS_WPM) + (size_t)nb * 32 * 1024, 1024); }
    if (it < I4) { const int r = it - I3, nb = r % 64, kb = r / 64; return mk_desc(KINP(I_WPH), D, nb * 32, 32, kb * 64, nullptr, (bf16*)(ws + WS_WPH) + (size_t)nb * 32 * 1024, 1024); }
    if (it < I5) { const int r = it - I4, nb = r % 64, kb = r / 64; return mk_desc(KINP(I_WOUT), D, nb * 32, 32, kb * 64, nullptr, (bf16*)(ws + WS_WOUT) + (size_t)nb * 32 * D, D); }
    if (it < I6) { const int r = it - I5, nb = r % 128, kb = r / 128; return mk_desc(KINP(I_WKV), 2 * D, nb * 32, 32, kb * 64, nullptr, (bf16*)(ws + WS_WKV) + (size_t)nb * 32 * D, D); }
    { const int r = it - I6, nb = r % 64, kb = r / 64; return mk_desc(KINP(I_WO), D, nb * 32, 32, kb * 64, nullptr, (bf16*)(ws + WS_WO) + (size_t)nb * 32 * D, D); }
}
constexpr int WIN_P0 = 3712;
template <bool EARLY>
__device__ __forceinline__ void copy_items(KArgs kargs, unsigned char* ws, int first, int count, int cw, int ncw) {
    int ln = threadIdx.x & 63; asm volatile("" : "+v"(ln));
#pragma unroll 1
    for (int base = cw; base < count; base += 4 * ncw) {
        CvtDesc d[4]; f32x4 v[4][8];
#pragma unroll
        for (int u = 0; u < 4; ++u) { const int j = base + u * ncw; if (j < count) { d[u] = w_desc(kargs, ws, EARLY ? (j < 11264 ? j : (j < 11264 + WIN_P0 ? (I1 - WIN_P0) + (j - 11264) : I4 + (j - 11264 - WIN_P0))) : first + j); cvt_load(d[u], ln, v[u]); } }
#pragma unroll
        for (int u = 0; u < 4; ++u) { const int j = base + u * ncw; if (j < count) cvt_store(d[u], ln, v[u]); }
    }
}
__device__ __forceinline__ void wq_row(KArgs kargs, unsigned char* ws, int d, int lane) {
    const float g = KINP(I_NX)[d]; const f32x4* src = (const f32x4*)(KINP(I_WQ) + (size_t)d * D) + lane; bf16* dst = (bf16*)(ws + WS_WQ) + (size_t)d * D;
    f32x4 v[8];
#pragma unroll
    for (int j = 0; j < 8; ++j) v[j] = __builtin_nontemporal_load(src + 64 * j);
#pragma unroll
    for (int j = 0; j < 8; ++j) { const f32x4 o = v[j] * g; u32x2 w; w.x = pk2(o[0], o[1]); w.y = pk2(o[2], o[3]); *(GAS u32x2*)(dst + 256 * j + 4 * lane) = w; }
}

__global__ void __launch_bounds__(NTHR, 2) fwd_kernel(Args args) {
    extern __shared__ __attribute__((aligned(16))) unsigned char lds_raw[];
    LAS unsigned char* lds = (LAS unsigned char*)lds_raw;
    volatile LAS unsigned* MISC = (volatile LAS unsigned*)(lds + MISC_OFF);
    const int tid = threadIdx.x, lane = tid & 63, wave = __builtin_amdgcn_readfirstlane(tid >> 6);
    const int G = gridDim.x, bid = blockIdx.x;
    KArgs kargs = (KArgs)__builtin_amdgcn_kernarg_segment_ptr();
#define INP(i) ((const float*)kargs[(i)])
    unsigned char* ws = (unsigned char*)kargs[29];
    unsigned* ctl = (unsigned*)(ws + WS_CTL);
    if (tid < 64) MISC[tid] = 0u;
    __syncthreads();
    XcdBarrier bar = xcd_barrier_post(ctl + CW_BAR, MISC + 8);
    u64* ss = (u64*)(ws + WS_CTL + CTL_SS);
    const int gw = bid * NWAVES + wave, NGW = G * NWAVES;
    float* X = (float*)(ws + WS_X); bf16* XB = (bf16*)(ws + WS_XB);
    float* smallf = (float*)(ws + WS_SMALL);

    const bool split = (G == 256);
    constexpr int NEARLY = 11264 + WIN_P0 + (I7 - I4), NMID = (I1 - WIN_P0) - 11264, NLATE = I4 - I1;

    for (int rep_ = 0; rep_ < NREP(0); ++rep_) if (rep_ == 0 || (xcd_barrier(bar), true))
    {
        if (split) copy_items<true>(kargs, ws, 0, NEARLY, gw, NGW); else copy_items<false>(kargs, ws, 0, I7, gw, NGW);
#pragma unroll 1
        for (int d = gw; d < D; d += NGW) wq_row(kargs, ws, d, lane);
#pragma unroll 1
        for (int it = gw; it < 8192 + 512; it += NGW) {
            if (it < 8192) { const int row = it;
                const f32x4* src = (const f32x4*)(INP(I_X) + (size_t)row * D) + lane; bf16* dst = XB + (size_t)row * D; float s = 0.f;
                f32x4 v[8];
#pragma unroll
                for (int j = 0; j < 8; ++j) v[j] = __builtin_nontemporal_load(src + 64 * j);
#pragma unroll
                for (int j = 0; j < 8; ++j) { s += (v[j][0] * v[j][0] + v[j][1] * v[j][1]) + (v[j][2] * v[j][2] + v[j][3] * v[j][3]); u32x2 w; w.x = pk2(v[j][0], v[j][1]); w.y = pk2(v[j][2], v[j][3]); *(u32x2*)(dst + 256 * j + 4 * lane) = w; }
                s = wave_sum(s); if (lane == 0) ss[row] = (u64)(s * SS_SCALE); }
            else { const int row = it - 8192;
                const f32x4* src = (const f32x4*)(INP(I_MEM) + (size_t)row * D) + lane; const f32x4* gp = (const f32x4*)INP(I_NMEM) + lane; bf16* dst = (bf16*)(ws + WS_MEMN) + (size_t)row * D;
                f32x4 v[8]; float s = 0.f;
#pragma unroll
                for (int j = 0; j < 8; ++j) { v[j] = __builtin_nontemporal_load(src + 64 * j); s += (v[j][0] * v[j][0] + v[j][1] * v[j][1]) + (v[j][2] * v[j][2] + v[j][3] * v[j][3]); }
                const float r = rsqrtf(wave_sum(s) * (1.0f / D) + EPS);
#pragma unroll
                for (int j = 0; j < 8; ++j) { const f32x4 o = v[j] * r * gp[64 * j]; u32x2 w; w.x = pk2(o[0], o[1]); w.y = pk2(o[2], o[3]); *(u32x2*)(dst + 256 * j + 4 * lane) = w; } }
        }
    }
    xcd_barrier(bar);

    const bool LOCF = (MISC[11] != 0u);
    const int lrf = (int)MISC[10], xf = (int)bar.x;
    unsigned* rdyMID = ctl + 12416; unsigned* rdyKV = ctl + 12480;
#define FRONT_BARRIER() do { if (LOCF) xcd_local_barrier(bar, lrf & 3, ctl + 13312); else xcd_barrier(bar); } while (0)
    for (int rep_ = 0; rep_ < NREP(1); ++rep_) if (rep_ == 0 || (xcd_barrier(bar), true))
    { SchedUpKv S; S.o.init(32, 44, G, bid); S.G = G; S.c = bid; S.XBp = (const char*)XB; S.W13p = (const char*)(ws + WS_W13); S.MEMNp = (const char*)(ws + WS_MEMN); S.WKVp = (const char*)(ws + WS_WKV);
      S.loc = 0; S.p0 = 0; S.xq = 0; if (LOCF) { S.loc = 1; S.p0 = 4 * xf; S.xq = xf; S.c = lrf; }
      EpiUpKv E{EpiUp{(bf16*)(ws + AR_ACT), ss + 0 * M}, (bf16*)(ws + WS_KV)};
      pg8::gemm_phase((const char*)ws, lds, D, D, S, E);
      if (LOCF) {
          if (lrf >= 16 && lrf < 20) publish_count(rdyKV);
          if (lrf >= 20) { copy_items<false>(kargs, ws, 11264, NMID, (xf * 12 + lrf - 20) * NWAVES + wave, 96 * NWAVES); publish_count(rdyMID); }
      } else if (split && bid >= 160) copy_items<false>(kargs, ws, 11264, NMID, (bid - 160) * NWAVES + wave, 96 * NWAVES); }
    FRONT_BARRIER();
    if (LOCF) await_count(rdyMID, 96u, bar.bar);
    for (int rep_ = 0; rep_ < NREP(2); ++rep_) if (rep_ == 0 || (xcd_barrier(bar), true))
    { SchedStd S; S.o.init(32, 8, G, bid); if (LOCF) S.o.init_loc(8, 4 * xf, lrf);
      S.A = (const char*)(ws + AR_ACT); S.B = (const char*)(ws + WS_W2T); S.astep = (size_t)256 * FF * 2; S.bstep = (size_t)256 * FF * 2; S.bbatch = 0; S.nt = FF / 64;
      EpiRes<true> E{INP(I_X), XB, ss + 1 * M, 0.5f};
      pg8::gemm_phase((const char*)ws, lds, FF, FF, S, E); }
    FRONT_BARRIER();
    if (LOCF) await_count(rdyKV, 32u, bar.bar);
    for (int rep_ = 0; rep_ < NREP(3); ++rep_) if (rep_ == 0 || (xcd_barrier(bar), true))
    { SchedInW S; S.o.init(32, 29, G, bid); S.G = G; S.c = bid; S.XBp = (const char*)XB; S.WINp = (const char*)(ws + WS_WIN); S.Kp = (const char*)(ws + WS_KV); S.Vp = (const char*)(ws + WS_KV) + (size_t)512 * D * 2;
      S.WQp = (const char*)(ws + WS_WQ); S.WOp = (const char*)(ws + WS_WO);
      S.loc = 0; S.p0 = 0; S.xq = 0; if (LOCF) { S.loc = 1; S.p0 = 4 * xf; S.xq = xf; S.c = lrf; }
      EpiInW E{EpiInproj{ws, ss + 1 * M, INP(I_IGB), INP(I_FGB)}, (bf16*)(ws + WS_WQKT), (bf16*)(ws + WS_VWOT)};
      pg8::gemm_phase((const char*)ws, lds, D, D, S, E);
      if (LOCF) { if (lrf >= 24) copy_items<false>(kargs, ws, I1, NLATE, (xf * 8 + lrf - 24) * NWAVES + wave, 64 * NWAVES); }
      else if (split && bid >= 192) copy_items<false>(kargs, ws, I1, NLATE, (bid - 192) * NWAVES + wave, 64 * NWAVES); }
    xcd_barrier(bar);

    const bool LOCM = (MISC[11] != 0u);
    const int lrk = (int)MISC[10], xq = (int)bar.x;
    const int ms = LOCM ? 32 : G;
    const int m0 = LOCM ? xq * 64 + lrk : bid, m1 = LOCM ? xq * 64 + 64 : 512;
    const int h0 = LOCM ? xq * 128 + lrk : (bid + G - 512 % G) % G, h1 = LOCM ? xq * 128 + 128 : 1024;
#define MIX_BARRIER() do { if (LOCM) xcd_local_barrier(bar); else xcd_barrier(bar); } while (0)
    for (int rep_ = 0; rep_ < NREP(7); ++rep_) if (rep_ == 0 || (xcd_barrier(bar), true))
    {
        const GAS float* convw = (const GAS float*)INP(I_CONVW); const GAS float* convb = (const GAS float*)INP(I_CONVB); const GAS float* lbl = (const GAS float*)INP(I_LBL);
        const GAS float* gates = (const GAS float*)(smallf + SM_GATES / 4);
        GAS float* BLAST = (GAS float*)(smallf + SM_BLAST / 4); GAS float* MLOC = (GAS float*)(smallf + SM_MLOC / 4); GAS float* DN = (GAS float*)(smallf + SM_DN / 4); GAS float* DEC = (GAS float*)(smallf + SM_DEC / 4);
        int tid7 = threadIdx.x; asm volatile("" : "+v"(tid7));
        {   MaRegs rm; const GAS bf16* QKRAW = (const GAS bf16*)(ws + AR_QKRAW); const GAS bf16* MV = (const GAS bf16*)(ws + AR_MV);
            if (m0 < m1) { mlstm_stage_convw(lds, (m0 >> 6) & 3, tid7, convw, convb); ma_load(m0, tid7, gates, QKRAW, MV, rm); }
#pragma unroll 1
            for (int item = m0; item < m1; item += ms)
                mlstm_state_item(lds, item, tid7, rm, (item + ms < m1) ? item + ms : (1 << 20), gates, convw, convb, QKRAW, (GAS bf16*)(ws + AR_QC), (GAS bf16*)(ws + AR_KC), MV, (GAS bf16*)(ws + AR_MST), DN, BLAST, MLOC);
        }
        {   HaRegs rh;
            const GAS bf16* HF = (const GAS bf16*)(ws + AR_HF); const GAS bf16* HI = (const GAS bf16*)(ws + AR_HI);
            if (h0 < h1) { LAS float* LBV = (LAS float*)(lds + 2048 + 34816 + 18432 + 18432 + 17408 * 2);
                LBV[tid7] = sigmoidf_(lbl[1024 + tid7] - lbl[tid7]); LBV[512 + tid7] = sigmoidf_(lbl[1536 + tid7] - lbl[512 + tid7]);
                ha_load(h0, tid7, HF, HI, rh); }
#pragma unroll 1
            for (int it = h0; it < h1; it += ms)
                hgrn_state_item(lds, it, tid7, rh, (it + ms < h1) ? it + ms : (1 << 20), HF, HI, lbl, (GAS bf16*)(ws + AR_HST), DEC);
        }
    }
    MIX_BARRIER();

    for (int rep_ = 0; rep_ < NREP(8); ++rep_) if (rep_ == 0 || (xcd_barrier(bar), true))
    {
        const float* BLAST = smallf + SM_BLAST / 4; const float* MLOC = smallf + SM_MLOC / 4; float* MPREV = smallf + SM_MPREV / 4; float* DN = smallf + SM_DN / 4; const float* DEC = smallf + SM_DEC / 4;
        bf16* MST = (bf16*)(ws + AR_MST); bf16* HST = (bf16*)(ws + AR_HST);
        const int q8 = LOCM ? (lrk < 16 ? (xq << 13) + lrk * NTHR + tid : 65536 + ((2 * xq + ((lrk - 16) >> 3)) << 12) + ((lrk - 16) & 7) * NTHR + tid) : bid * NTHR + tid;
        const int q8s = LOCM ? (1 << 24) : G * NTHR;
#pragma unroll 1
        for (int q = q8; q < 131072; q += q8s) {
            if (q < 65536) {
                const int bh = q >> 13, qi = q & 8191; float m = 0.f; f32x4 C = {0.f, 0.f, 0.f, 0.f};
#define P8_LDM(c0, dw, bl, ml) _Pragma("unroll") for (int j = 0; j < 8; ++j) { const int item = bh * 64 + (c0) + j; dw[j] = *(const u32x2*)(MST + (size_t)item * 32768 + qi * 4); bl[j] = BLAST[item]; ml[j] = MLOC[item]; }
#define P8_PRM(c0, dw, bl, ml) _Pragma("unroll") for (int j = 0; j < 8; ++j) { \
                        const int item = bh * 64 + (c0) + j; u32x2 cw; cw.x = pk2(C[0], C[1]); cw.y = pk2(C[2], C[3]); *(u32x2*)(MST + (size_t)item * 32768 + qi * 4) = cw; \
                        if (qi == 0) MPREV[item] = m; \
                        const float mn = fmaxf(bl[j] + m, ml[j]), dec = __expf(bl[j] + m - mn), wl = __expf(ml[j] - mn); \
                        C[0] = dec * C[0] + wl * lo_bf(dw[j].x); C[1] = dec * C[1] + wl * hi_bf(dw[j].x); C[2] = dec * C[2] + wl * lo_bf(dw[j].y); C[3] = dec * C[3] + wl * hi_bf(dw[j].y); m = mn; }
                u32x2 dwA[8], dwB[8]; float blA[8], mlA[8], blB[8], mlB[8];
                P8_LDM(0, dwA, blA, mlA); P8_LDM(8, dwB, blB, mlB);
                P8_PRM(0, dwA, blA, mlA); P8_LDM(16, dwA, blA, mlA); P8_PRM(8, dwB, blB, mlB); P8_LDM(24, dwB, blB, mlB); P8_PRM(16, dwA, blA, mlA); P8_LDM(32, dwA, blA, mlA); P8_PRM(24, dwB, blB, mlB); P8_LDM(40, dwB, blB, mlB);
                P8_PRM(32, dwA, blA, mlA); P8_LDM(48, dwA, blA, mlA); P8_PRM(40, dwB, blB, mlB); P8_LDM(56, dwB, blB, mlB); P8_PRM(48, dwA, blA, mlA); P8_PRM(56, dwB, blB, mlB);
#undef P8_LDM
#undef P8_PRM
            } else {
                const int q2 = q - 65536, bh = q2 >> 12, qi = q2 & 4095, d = (qi * 4) & 127; f32x4 Sx = {0.f, 0.f, 0.f, 0.f};
#define P8_LDH(c0, dw, dc) _Pragma("unroll") for (int j = 0; j < 8; ++j) { const int it = bh * 64 + (c0) + j; dw[j] = *(const u32x2*)(HST + (size_t)it * 16384 + qi * 4); dc[j] = *(const f32x4*)(DEC + (size_t)it * 128 + d); }
#define P8_PRH(c0, dw, dc) _Pragma("unroll") for (int j = 0; j < 8; ++j) { \
                        const int it = bh * 64 + (c0) + j; u32x2 cw; cw.x = pk2(Sx[0], Sx[1]); cw.y = pk2(Sx[2], Sx[3]); *(u32x2*)(HST + (size_t)it * 16384 + qi * 4) = cw; \
                        Sx[0] = dc[j][0] * Sx[0] + lo_bf(dw[j].x); Sx[1] = dc[j][1] * Sx[1] + hi_bf(dw[j].x); Sx[2] = dc[j][2] * Sx[2] + lo_bf(dw[j].y); Sx[3] = dc[j][3] * Sx[3] + hi_bf(dw[j].y); }
                u32x2 dwA[8], dwB[8]; f32x4 dcA[8], dcB[8];
                P8_LDH(0, dwA, dcA); P8_LDH(8, dwB, dcB);
                P8_PRH(0, dwA, dcA); P8_LDH(16, dwA, dcA); P8_PRH(8, dwB, dcB); P8_LDH(24, dwB, dcB); P8_PRH(16, dwA, dcA); P8_LDH(32, dwA, dcA); P8_PRH(24, dwB, dcB); P8_LDH(40, dwB, dcB);
                P8_PRH(32, dwA, dcA); P8_LDH(48, dwA, dcA); P8_PRH(40, dwB, dcB); P8_LDH(56, dwB, dcB); P8_PRH(48, dwA, dcA); P8_PRH(56, dwB, dcB);
#undef P8_LDH
#undef P8_PRH
            }
        }
#pragma unroll 1
        for (int q = LOCM ? ((lrk == 0 && tid < 128) ? xq * 128 + tid : 1024) : bid * NTHR + tid; q < 1024; q += q8s) {
            const int bh = q >> 7, d = q & 127; float m = 0.f, n = 0.f;
#pragma unroll 1
            for (int c0 = 0; c0 < 64; c0 += 16) {
                float dn[16], bl[16], ml[16];
#pragma unroll
                for (int j = 0; j < 16; ++j) { const int item = bh * 64 + c0 + j; dn[j] = DN[(size_t)item * 128 + d]; bl[j] = BLAST[item]; ml[j] = MLOC[item]; }
#pragma unroll
                for (int j = 0; j < 16; ++j) { const int item = bh * 64 + c0 + j; DN[(size_t)item * 128 + d] = n;
                    const float mn = fmaxf(bl[j] + m, ml[j]), dec = __expf(bl[j] + m - mn), wl = __expf(ml[j] - mn); n = dec * n + wl * dn[j]; m = mn; }
            }
        }
    }
    MIX_BARRIER();
    for (int rep_ = 0; rep_ < NREP(9); ++rep_) if (rep_ == 0 || (xcd_barrier(bar), true))
    {
        const GAS float* lbl = (const GAS float*)INP(I_LBL); const GAS float* mhn = (const GAS float*)INP(I_MHN); const GAS float* hhn = (const GAS float*)INP(I_HHN);
        const GAS float* gates = (const GAS float*)(smallf + SM_GATES / 4); const GAS float* MPREV = (const GAS float*)(smallf + SM_MPREV / 4); const GAS float* NPREV = (const GAS float*)(smallf + SM_DN / 4);
        int tid9 = threadIdx.x; asm volatile("" : "+v"(tid9));
        const OutPtrs OP{gates, MPREV, NPREV, (const GAS bf16*)(ws + AR_QC), (const GAS bf16*)(ws + AR_KC), (const GAS bf16*)(ws + AR_MV), (const GAS bf16*)(ws + AR_MST),
                         (const GAS bf16*)(ws + AR_HQ), (const GAS bf16*)(ws + AR_HF), (const GAS bf16*)(ws + AR_HI), (const GAS bf16*)(ws + AR_HST)};
        {   MoRegs rm;
            if (m0 < m1) { if (tid9 < 64) *(LAS f32x4*)(lds + 4096 + 17408 * 2 + 9216 + 36864 + 69632 + tid9 * 16) = *(const GAS f32x4*)(mhn + ((m0 >> 6) & 3) * 256 + tid9 * 4);
                             mo_load(m0, tid9, OP, rm); }
#pragma unroll 1
            for (int item = m0; item < m1; item += ms)
                mlstm_out_item(lds, item, tid9, OP, rm, (item + ms < m1) ? item + ms : (1 << 20), (const GAS bf16*)(ws + AR_MO), mhn, (GAS bf16*)(ws + AR_YM));
        }
        {   HoRegs rh; const int first = 512 + h0;
            if (h0 < h1) {
                LAS float* LBV = (LAS float*)(lds + 4096 + 32768 + 17408 * 3 + 9216 + 18432 + 34816);
                LBV[tid9] = sigmoidf_(lbl[1024 + tid9] - lbl[tid9]); LBV[512 + tid9] = sigmoidf_(lbl[1536 + tid9] - lbl[512 + tid9]);
                LBV[1024 + tid9] = hhn[tid9]; LBV[1536 + tid9] = hhn[512 + tid9];
                __syncthreads();
                ho_load(first - 512, tid9, OP, rh); }
#pragma unroll 1
            for (int item = first; item < 512 + h1; item += ms)
                hgrn_out_item(lds, item - 512, tid9, OP, rh, (item + ms < 512 + h1) ? item + ms : (1 << 20), (const GAS bf16*)(ws + AR_HG), lbl, hhn, (GAS bf16*)(ws + AR_YH));
        }
    }

    for (int rep_ = 0; rep_ < NREP(10); ++rep_) if (rep_ == 0 || (xcd_barrier(bar), true))
    { SchedStd S; S.o.init(32, 16, G, bid); if (LOCM) S.o.init_loc(16, 4 * xq, lrk);
      S.A = (const char*)XB; S.B = (const char*)(ws + WS_WG); S.astep = 256 * D * 2; S.bstep = 256 * D * 2; S.bbatch = 0; S.nt = 32;
      EpiGates E{(bf16*)(ws + AR_GM), (bf16*)(ws + AR_GH), ss + 1 * M};
      pg8::gemm_phase((const char*)ws, lds, D, D, S, E); }
    xcd_barrier(bar);
    const bool LOC = (MISC[11] != 0u);
    const int lrank = (int)MISC[10], lp0 = 4 * (int)bar.x;
    unsigned* rdyW13 = ctl + 12288; unsigned* rdyW2T = ctl + 12352;
#define PHASE_BARRIER() do { if (LOC) xcd_local_barrier(bar, lrank & 3, ctl + 13312); else xcd_barrier(bar); } while (0)
    for (int rep_ = 0; rep_ < NREP(11); ++rep_) if (rep_ == 0 || (xcd_barrier(bar), true))
    { SchedPair S{G, bid, (const char*)(ws + AR_YM), (const char*)(ws + AR_YH), (const char*)(ws + WS_WPM), (const char*)(ws + WS_WPH), 0, 0};
      if (LOC) { S.loc = 1; S.p0 = lp0; S.c = lrank; }
      EpiProj E{(const bf16*)(ws + AR_GM), (const bf16*)(ws + AR_GH), (bf16*)(ws + AR_MERGED)};
      pg8::gemm_phase((const char*)ws, lds, 1024, 1024, S, E); }
    PHASE_BARRIER();
    for (int rep_ = 0; rep_ < NREP(12); ++rep_) if (rep_ == 0 || (xcd_barrier(bar), true))
    { SchedStd S; S.o.init(32, 8, G, bid); if (LOC) S.o.init_loc(8, lp0, lrank);
      S.A = (const char*)(ws + AR_MERGED); S.B = (const char*)(ws + WS_WOUT); S.astep = 256 * D * 2; S.bstep = 256 * D * 2; S.bbatch = 0; S.nt = 32;
      EpiRes<false> E{nullptr, XB, ss + 2 * M, 1.0f};
      pg8::gemm_phase((const char*)ws, lds, D, D, S, E); }
    PHASE_BARRIER();
    for (int rep_ = 0; rep_ < NREP(13); ++rep_) if (rep_ == 0 || (xcd_barrier(bar), true))
    { SchedStd S; S.o.init(32, 4, G, bid); if (LOC) S.o.init_loc(4, lp0, lrank);
      S.A = (const char*)XB; S.B = (const char*)(ws + WS_WQKT); S.astep = 256 * D * 2; S.bstep = 256 * D * 2; S.bbatch = (size_t)1024 * D * 2; S.nt = 32;
      EpiScores E{(bf16*)(ws + AR_P), ss + 2 * M, (LAS float*)(lds + RING_BYTES)};
      pg8::gemm_phase((const char*)ws, lds, D, D, S, E);
      const int cfirst = (G > 128) ? 128 : 0, nconv = (G - cfirst) * NWAVES;
      const bool copier = LOC ? (lrank >= 16) : (bid >= cfirst); const int cidx = LOC ? ((int)bar.x * 16 + lrank - 16) : (bid - cfirst);
      if (copier) {
          const float* w1 = INP(I_F2W1); const float* w3 = INP(I_F2W3); const float* w2 = INP(I_F2W2); const float* gn = INP(I_NFFN2);
          const int nit = (G == 256) ? 11264 : N_FFN_ITEMS;
#pragma unroll 1
          for (int base = cidx * NWAVES + wave; base < nit; base += 4 * nconv) {
              CvtDesc d[4]; f32x4 v[4][8];
#pragma unroll
              for (int u = 0; u < 4; ++u) { const int it = base + u * nconv; if (it < nit) { d[u] = ffn_desc(it, w1, w3, w2, gn, (bf16*)(ws + WS_W13), (bf16*)(ws + WS_W2T)); cvt_load(d[u], lane, v[u]); } }
#pragma unroll
              for (int u = 0; u < 4; ++u) { const int it = base + u * nconv; if (it < nit) cvt_store(d[u], lane, v[u]); }
          }
          if (LOC) publish_count(rdyW13);
      } }
    PHASE_BARRIER();
    for (int rep_ = 0; rep_ < NREP(15); ++rep_) if (rep_ == 0 || (xcd_barrier(bar), true))
    { SchedStd S; S.o.init(32, 8, G, bid); if (LOC) S.o.init_loc(8, lp0, lrank);
      S.A = (const char*)(ws + AR_P); S.B = (const char*)(ws + WS_VWOT); S.astep = 256 * 1024 * 2; S.bstep = 256 * 1024 * 2; S.bbatch = (size_t)2048 * 1024 * 2; S.nt = 16;
      EpiRes<false> E{nullptr, XB, ss + 3 * M, 1.0f};
      pg8::gemm_phase((const char*)ws, lds, 1024, 1024, S, E); }
    PHASE_BARRIER();
    if (LOC) await_count(rdyW13, 128u, bar.bar);
    for (int rep_ = 0; rep_ < NREP(16); ++rep_) if (rep_ == 0 || (xcd_barrier(bar), true))
    { SchedStd S; S.o.init(32, 44, G, bid); if (LOC) S.o.init_loc(44, lp0, lrank);
      S.A = (const char*)XB; S.B = (const char*)(ws + WS_W13); S.astep = 256 * D * 2; S.bstep = 256 * D * 2; S.bbatch = 0; S.nt = 32;
      EpiUp E{(bf16*)(ws + AR_ACT), ss + 3 * M};
      pg8::gemm_phase((const char*)ws, lds, D, D, S, E);
      const bool copier16 = LOC ? (lrank >= 16) : (bid >= 128); const int cidx16 = LOC ? ((int)bar.x * 16 + lrank - 16) : (bid - 128);
      if (G == 256 && copier16) {
          const float* w1 = INP(I_F2W1); const float* w3 = INP(I_F2W3); const float* w2 = INP(I_F2W2); const float* gn = INP(I_NFFN2); const int nconv = 128 * NWAVES;
          int ln16 = threadIdx.x & 63; asm volatile("" : "+v"(ln16));
#pragma unroll 1
          for (int base = 11264 + cidx16 * NWAVES + wave; base < N_FFN_ITEMS; base += 4 * nconv) {
              CvtDesc d[4]; f32x4 v[4][8];
#pragma unroll
              for (int u = 0; u < 4; ++u) { const int it = base + u * nconv; if (it < N_FFN_ITEMS) { d[u] = ffn_desc(it, w1, w3, w2, gn, (bf16*)(ws + WS_W13), (bf16*)(ws + WS_W2T)); cvt_load(d[u], ln16, v[u]); } }
#pragma unroll
              for (int u = 0; u < 4; ++u) { const int it = base + u * nconv; if (it < N_FFN_ITEMS) cvt_store(d[u], ln16, v[u]); }
          }
          if (LOC) publish_count(rdyW2T);
      } }
    PHASE_BARRIER();
    if (LOC) await_count(rdyW2T, 128u, bar.bar);
    if (G == 256) {
        SchedStd S; S.o.init(32, 8, G, bid); if (LOC) S.o.init_loc(8, lp0, lrank); S.A = (const char*)(ws + AR_ACT); S.B = (const char*)(ws + WS_W2T); S.astep = (size_t)256 * FF * 2; S.bstep = (size_t)256 * FF * 2; S.bbatch = 0; S.nt = FF / 64;
        EpiResFinal E{XB, (float*)kargs[28], INP(I_NFIN), ss + 4 * M, ctl + CW_PANEL, 0.5f};
        pg8::gemm_phase((const char*)ws, lds, FF, FF, S, E);
    } else {
        { SchedStd S; S.o.init(32, 8, G, bid); S.A = (const char*)(ws + AR_ACT); S.B = (const char*)(ws + WS_W2T); S.astep = (size_t)256 * FF * 2; S.bstep = (size_t)256 * FF * 2; S.bbatch = 0; S.nt = FF / 64;
          EpiRes<false> E{nullptr, XB, ss + 4 * M, 0.5f};
          pg8::gemm_phase((const char*)ws, lds, FF, FF, S, E); }
        xcd_barrier(bar);
        for (int row = gw; row < M; row += NGW) {
            const float r = rinv_of(ss + 4 * M, row);
            const u32x2* src = (const u32x2*)(XB + (size_t)row * D) + lane; const f32x4* gp = (const f32x4*)INP(I_NFIN) + lane; f32x4* dst = (f32x4*)((float*)kargs[28] + (size_t)row * D) + lane;
#pragma unroll
            for (int j = 0; j < 8; ++j) { const u32x2 xw = src[64 * j]; const f32x4 xv = {lo_bf(xw.x), hi_bf(xw.x), lo_bf(xw.y), hi_bf(xw.y)}; dst[64 * j] = xv * r * gp[64 * j]; }
        }
    }
}

extern "C" void kernel_launch(void* const* d_in, const int* in_sizes, int n_in, void* d_out, int out_size, void* d_ws, size_t ws_size, hipStream_t stream) {
    static int grid = 0;
    if (grid == 0) {
        if (n_in != 28 || in_sizes[0] != M * D || out_size != M * D || ws_size < WS_END) {
            fprintf(stderr, "kernel_launch: unexpected problem: n_in %d in0 %d out %d ws %zu (need %zu)\n", n_in, n_in > 0 ? in_sizes[0] : -1, out_size, ws_size, (size_t)WS_END); grid = -1; return; }
        int dev = 0, cus = 0;
        if (hipGetDevice(&dev) != hipSuccess || hipDeviceGetAttribute(&cus, hipDeviceAttributeMultiprocessorCount, dev) != hipSuccess) { fprintf(stderr, "kernel_launch: device query failed\n"); grid = -1; return; }
        if (hipFuncSetAttribute((const void*)fwd_kernel, hipFuncAttributeMaxDynamicSharedMemorySize, LDS_BYTES) != hipSuccess) { fprintf(stderr, "kernel_launch: hipFuncSetAttribute failed\n"); grid = -1; return; }
        int per_cu = 0;
        if (hipOccupancyMaxActiveBlocksPerMultiprocessor(&per_cu, (const void*)fwd_kernel, NTHR, LDS_BYTES) != hipSuccess || per_cu < 1) fprintf(stderr, "kernel_launch: note: occupancy query reports %d\n", per_cu);
        (void)hipGetLastError();
        grid = cus;
    }
    if (grid < 0) return;
    if (hipMemsetAsync((char*)d_ws + WS_CTL, 0, CTL_ZERO_BYTES, stream) != hipSuccess) { fprintf(stderr, "kernel_launch: memset failed\n"); return; }
    Args a{};
    for (int i = 0; i < 28; ++i) a.in[i] = (const float*)d_in[i];
    a.out = (float*)d_out; a.ws = (unsigned char*)d_ws;
    hipLaunchKernelGGL(fwd_kernel, dim3(grid), dim3(NTHR), LDS_BYTES, stream, a);
}
```

```cpp
#include <hip/hip_runtime.h>
#include <cstdio>
#include <cstdint>

#define LAS __attribute__((address_space(3)))
#define GAS __attribute__((address_space(1)))
typedef unsigned short bf16;
typedef short bf16x8 __attribute__((ext_vector_type(8)));
typedef float f32x4 __attribute__((ext_vector_type(4)));
typedef float f32x2 __attribute__((ext_vector_type(2)));
typedef unsigned u32x4 __attribute__((ext_vector_type(4)));
typedef unsigned u32x2 __attribute__((ext_vector_type(2)));
typedef unsigned long long u64;

constexpr int NB = 2, T = 4096, D = 2048, FF = 5632, M = NB * T;
constexpr int MEM = 256, DIN = 11272;
constexpr float EPS = 1e-6f;
constexpr int NWAVES = 8, NTHR = 512;

constexpr size_t MiB = 1u << 20;
constexpr size_t WS_CTL = 0, CTL_ZERO_BYTES = 1 * MiB;
constexpr size_t WS_SMALL = 1 * MiB;
constexpr size_t WS_MEMN = 3 * MiB;
constexpr size_t WS_KV = 5 * MiB;
constexpr size_t WS_WQKT = 9 * MiB;
constexpr size_t WS_VWOT = 17 * MiB;
constexpr size_t WS_W13 = 25 * MiB;
constexpr size_t WS_W2T = 69 * MiB;
constexpr size_t WS_WIN = 91 * MiB;
constexpr size_t WS_WG = 120 * MiB;
constexpr size_t WS_WPM = 136 * MiB, WS_WPH = 140 * MiB;
constexpr size_t WS_WOUT = 144 * MiB;
constexpr size_t WS_WQ = 152 * MiB;
constexpr size_t WS_WKV = 160 * MiB;
constexpr size_t WS_WO = 176 * MiB;
constexpr size_t WS_X = 184 * MiB;
constexpr size_t WS_XB = 248 * MiB;
constexpr size_t WS_AR = 280 * MiB;
constexpr size_t WS_END = 512 * MiB;
constexpr size_t AR_ACT = WS_AR;
constexpr size_t AR_QKRAW = WS_AR, AR_QC = WS_AR + 16 * MiB, AR_KC = WS_AR + 24 * MiB, AR_MV = WS_AR + 32 * MiB, AR_MO = WS_AR + 48 * MiB;
constexpr size_t AR_HQ = WS_AR + 64 * MiB, AR_HF = WS_AR + 80 * MiB, AR_HI = WS_AR + 96 * MiB, AR_HG = WS_AR + 112 * MiB;
constexpr size_t AR_MST = WS_AR + 128 * MiB;
constexpr size_t AR_HST = WS_AR + 160 * MiB;
constexpr size_t AR_YM = WS_AR + 192 * MiB, AR_YH = WS_AR + 208 * MiB;
constexpr size_t AR_GM = WS_X, AR_GH = WS_X + 32 * MiB;
constexpr size_t AR_TMP = WS_AR;
constexpr size_t AR_MERGED = WS_AR + 64 * MiB;
constexpr size_t AR_SC = WS_AR;
constexpr size_t AR_P = WS_AR + 32 * MiB;
static_assert(AR_YH + 16 * MiB <= WS_END, "arena");
constexpr size_t SM_GATES = 0;
constexpr size_t SM_BLAST = 256 * 1024;
constexpr size_t SM_MLOC = SM_BLAST + 2048;
constexpr size_t SM_MPREV = SM_MLOC + 2048;
constexpr size_t SM_DN = 512 * 1024;
constexpr size_t SM_DEC = 768 * 1024;
constexpr int CW_BAR = 4096;
constexpr int CW_PANEL = 8192;
constexpr size_t CTL_SS = 64 * 1024;
constexpr float SS_SCALE = 16777216.0f, SS_INV = 1.0f / (16777216.0f * 2048.0f);

constexpr int LDS_BYTES = 163840, RING_BYTES = 131072, MISC_OFF = LDS_BYTES - 256;

#define RLX_AGENT __ATOMIC_RELAXED, __HIP_MEMORY_SCOPE_AGENT
__device__ __forceinline__ unsigned f2bf(float f) { unsigned u = __builtin_bit_cast(unsigned, f); return (u + 0x7fffu + ((u >> 16) & 1u)) >> 16; }
__device__ __forceinline__ float bf2f(unsigned h) { return __builtin_bit_cast(float, (h & 0xffffu) << 16); }
typedef float f32x2_t __attribute__((ext_vector_type(2))); typedef __bf16 bf16x2_t __attribute__((ext_vector_type(2)));
__device__ __forceinline__ unsigned pk2(float lo, float hi) { f32x2_t v = {lo, hi}; bf16x2_t b = __builtin_convertvector(v, bf16x2_t); return __builtin_bit_cast(unsigned, b); }
__device__ __forceinline__ float lo_bf(unsigned w) { return __builtin_bit_cast(float, w << 16); }
__device__ __forceinline__ float hi_bf(unsigned w) { return __builtin_bit_cast(float, w & 0xffff0000u); }
__device__ __forceinline__ float sigmoidf_(float x) { return __builtin_amdgcn_rcpf(1.0f + __expf(-x)); }
__device__ __forceinline__ float siluf_(float x) { return x * __builtin_amdgcn_rcpf(1.0f + __expf(-x)); }
__device__ __forceinline__ float wave_sum(float v) {
#pragma unroll
    for (int o = 1; o < 64; o <<= 1) v += __shfl_xor(v, o);
    return v;
}
__device__ __forceinline__ float wave_max(float v) {
#pragma unroll
    for (int o = 1; o < 64; o <<= 1) v = fmaxf(v, __shfl_xor(v, o));
    return v;
}

#define XB_TMO      128
#define XB_XCNT(j)  (256  + 64 * (j))
#define XB_XSUB(j)  (1280 + 64 * (j))
#define XB_XGEN(j)  (2304 + 64 * (j))
#define XB_TOP      3328
#define XB_TOPGEN   3392
#define XCD_BAR_WORDS 3456
#define XB_LSUB(j)  (3456 + 32 * (j))
#define XB_LGEN(j)  (3712 + 32 * (j))
#define XB_SPIN_CAP (1u << 18)
__device__ __forceinline__ unsigned xb_ld(unsigned* p)              { return __hip_atomic_load(p, __ATOMIC_RELAXED, __HIP_MEMORY_SCOPE_AGENT); }
__device__ __forceinline__ unsigned xb_add(unsigned* p, unsigned v) { return __hip_atomic_fetch_add(p, v, __ATOMIC_RELAXED, __HIP_MEMORY_SCOPE_AGENT); }
__device__ __forceinline__ unsigned xb_xcc_id() { return (unsigned)__builtin_amdgcn_s_getreg((3 << 11) | 20) & 0xFu; }
#define XB_SPIN(cond, bar) do { unsigned _sp = 0; while (cond) { __builtin_amdgcn_s_sleep(1); \
    if ((++_sp & 255u) == 0u) { if (xb_ld(&(bar)[XB_TMO])) break; if (_sp > XB_SPIN_CAP) { atomicAdd(&(bar)[XB_TMO], 1u); break; } } } } while (0)
struct XcdBarrier { unsigned* bar; unsigned x; volatile LAS unsigned* st; };
__device__ __forceinline__ XcdBarrier xcd_barrier_post(unsigned* bar, volatile LAS unsigned* st) {
    XcdBarrier b; b.bar = bar; b.x = xb_xcc_id(); b.st = st;
    if (threadIdx.x == 0) st[2] = xb_add(&bar[XB_XCNT(b.x)], 1u);
    return b;
}
__device__ __forceinline__ void xcd_barrier_complete(unsigned* bar, unsigned x, unsigned& nloc, unsigned& nx, unsigned& uniform) {
    const unsigned G = gridDim.x * gridDim.y * gridDim.z;
    unsigned sum, cnt, mine, sp = 0u;
    for (;;) {
        sum = 0u; cnt = 0u; mine = 0u;
#pragma unroll
        for (unsigned j = 0; j < 16; ++j) { const unsigned c = xb_ld(&bar[XB_XCNT(j)]); sum += c; cnt += (c > 0u) ? 1u : 0u; mine = (j == x) ? c : mine; }
        if (sum == G) break;
        __builtin_amdgcn_s_sleep(1);
        if ((++sp & 255u) == 0u) { if (xb_ld(&bar[XB_TMO])) break; if (sp > XB_SPIN_CAP) { atomicAdd(&bar[XB_TMO], 1u); break; } }
    }
    nloc = mine > 0u ? mine : 1u; nx = cnt > 0u ? cnt : 1u;
    uniform = (G == 256u && cnt == 8u) ? 1u : 0u;
#pragma unroll
    for (unsigned j = 0; j < 8; ++j) if (xb_ld(&bar[XB_XCNT(j)]) != 32u) uniform = 0u;
}
__device__ __forceinline__ void xcd_barrier(const XcdBarrier& b) {
    asm volatile("s_waitcnt vmcnt(0)" ::: "memory");
    __syncthreads();
    if (threadIdx.x == 0) {
        unsigned* bar = b.bar;
        __builtin_amdgcn_s_waitcnt(0);
        unsigned nloc = b.st[0], nx = b.st[1];
        if (nloc == 0u) { unsigned uni; xcd_barrier_complete(bar, b.x, nloc, nx, uni); b.st[0] = nloc; b.st[1] = nx; b.st[3] = uni; }
        const unsigned old = xb_add(&bar[XB_XSUB(b.x)], 1u);
        const unsigned gen = old / nloc;
        if (old + 1u == (gen + 1u) * nloc) {
            __builtin_amdgcn_fence(__ATOMIC_RELEASE, "agent");
            asm volatile("s_waitcnt vmcnt(0)" ::: "memory");
            const unsigned og = xb_add(&bar[XB_TOP], 1u);
            const unsigned tg = og / nx;
            if (og + 1u == (tg + 1u) * nx) xb_add(&bar[XB_TOPGEN], 1u);
            else XB_SPIN(xb_ld(&bar[XB_TOPGEN]) == tg, bar);
            xb_add(&bar[XB_XGEN(b.x)], 1u);
            __builtin_amdgcn_fence(__ATOMIC_ACQUIRE, "agent");
            asm volatile("s_waitcnt vmcnt(0)" ::: "memory");
        } else {
            XB_SPIN(xb_ld(&bar[XB_XGEN(b.x)]) == gen, bar);
            __builtin_amdgcn_fence(__ATOMIC_ACQUIRE, "agent");
            asm volatile("s_waitcnt vmcnt(0)" ::: "memory");
        }
    }
    __syncthreads();
}

__device__ __forceinline__ void xcd_local_barrier(const XcdBarrier& b, const int pg = -1, unsigned* pgw = nullptr) {
    asm volatile("s_waitcnt vmcnt(0)" ::: "memory");
    __syncthreads();
    if (threadIdx.x == 0) {
        unsigned* bar = b.bar;
        __builtin_amdgcn_s_waitcnt(0);
        const unsigned nloc = pg < 0 ? b.st[0] : 8u;
        unsigned* sub = pg < 0 ? &bar[XB_LSUB(b.x)] : pgw + 64 * (4 * (int)b.x + pg); unsigned* gnp = pg < 0 ? &bar[XB_LGEN(b.x)] : pgw + 64 * (4 * (int)b.x + pg) + 32;
        const unsigned old = xb_add(sub, 1u);
        asm volatile("buffer_inv sc1" ::: "memory");
        const unsigned gen = old / nloc;
        if (old + 1u == (gen + 1u) * nloc) xb_add(gnp, 1u);
        else XB_SPIN(xb_ld(gnp) == gen, bar);
        asm volatile("s_waitcnt vmcnt(0)" ::: "memory");
    }
    __syncthreads();
}
__device__ __forceinline__ void publish_count(unsigned* ctr) {
    asm volatile("s_waitcnt vmcnt(0)" ::: "memory");
    __syncthreads();
    if (threadIdx.x == 0) { __builtin_amdgcn_fence(__ATOMIC_RELEASE, "agent"); asm volatile("s_waitcnt vmcnt(0)" ::: "memory"); xb_add(ctr, 1u); }
}
__device__ __forceinline__ void await_count(unsigned* ctr, unsigned n, unsigned* bar) {
    if (threadIdx.x == 0) { XB_SPIN(xb_ld(ctr) < n, bar); __builtin_amdgcn_fence(__ATOMIC_ACQUIRE, "agent"); asm volatile("s_waitcnt vmcnt(0)" ::: "memory"); }
    __syncthreads();
}

namespace pg8 {
constexpr int BM = 256, BK = 64, HALF = 128, HTB = HALF * BK * 2, STAGE_BYTES = 8 * HTB, NXCD = 8, WGM = 8;
__host__ __device__ __forceinline__ int lds_byte(int r, int c) { return r * 128 + (((c >> 3) ^ (r & 7)) * 16) + (c & 7) * 2; }
__host__ __device__ __forceinline__ void stage_rc(int b, int& R, int& C) { const int pc = b / 1024, sb = b % 1024, r8 = sb / 128, pos = (sb % 128) / 16; R = pc * 8 + r8; C = (pos ^ r8) * 8; }
__host__ __device__ __forceinline__ int perm32(int rho) { const int n = rho >> 4, i = rho & 15; return 8 * (i >> 2) + 4 * n + (i & 3); }

struct Unit { int pm, pn, kind, aux, nt; };

struct TileOrder {
    int nM, nN, nwg, G, c, loc, p0;
    __device__ void init(int nM_, int nN_, int G_, int c_) { nM = nM_; nN = nN_; nwg = nM * nN; G = G_; c = c_; loc = 0; p0 = 0; }
    __device__ void init_loc(int nN_, int p0_, int lrank) { nM = 4; nN = nN_; nwg = 4 * nN_; G = 32; c = lrank; loc = 1; p0 = p0_; }
    __device__ bool tile(int i, int& pm, int& pn) const {
        if (loc) { const int L = i * 32 + c; if (L >= nwg) return false; pm = p0 + (L & 3); pn = L >> 2; return true; }
        return tileL((long)i * G + c, pm, pn); }
    __device__ bool tileL(long L, int& pm, int& pn) const {
        if (L >= nwg) return false;
        int wgid = (int)L; { const int q = nwg / NXCD, r = nwg % NXCD, xcd = wgid % NXCD, off = wgid / NXCD; wgid = (xcd < r ? xcd * (q + 1) : r * (q + 1) + (xcd - r) * q) + off; }
        const int nig = WGM * nN, gid = wgid / nig, fm = gid * WGM, gsz = (nM - fm) < WGM ? (nM - fm) : WGM;
        pm = fm + ((wgid % nig) % gsz); pn = (wgid % nig) / gsz; return true;
    }
};

template <class Epi, class Sched>
__device__ __forceinline__ void gemm_phase(const char* wsb, LAS unsigned char* lds, const int lda, const int ldb, const Sched& S, const Epi& E) {
    int tid_ = threadIdx.x; asm volatile("" : "+v"(tid_));
    const int tid = tid_, wid = __builtin_amdgcn_readfirstlane(tid >> 6), lane = tid & 63, wr = wid >> 2, wc = wid & 3, fr = lane & 15, fq = lane >> 4;
    unsigned voffA, voffB;
    { int R, C; stage_rc(tid * 16, R, C); const int Rb = (R & ~31) + perm32(R & 31);
      voffA = (unsigned)(R * lda + C) * 2u; voffB = (unsigned)(Rb * ldb + C) * 2u; }
    const unsigned hpA = 64u * (unsigned)lda * 2u, hpB = 64u * (unsigned)ldb * 2u;
    const __amdgpu_buffer_rsrc_t rsW = __builtin_amdgcn_make_buffer_rsrc((void*)wsb, (short)0, 0x7fffffff, 0x00020000);
    const size_t kstep = (size_t)(BK * 2);
    const size_t hstepA = (size_t)HALF * lda * 2, hstepB = (size_t)HALF * ldb * 2;
    const unsigned ldsw = (unsigned)wid * 1024u;
    const int aoff = lds_byte(wr * 64 + fr, fq * 8), boff = lds_byte(wc * 32 + fr, fq * 8), aoff1 = aoff ^ 64, boff1 = boff ^ 64;
#define PG8_SA(b, h) (((b) * 2 + (h)) * HTB)
#define PG8_SB(b, h) ((4 + (b) * 2 + (h)) * HTB)
#define PG8_STAGE(bufoff, gbase, voff, hp) do { const unsigned so_ = (unsigned)((const char*)(gbase) - wsb); \
        __builtin_amdgcn_raw_ptr_buffer_load_lds(rsW, (LAS unsigned*)(lds + (bufoff) + ldsw), 16, (voff), so_, 0, 0); \
        __builtin_amdgcn_raw_ptr_buffer_load_lds(rsW, (LAS unsigned*)(lds + (bufoff) + ldsw + 8192), 16, (voff), so_ + (hp), 0, 0); } while (0)
#define PG8_LDA(dst, b, h) do { _Pragma("unroll") for (int m = 0; m < 4; ++m) _Pragma("unroll") for (int k = 0; k < 2; ++k) dst[m][k] = *(const LAS bf16x8*)(lds + PG8_SA(b, h) + (k ? aoff1 : aoff) + m * 2048); } while (0)
#define PG8_LDB(dst, b, h) do { _Pragma("unroll") for (int n = 0; n < 2; ++n) _Pragma("unroll") for (int k = 0; k < 2; ++k) dst[n][k] = *(const LAS bf16x8*)(lds + PG8_SB(b, h) + (k ? boff1 : boff) + n * 2048); } while (0)
#define PG8_MMA(ai, bj, At, Bt) do { __builtin_amdgcn_s_setprio(1); _Pragma("unroll") for (int m = 0; m < 4; ++m) _Pragma("unroll") for (int n = 0; n < 2; ++n) _Pragma("unroll") for (int k = 0; k < 2; ++k) \
        acc[ai][bj][m][n] = __builtin_amdgcn_mfma_f32_16x16x32_bf16(Bt[n][k], At[m][k], acc[ai][bj][m][n], 0, 0, 0); __builtin_amdgcn_s_setprio(0); } while (0)
#define PG8_WAIT_V(n) asm volatile("s_waitcnt vmcnt(" #n ")" ::: "memory")
#define PG8_WAIT_L(n) asm volatile("s_waitcnt lgkmcnt(" #n ")" ::: "memory")
#define PG8_BAR __builtin_amdgcn_s_barrier()
#define PG8_SCHED __builtin_amdgcn_sched_barrier(0)
    Unit cur, nxt; int ui = 0;
    if (!S.next(0, cur)) return;
    f32x4 acc[2][2][4][2];
#pragma unroll
    for (int a = 0; a < 2; ++a)
#pragma unroll
        for (int b = 0; b < 2; ++b)
#pragma unroll
            for (int m = 0; m < 4; ++m)
#pragma unroll
                for (int n = 0; n < 2; ++n) acc[a][b][m][n] = (f32x4){0.f, 0.f, 0.f, 0.f};
    bf16x8 At[4][2], B0[2][2], B1[2][2];
    const char* cA; const char* cB; S.ptrs(cur, cA, cB);
    typename Epi::Pre pre; E.prefetch(cur, wr, fr, pre);
    PG8_STAGE(PG8_SB(0, 0), cB, voffB, hpB); PG8_STAGE(PG8_SB(0, 1), cB + hstepB, voffB, hpB); PG8_STAGE(PG8_SA(0, 0), cA, voffA, hpA); PG8_STAGE(PG8_SA(0, 1), cA + hstepA, voffA, hpA);
    if (wr == 1) PG8_BAR;
    PG8_WAIT_V(2); PG8_BAR;
    PG8_STAGE(PG8_SB(1, 0), cB + kstep, voffB, hpB); PG8_STAGE(PG8_SA(1, 0), cA + kstep, voffA, hpA); PG8_STAGE(PG8_SB(1, 1), cB + hstepB + kstep, voffB, hpB);
    PG8_WAIT_V(6); PG8_BAR;
    for (;;) {
        const bool has_next = S.next(ui + 1, nxt);
        const char* nA = cA + (size_t)(cur.nt - 2) * kstep; const char* nB = cB + (size_t)(cur.nt - 2) * kstep;
        if (has_next) S.ptrs(nxt, nA, nB);
        const int nt = cur.nt;
        for (int t = 0; t < nt; t += 2) {
            const bool last = (t == nt - 2);
            const char* a1 = cA + (size_t)(t + 1) * kstep;
            const char* a2 = last ? nA : cA + (size_t)(t + 2) * kstep; const char* b2 = last ? nB : cB + (size_t)(t + 2) * kstep;
            const char* a3 = a2 + kstep; const char* b3 = b2 + kstep;
            PG8_LDB(B0, 0, 0); PG8_LDB(B1, 0, 1); PG8_SCHED; PG8_LDA(At, 0, 0); PG8_STAGE(PG8_SA(1, 1), a1 + hstepA, voffA, hpA);
            PG8_WAIT_V(8); PG8_WAIT_L(0); PG8_BAR; PG8_MMA(0, 0, At, B0); PG8_MMA(0, 1, At, B1); PG8_BAR; PG8_SCHED;
            PG8_LDA(At, 0, 1); PG8_STAGE(PG8_SB(0, 0), b2, voffB, hpB); PG8_STAGE(PG8_SB(0, 1), b2 + hstepB, voffB, hpB); PG8_STAGE(PG8_SA(0, 0), a2, voffA, hpA);
            PG8_WAIT_V(8); PG8_WAIT_L(0); PG8_BAR; PG8_MMA(1, 0, At, B0); PG8_MMA(1, 1, At, B1); PG8_BAR; PG8_SCHED;
            PG8_LDB(B0, 1, 0); PG8_LDB(B1, 1, 1); PG8_SCHED; PG8_LDA(At, 1, 0); PG8_STAGE(PG8_SA(0, 1), a2 + hstepA, voffA, hpA);
            PG8_WAIT_V(8); PG8_WAIT_L(0); PG8_BAR; PG8_MMA(0, 0, At, B0); PG8_MMA(0, 1, At, B1); PG8_BAR; PG8_SCHED;
            PG8_LDA(At, 1, 1); PG8_STAGE(PG8_SB(1, 0), b3, voffB, hpB); PG8_STAGE(PG8_SB(1, 1), b3 + hstepB, voffB, hpB); PG8_STAGE(PG8_SA(1, 0), a3, voffA, hpA);
            PG8_WAIT_V(8); PG8_WAIT_L(0); PG8_BAR; PG8_MMA(1, 0, At, B0); PG8_MMA(1, 1, At, B1); PG8_BAR; PG8_SCHED;
        }
        if (wr == 0) PG8_BAR;
        { int fr_e = fr, fq_e = fq; asm volatile("" : "+v"(fr_e), "+v"(fq_e));
          E(acc, cur, wr, wc, fr_e, fq_e, pre);
          }
        if (!has_next) break;
        if (!(Sched::PAIR && cur.kind == 0)) {
#pragma unroll
        for (int a = 0; a < 2; ++a)
#pragma unroll
            for (int b = 0; b < 2; ++b)
#pragma unroll
                for (int m = 0; m < 4; ++m)
#pragma unroll
                    for (int n = 0; n < 2; ++n) acc[a][b][m][n] = (f32x4){0.f, 0.f, 0.f, 0.f};
        }
        cur = nxt; cA = nA; cB = nB; ++ui;
        E.prefetch(cur, wr, fr, pre);
        if (wr == 1) PG8_BAR;
    }
    PG8_WAIT_V(0);
    PG8_BAR;
#undef PG8_SA
#undef PG8_SB
#undef PG8_STAGE
#undef PG8_LDA
#undef PG8_LDB
#undef PG8_MMA
#undef PG8_WAIT_V
#undef PG8_WAIT_L
#undef PG8_BAR
#undef PG8_SCHED
}
}
using pg8::Unit;

struct SchedStd { static constexpr bool PAIR = false;
    pg8::TileOrder o; const char* A; const char* B; size_t astep, bstep, bbatch; int nt;
    __device__ bool next(int i, Unit& u) const { u.kind = 0; u.aux = 0; u.nt = nt; return o.tile(i, u.pm, u.pn); }
    __device__ void ptrs(const Unit& u, const char*& a, const char*& b) const { a = A + (size_t)u.pm * astep; b = B + (size_t)u.pn * bstep + (size_t)(u.pm >> 4) * bbatch; }
};
struct SchedPair { static constexpr bool PAIR = true;
    int G, c; const char *A0, *A1, *B0, *B1; int loc, p0;
    __device__ bool next(int i, Unit& u) const {
        u.kind = i & 1; u.aux = 0; u.nt = 16;
        if (loc) { if (i >= 2) return false; u.pm = p0 + (c & 3); u.pn = c >> 2; return true; }
        const int p = (i >> 1) * G + c; if (p >= 256) return false; u.pm = p >> 3; u.pn = p & 7; return true; }
    __device__ void ptrs(const Unit& u, const char*& a, const char*& b) const { a = (u.kind ? A1 : A0) + (size_t)u.pm * (256 * 1024 * 2); b = (u.kind ? B1 : B0) + (size_t)u.pn * (256 * 1024 * 2); }
};
constexpr size_t TSTEP = (size_t)256 * D * 2;
struct SchedUpKv { static constexpr bool PAIR = false;
    pg8::TileOrder o; int G, c; const char *XBp, *W13p, *MEMNp, *WKVp; int loc, p0, xq;
    __device__ bool next(int i, Unit& u) const { const long L = loc ? (long)i * 32 + c : (long)i * G + c; u.aux = 0; u.nt = 32;
        if (loc) {
            if (L < 176) { u.kind = 0; u.pm = p0 + ((int)L & 3); u.pn = (int)L >> 2; return true; }
            if (L < 180) { const int r = xq * 4 + ((int)L - 176); u.kind = 1; u.pm = r & 1; u.pn = r >> 1; return true; }
            return false; }
        if (L < 1408) { u.kind = 0; return o.tileL(L, u.pm, u.pn); }
        if (L < 1440) { const int r = (int)L - 1408; u.kind = 1; u.pm = r & 1; u.pn = r >> 1; return true; }
        return false; }
    __device__ void ptrs(const Unit& u, const char*& a, const char*& b) const { a = (u.kind ? MEMNp : XBp) + (size_t)u.pm * TSTEP; b = (u.kind ? WKVp : W13p) + (size_t)u.pn * TSTEP; }
};
struct SchedInW { static constexpr bool PAIR = false;
    pg8::TileOrder o; int G, c; const char *XBp, *WINp, *Kp, *Vp, *WQp, *WOp; int loc, p0, xq;
    __device__ bool wunit(int r, Unit& u) const { const int rr = r & 63; u.kind = 1 + (r >> 6); u.aux = ((rr >> 5) << 2) | ((rr >> 3) & 3); u.pm = rr & 7; u.pn = 0; u.nt = 8; return true; }
    __device__ bool next(int i, Unit& u) const {
        u.aux = 0; u.nt = 32; u.kind = 0;
        if (loc) {
            const int L = i * 32 + c;
            if (L < 116) { u.pm = p0 + (L & 3); u.pn = L >> 2; return true; }
            if (i == 3) return wunit(xq * 16 + (c - 20), u);
            if (i == 4 && c >= 20 && c < 24) return wunit(xq * 16 + 12 + (c - 20), u);
            return false; }
        if (G == 256) {
            if (i < 3) return o.tileL((long)i * 256 + c, u.pm, u.pn);
            if (i == 3) { if (768 + c < 928) return o.tileL(768 + c, u.pm, u.pn); return wunit(c - 160, u); }
            if (i == 4 && c >= 160 && c < 192) return wunit(96 + c - 160, u);
            return false;
        }
        const long L = (long)i * G + c;
        if (L < 928) return o.tileL(L, u.pm, u.pn);
        if (L < 1056) return wunit((int)L - 928, u);
        return false; }
    __device__ void ptrs(const Unit& u, const char*& a, const char*& b) const {
        const int bb = u.aux >> 2, hh = u.aux & 3;
        if (u.kind == 0) { a = XBp + (size_t)u.pm * TSTEP; b = WINp + (size_t)u.pn * TSTEP; }
        else if (u.kind == 1) { a = Kp + (size_t)bb * TSTEP + hh * 1024; b = WQp + (size_t)u.pm * TSTEP + hh * 1024; }
        else { a = WOp + (size_t)u.pm * TSTEP + hh * 1024; b = Vp + (size_t)bb * TSTEP + hh * 1024; } }
};

#define EPI_ROWS(ai, m) (u.pm * 256 + (ai) * 128 + wr * 64 + (m) * 16 + fr)
#define EPI_COL8(bj) ((bj) * 128 + wc * 32 + 8 * fq)
struct NoPre {};
struct RowPre { u64 s[8]; };
__device__ __forceinline__ void rowpre_load(const u64* ss, const int pm, int wr, int fr, RowPre& p) {
#pragma unroll
    for (int k = 0; k < 8; ++k) p.s[k] = ((const GAS u64*)ss)[pm * 256 + (k >> 2) * 128 + wr * 64 + (k & 3) * 16 + fr]; }
__device__ __forceinline__ float rinv_of(const u64* ss, int row) { return rsqrtf((float)((const GAS u64*)ss)[row] * SS_INV + EPS); }

struct EpiUp {
    struct Pre { u64 s[8]; };
    __device__ __forceinline__ void prefetch(const Unit& u, int wr, int fr, Pre& p) const {
#pragma unroll
        for (int k = 0; k < 8; ++k) p.s[k] = ((const GAS u64*)ss)[u.pm * 256 + (k >> 2) * 128 + wr * 64 + (k & 3) * 16 + fr]; }
    bf16* act; const u64* ss;
    __device__ __forceinline__ void operator()(const f32x4 (&acc)[2][2][4][2], const Unit& u, int wr, int wc, int fr, int fq, const Pre& pre) const {
#ifdef EPI_TWICE
      for (int rep2 = 0; rep2 < 2; ++rep2) { asm volatile("" : "+v"(fr), "+v"(fq));
#endif
#pragma unroll
        for (int ai = 0; ai < 2; ++ai)
#pragma unroll
            for (int m = 0; m < 4; ++m) {
                const int row = EPI_ROWS(ai, m); const float r = rsqrtf((float)pre.s[ai * 4 + m] * SS_INV + EPS);
                float o[8];
#pragma unroll
                for (int n = 0; n < 2; ++n)
#pragma unroll
                    for (int i = 0; i < 4; ++i) { const float a = acc[ai][0][m][n][i] * r, b = acc[ai][1][m][n][i] * r; o[n * 4 + i] = siluf_(a) * b; }
                u32x4 w; w.x = pk2(o[0], o[1]); w.y = pk2(o[2], o[3]); w.z = pk2(o[4], o[5]); w.w = pk2(o[6], o[7]);
                *(GAS u32x4*)(act + (size_t)row * FF + u.pn * 128 + wc * 32 + 8 * fq) = w;
            }
#ifdef EPI_TWICE
      }
#endif
    }
};
template <bool IN_F32>
struct EpiRes {
    typedef NoPre Pre; __device__ __forceinline__ void prefetch(const Unit&, int, int, Pre&) const {}
    const float* xin32; bf16* xb; u64* ssn; float scale;
    __device__ __forceinline__ void operator()(const f32x4 (&acc)[2][2][4][2], const Unit& u, int wr, int wc, int fr, int fq, const Pre& pre) const {
#pragma unroll
        for (int ai = 0; ai < 2; ++ai)
#pragma unroll
            for (int m = 0; m < 4; ++m) {
                const int row = EPI_ROWS(ai, m); float q = 0.f;
#pragma unroll
                for (int bj = 0; bj < 2; ++bj) {
                    const size_t off = (size_t)row * D + u.pn * 256 + EPI_COL8(bj);
                    f32x4 x0, x1;
                    if (IN_F32) { x0 = *(const GAS f32x4*)(xin32 + off); x1 = *(const GAS f32x4*)(xin32 + off + 4); }
                    else { const u32x4 xw = *(const GAS u32x4*)(xb + off); x0[0] = lo_bf(xw.x); x0[1] = hi_bf(xw.x); x0[2] = lo_bf(xw.y); x0[3] = hi_bf(xw.y); x1[0] = lo_bf(xw.z); x1[1] = hi_bf(xw.z); x1[2] = lo_bf(xw.w); x1[3] = hi_bf(xw.w); }
                    const f32x4 o0 = x0 + acc[ai][bj][m][0] * scale, o1 = x1 + acc[ai][bj][m][1] * scale;
                    u32x4 w; w.x = pk2(o0[0], o0[1]); w.y = pk2(o0[2], o0[3]); w.z = pk2(o1[0], o1[1]); w.w = pk2(o1[2], o1[3]); *(GAS u32x4*)(xb + off) = w;
                    q += (o0[0] * o0[0] + o0[1] * o0[1]) + (o0[2] * o0[2] + o0[3] * o0[3]) + (o1[0] * o1[0] + o1[1] * o1[1]) + (o1[2] * o1[2] + o1[3] * o1[3]);
                }
                q += __shfl_xor(q, 16); q += __shfl_xor(q, 32);
                if (fq == 0) atomicAdd((u64*)(ssn + row), (u64)(q * SS_SCALE));
            }
    }
};
struct EpiResFinal {
    typedef NoPre Pre; __device__ __forceinline__ void prefetch(const Unit&, int, int, Pre&) const {}
    const bf16* xin; float* out; const float* gfin; u64* ssn; unsigned* cnt; float scale;
    __device__ __forceinline__ void operator()(f32x4 (&acc)[2][2][4][2], const Unit& u, int wr, int wc, int fr, int fq, const Pre& pre) const {
#pragma unroll
        for (int ai = 0; ai < 2; ++ai)
#pragma unroll
            for (int m = 0; m < 4; ++m) {
                const int row = EPI_ROWS(ai, m); float q = 0.f;
#pragma unroll
                for (int bj = 0; bj < 2; ++bj) {
                    const size_t off = (size_t)row * D + u.pn * 256 + EPI_COL8(bj);
                    const u32x4 xw = *(const GAS u32x4*)(xin + off);
                    f32x4 x0, x1; x0[0] = lo_bf(xw.x); x0[1] = hi_bf(xw.x); x0[2] = lo_bf(xw.y); x0[3] = hi_bf(xw.y); x1[0] = lo_bf(xw.z); x1[1] = hi_bf(xw.z); x1[2] = lo_bf(xw.w); x1[3] = hi_bf(xw.w);
                    const f32x4 o0 = x0 + acc[ai][bj][m][0] * scale, o1 = x1 + acc[ai][bj][m][1] * scale;
                    acc[ai][bj][m][0] = o0; acc[ai][bj][m][1] = o1;
                    q += (o0[0] * o0[0] + o0[1] * o0[1]) + (o0[2] * o0[2] + o0[3] * o0[3]) + (o1[0] * o1[0] + o1[1] * o1[1]) + (o1[2] * o1[2] + o1[3] * o1[3]);
                }
                q += __shfl_xor(q, 16); q += __shfl_xor(q, 32);
                if (fq == 0) atomicAdd((u64*)(ssn + row), (u64)(q * SS_SCALE));
            }
        asm volatile("s_waitcnt vmcnt(0)" ::: "memory");
        unsigned* c = cnt + 64 * u.pm;
        if (fr == 0 && fq == 0) __hip_atomic_fetch_add(c, 1u, __ATOMIC_RELAXED, __HIP_MEMORY_SCOPE_AGENT);
        if (wr == 0 && wc == 0) {
            unsigned spins = 0;
            while ((unsigned)__builtin_amdgcn_readfirstlane(__hip_atomic_load(c, __ATOMIC_RELAXED, __HIP_MEMORY_SCOPE_AGENT)) < 64u) { __builtin_amdgcn_s_sleep(2); if (++spins > (1u << 22)) break; }
            __builtin_amdgcn_fence(__ATOMIC_ACQUIRE, "agent");
            asm volatile("s_waitcnt vmcnt(0)" ::: "memory");
        }
        asm volatile("" ::: "memory"); __builtin_amdgcn_s_barrier(); asm volatile("" ::: "memory");
#pragma unroll
        for (int ai = 0; ai < 2; ++ai)
#pragma unroll
            for (int m = 0; m < 4; ++m) {
                const int row = EPI_ROWS(ai, m);
                const float r = rsqrtf((float)__hip_atomic_load(ssn + row, __ATOMIC_RELAXED, __HIP_MEMORY_SCOPE_AGENT) * SS_INV + EPS);
#pragma unroll
                for (int bj = 0; bj < 2; ++bj) {
                    const size_t off = (size_t)row * D + u.pn * 256 + EPI_COL8(bj); const int col = u.pn * 256 + EPI_COL8(bj);
                    const f32x4 o0 = acc[ai][bj][m][0], o1 = acc[ai][bj][m][1];
                    *(GAS f32x4*)(out + off) = o0 * r * *(const GAS f32x4*)(gfin + col); *(GAS f32x4*)(out + off + 4) = o1 * r * *(const GAS f32x4*)(gfin + col + 4);
                }
            }
    }
};
struct EpiInproj {
    typedef RowPre Pre; __device__ __forceinline__ void prefetch(const Unit& u, int wr, int fr, Pre& p) const { rowpre_load(ss, u.pm, wr, fr, p); }
    unsigned char* ws; const u64* ss; const float* igb; const float* fgb;
    __device__ __forceinline__ void operator()(const f32x4 (&acc)[2][2][4][2], const Unit& u, int wr, int wc, int fr, int fq, const Pre& pre) const {
        if (u.pn == 28) {
            if (wc == 0 && fq == 0) {
                float* gates = (float*)(ws + WS_SMALL + SM_GATES);
#pragma unroll
                for (int ai = 0; ai < 2; ++ai)
#pragma unroll
                    for (int m = 0; m < 4; ++m) {
                        const int row = EPI_ROWS(ai, m); const float r = rsqrtf((float)pre.s[ai * 4 + m] * SS_INV + EPS);
                        f32x4 gi, gf;
#pragma unroll
                        for (int i = 0; i < 4; ++i) {
                            gi[i] = acc[ai][0][m][0][i] * r + igb[i];
                            const float xf = acc[ai][0][m][1][i] * r + fgb[i];
                            gf[i] = fminf(xf, 0.f) - __logf(1.0f + __expf(-fabsf(xf)));
                        }
                        *(GAS f32x4*)(gates + (size_t)row * 8) = gi; *(GAS f32x4*)(gates + (size_t)row * 8 + 4) = gf;
                    }
            }
            return;
        }
        const int ty = u.pn >> 2;
        bf16* base = (bf16*)(ws + (ty == 0 ? AR_QKRAW : ty == 1 ? AR_MV : ty == 2 ? AR_MO : ty == 3 ? AR_HQ : ty == 4 ? AR_HF : ty == 5 ? AR_HI : AR_HG));
#pragma unroll
        for (int ai = 0; ai < 2; ++ai)
#pragma unroll
            for (int m = 0; m < 4; ++m) {
                const int row = EPI_ROWS(ai, m); const float r = rsqrtf((float)pre.s[ai * 4 + m] * SS_INV + EPS);
#pragma unroll
                for (int bj = 0; bj < 2; ++bj) {
                    float o[8];
#pragma unroll
                    for (int n = 0; n < 2; ++n)
#pragma unroll
                        for (int i = 0; i < 4; ++i) {
                            float v = acc[ai][bj][m][n][i] * r;
                            if (ty == 2) v = sigmoidf_(v); else if (ty == 3) v = siluf_(v) * 0.08838834764831845f; else if (ty == 6) v = siluf_(v);
                            o[n * 4 + i] = v;
                        }
                    u32x4 w; w.x = pk2(o[0], o[1]); w.y = pk2(o[2], o[3]); w.z = pk2(o[4], o[5]); w.w = pk2(o[6], o[7]);
                    *(GAS u32x4*)(base + (size_t)row * 1024 + (u.pn & 3) * 256 + EPI_COL8(bj)) = w;
                }
            }
    }
};
struct EpiGates {
    typedef RowPre Pre; __device__ __forceinline__ void prefetch(const Unit& u, int wr, int fr, Pre& p) const { rowpre_load(ss, u.pm, wr, fr, p); }
    bf16* gm; bf16* gh; const u64* ss;
    __device__ __forceinline__ void operator()(const f32x4 (&acc)[2][2][4][2], const Unit& u, int wr, int wc, int fr, int fq, const Pre& pre) const {
        bf16* base = (u.pn < 8) ? gm : gh;
#pragma unroll
        for (int ai = 0; ai < 2; ++ai)
#pragma unroll
            for (int m = 0; m < 4; ++m) {
                const int row = EPI_ROWS(ai, m); const float r = rsqrtf((float)pre.s[ai * 4 + m] * SS_INV + EPS);
#pragma unroll
                for (int bj = 0; bj < 2; ++bj) {
                    float o[8];
#pragma unroll
                    for (int n = 0; n < 2; ++n)
#pragma unroll
                        for (int i = 0; i < 4; ++i) o[n * 4 + i] = sigmoidf_(acc[ai][bj][m][n][i] * r);
                    u32x4 w; w.x = pk2(o[0], o[1]); w.y = pk2(o[2], o[3]); w.z = pk2(o[4], o[5]); w.w = pk2(o[6], o[7]);
                    *(GAS u32x4*)(base + (size_t)row * D + (u.pn & 7) * 256 + EPI_COL8(bj)) = w;
                }
            }
    }
};
struct EpiProj {
    typedef NoPre Pre; __device__ __forceinline__ void prefetch(const Unit&, int, int, Pre&) const {}
    const bf16* gm; const bf16* gh; bf16* merged;
    __device__ __forceinline__ void operator()(f32x4 (&acc)[2][2][4][2], const Unit& u, int wr, int wc, int fr, int fq, const Pre& pre) const {
#pragma unroll
        for (int ai = 0; ai < 2; ++ai)
#pragma unroll
            for (int m = 0; m < 4; ++m) {
                const int row = EPI_ROWS(ai, m);
#pragma unroll
                for (int bj = 0; bj < 2; ++bj) {
                    const size_t off = (size_t)row * D + u.pn * 256 + EPI_COL8(bj);
                    const u32x4 hw = *(const GAS u32x4*)(gh + off);
                    float h8[8] = {lo_bf(hw.x), hi_bf(hw.x), lo_bf(hw.y), hi_bf(hw.y), lo_bf(hw.z), hi_bf(hw.z), lo_bf(hw.w), hi_bf(hw.w)};
                    if (u.kind == 0) {
                        const u32x4 gw = *(const GAS u32x4*)(gm + off);
                        const float g8[8] = {lo_bf(gw.x), hi_bf(gw.x), lo_bf(gw.y), hi_bf(gw.y), lo_bf(gw.z), hi_bf(gw.z), lo_bf(gw.w), hi_bf(gw.w)};
#pragma unroll
                        for (int i = 0; i < 4; ++i) { acc[ai][bj][m][0][i] *= g8[i] * __builtin_amdgcn_rcpf(fmaxf(h8[i], 1e-30f)); acc[ai][bj][m][1][i] *= g8[4 + i] * __builtin_amdgcn_rcpf(fmaxf(h8[4 + i], 1e-30f)); }
                    } else {
                        const f32x4 a = acc[ai][bj][m][0], b = acc[ai][bj][m][1];
                        u32x4 w; w.x = pk2(a[0] * h8[0], a[1] * h8[1]); w.y = pk2(a[2] * h8[2], a[3] * h8[3]); w.z = pk2(b[0] * h8[4], b[1] * h8[5]); w.w = pk2(b[2] * h8[6], b[3] * h8[7]); *(GAS u32x4*)(merged + off) = w;
                    }
                }
            }
    }
};
struct EpiScores {
    typedef RowPre Pre; __device__ __forceinline__ void prefetch(const Unit& u, int wr, int fr, Pre& p) const { rowpre_load(ss, u.pm, wr, fr, p); }
    bf16* p; const u64* ss; LAS float* xch;
    __device__ __forceinline__ void operator()(const f32x4 (&acc)[2][2][4][2], const Unit& u, int wr, int wc, int fr, int fq, const Pre& pre) const {
        float v[2][4][16];
#pragma unroll
        for (int ai = 0; ai < 2; ++ai)
#pragma unroll
            for (int m = 0; m < 4; ++m) {
                const int row = EPI_ROWS(ai, m), rl = ai * 128 + wr * 64 + m * 16 + fr; const float r = rsqrtf((float)pre.s[ai * 4 + m] * SS_INV + EPS) * 0.04419417382415922f;
                float mx = -INFINITY;
#pragma unroll
                for (int bj = 0; bj < 2; ++bj)
#pragma unroll
                    for (int n = 0; n < 2; ++n)
#pragma unroll
                        for (int i = 0; i < 4; ++i) { const float x = acc[ai][bj][m][n][i] * r; v[ai][m][bj * 8 + n * 4 + i] = x; mx = fmaxf(mx, x); }
                mx = fmaxf(mx, __shfl_xor(mx, 16)); mx = fmaxf(mx, __shfl_xor(mx, 32));
                if (fq == 0) xch[rl * 4 + wc] = mx;
            }
        asm volatile("s_waitcnt lgkmcnt(0)" ::: "memory"); __builtin_amdgcn_s_barrier(); asm volatile("" ::: "memory");
#pragma unroll
        for (int ai = 0; ai < 2; ++ai)
#pragma unroll
            for (int m = 0; m < 4; ++m) {
                const int rl = ai * 128 + wr * 64 + m * 16 + fr; const f32x4 pm = *(const LAS f32x4*)(xch + rl * 4);
                const float mx = fmaxf(fmaxf(pm[0], pm[1]), fmaxf(pm[2], pm[3])); float sm = 0.f;
#pragma unroll
                for (int k = 0; k < 16; ++k) { const float e = __expf(v[ai][m][k] - mx); v[ai][m][k] = e; sm += e; }
                sm += __shfl_xor(sm, 16); sm += __shfl_xor(sm, 32);
                if (fq == 0) xch[1024 + rl * 4 + wc] = sm;
            }
        asm volatile("s_waitcnt lgkmcnt(0)" ::: "memory"); __builtin_amdgcn_s_barrier(); asm volatile("" ::: "memory");
#pragma unroll
        for (int ai = 0; ai < 2; ++ai)
#pragma unroll
            for (int m = 0; m < 4; ++m) {
                const int row = EPI_ROWS(ai, m), rl = ai * 128 + wr * 64 + m * 16 + fr; const f32x4 ps = *(const LAS f32x4*)(xch + 1024 + rl * 4);
                const float inv = __builtin_amdgcn_rcpf((ps[0] + ps[1]) + (ps[2] + ps[3]));
#pragma unroll
                for (int bj = 0; bj < 2; ++bj) {
                    const float* e = &v[ai][m][bj * 8];
                    u32x4 w; w.x = pk2(e[0] * inv, e[1] * inv); w.y = pk2(e[2] * inv, e[3] * inv); w.z = pk2(e[4] * inv, e[5] * inv); w.w = pk2(e[6] * inv, e[7] * inv);
                    *(GAS u32x4*)(p + (size_t)row * 1024 + u.pn * 256 + EPI_COL8(bj)) = w;
                }
            }
    }
};
__device__ __forceinline__ void store_tile_bf16(const f32x4 (&acc)[2][2][4][2], bf16* base, int ldc, int wr, int wc, int fr, int fq) {
#pragma unroll
    for (int ai = 0; ai < 2; ++ai)
#pragma unroll
        for (int m = 0; m < 4; ++m) {
            const int rl = ai * 128 + wr * 64 + m * 16 + fr;
#pragma unroll
            for (int bj = 0; bj < 2; ++bj) {
                const f32x4 a = acc[ai][bj][m][0], b = acc[ai][bj][m][1];
                u32x4 w; w.x = pk2(a[0], a[1]); w.y = pk2(a[2], a[3]); w.z = pk2(b[0], b[1]); w.w = pk2(b[2], b[3]);
                *(GAS u32x4*)(base + (size_t)rl * ldc + EPI_COL8(bj)) = w;
            }
        }
}
struct EpiUpKv {
    typedef EpiUp::Pre Pre; __device__ __forceinline__ void prefetch(const Unit& u, int wr, int fr, Pre& p) const { if (u.kind == 0) up.prefetch(u, wr, fr, p); }
    EpiUp up; bf16* kv;
    __device__ __forceinline__ void operator()(const f32x4 (&acc)[2][2][4][2], const Unit& u, int wr, int wc, int fr, int fq, const Pre& pre) const {
        if (u.kind == 0) up(acc, u, wr, wc, fr, fq, pre);
        else store_tile_bf16(acc, kv + (size_t)(u.pn >> 3) * (512 * D) + (size_t)u.pm * (256 * D) + (u.pn & 7) * 256, D, wr, wc, fr, fq);
    }
};
struct EpiInW {
    typedef RowPre Pre; __device__ __forceinline__ void prefetch(const Unit& u, int wr, int fr, Pre& p) const { if (u.kind == 0) inp.prefetch(u, wr, fr, p); }
    EpiInproj inp; bf16* wqkt; bf16* vwot;
    __device__ __forceinline__ void operator()(const f32x4 (&acc)[2][2][4][2], const Unit& u, int wr, int wc, int fr, int fq, const Pre& pre) const {
        const int bb = u.aux >> 2, hh = u.aux & 3;
        if (u.kind == 0) inp(acc, u, wr, wc, fr, fq, pre);
        else if (u.kind == 1) store_tile_bf16(acc, wqkt + (size_t)bb * (1024 * D) + (size_t)hh * (256 * D) + u.pm * 256, D, wr, wc, fr, fq);
        else store_tile_bf16(acc, vwot + (size_t)bb * (2048 * 1024) + (size_t)u.pm * (256 * 1024) + hh * 256, 1024, wr, wc, fr, fq);
    }
};

struct Args { const float* in[28]; float* out; unsigned char* ws; };
enum { I_X = 0, I_MEM, I_NFFN1, I_F1W1, I_F1W3, I_F1W2, I_NMIX, I_WIN, I_CONVW, I_CONVB, I_IGB, I_FGB, I_MHN, I_LBL, I_HHN, I_WPM, I_WPH, I_WOUT, I_NX, I_NMEM, I_WQ, I_WKV, I_WO,
       I_NFFN2, I_F2W1, I_F2W3, I_F2W2, I_NFIN };

struct CvtDesc { const float* src; const float* gain; bf16* dst; int ld_src, ld_dst, col0, nvalid, k0; };
__device__ __forceinline__ void cvt_load(const CvtDesc& d, int lane, f32x4 (&v)[8]) {
    const int kc = lane & 7, ng = lane >> 3; const bool ok = (4 * ng) < d.nvalid;
#pragma unroll
    for (int j = 0; j < 8; ++j) v[j] = ok ? __builtin_nontemporal_load((const GAS f32x4*)(d.src + (size_t)(d.k0 + 8 * kc + j) * d.ld_src + d.col0 + 4 * ng)) : (f32x4){0.f, 0.f, 0.f, 0.f};
}
__device__ __forceinline__ void cvt_store(const CvtDesc& d, int lane, f32x4 (&v)[8]) {
    const int kc = lane & 7, ng = lane >> 3;
    if (d.gain) {
        const f32x4 g0 = *(const f32x4*)(d.gain + d.k0 + 8 * kc), g1 = *(const f32x4*)(d.gain + d.k0 + 8 * kc + 4);
        v[0] *= g0[0]; v[1] *= g0[1]; v[2] *= g0[2]; v[3] *= g0[3]; v[4] *= g1[0]; v[5] *= g1[1]; v[6] *= g1[2]; v[7] *= g1[3];
    }
#pragma unroll
    for (int i = 0; i < 4; ++i) {
        u32x4 w; w.x = pk2(v[0][i], v[1][i]); w.y = pk2(v[2][i], v[3][i]); w.z = pk2(v[4][i], v[5][i]); w.w = pk2(v[6][i], v[7][i]);
        *(u32x4*)(d.dst + (size_t)(4 * ng + i) * d.ld_dst + d.k0 + 8 * kc) = w;
    }
}
__device__ __forceinline__ CvtDesc mk_desc(const float* src, int ld_src, int col0, int nvalid, int k0, const float* gain, bf16* dst, int ld_dst) {
    CvtDesc d; d.src = src; d.gain = gain; d.dst = dst; d.ld_src = ld_src; d.ld_dst = ld_dst; d.col0 = col0; d.nvalid = nvalid; d.k0 = k0; return d; }
__device__ __forceinline__ CvtDesc ffn_desc(int it, const float* w1, const float* w3, const float* w2, const float* gain, bf16* w13, bf16* w2t) {
    if (it < 11264) { const int nb = it % 352, kb = it / 352; const int pn = nb >> 3, bj = (nb >> 2) & 1, cb = nb & 3;
        return mk_desc(bj ? w3 : w1, FF, pn * 128 + cb * 32, 32, kb * 64, gain, w13 + (size_t)nb * 32 * D, D); }
    it -= 11264;
    const int nb = it % 64, kb = it / 64; return mk_desc(w2, D, nb * 32, 32, kb * 64, nullptr, w2t + (size_t)nb * 32 * FF, FF);
}
constexpr int N_FFN_ITEMS = 11264 + 5632;
#ifndef PHASES
#define PHASES 0xFFFFFu
#endif
#define PH(k) ((PHASES >> (k)) & 1u)
#ifndef REPS
#define REPS 0x0u
#endif
#define NREP(k) ((int)PH(k) + (int)((REPS >> (k)) & 1u))

__device__ __forceinline__ bf16x8 ldfrag(const LAS unsigned char* base, int row, int stride, int kbyte) { return *(const LAS bf16x8*)(base + row * stride + kbyte); }
#define MFMA16(a, b, c) __builtin_amdgcn_mfma_f32_16x16x32_bf16((a), (b), (c), 0, 0, 0)
__device__ __forceinline__ float wave_scan_incl(float v, int lane) {
    (void)lane;
#define WS_DPP(ctrl, rmask) v += __builtin_bit_cast(float, __builtin_amdgcn_update_dpp(0, __builtin_bit_cast(int, v), (ctrl), (rmask), 0xf, false))
    WS_DPP(0x111, 0xf); WS_DPP(0x112, 0xf); WS_DPP(0x114, 0xf); WS_DPP(0x118, 0xf);
    WS_DPP(0x142, 0xa);
    WS_DPP(0x143, 0xc);
#undef WS_DPP
    return v;
}
__device__ __forceinline__ void unpack8(const u32x4 w, float (&f)[8]) { f[0] = lo_bf(w.x); f[1] = hi_bf(w.x); f[2] = lo_bf(w.y); f[3] = hi_bf(w.y); f[4] = lo_bf(w.z); f[5] = hi_bf(w.z); f[6] = lo_bf(w.w); f[7] = hi_bf(w.w); }
__device__ __forceinline__ void put_t8(LAS unsigned char* Tt, int col0, int s, const u32x4 vw) {
    LAS bf16* p = (LAS bf16*)(Tt + col0 * 144 + s * 2);
    p[0 * 72] = (bf16)(vw.x & 0xffffu); p[1 * 72] = (bf16)(vw.x >> 16); p[2 * 72] = (bf16)(vw.y & 0xffffu); p[3 * 72] = (bf16)(vw.y >> 16);
    p[4 * 72] = (bf16)(vw.z & 0xffffu); p[5 * 72] = (bf16)(vw.z >> 16); p[6 * 72] = (bf16)(vw.w & 0xffffu); p[7 * 72] = (bf16)(vw.w >> 16);
}

struct MaRegs { u32x4 vr[4], qk[5]; float fl, ip; };
struct HaRegs { u32x4 hr[2], fr[2]; };
__device__ __forceinline__ void ma_load(int item, int tid, const GAS float* gates, const GAS bf16* QKRAW, const GAS bf16* MV, MaRegs& r) {
    const int b = item >> 8, h = (item >> 6) & 3, c = item & 63, R0 = b * T + c * 64;
#pragma unroll
    for (int i = 0; i < 4; ++i) { const int idx = tid + NTHR * i, row = idx >> 5, ch = idx & 31; r.vr[i] = *(const GAS u32x4*)(MV + (size_t)(R0 + row) * 1024 + h * 256 + ch * 8); }
#pragma unroll
    for (int j = 0; j < 5; ++j) { const int idx = tid + NTHR * j, row = idx >> 5, ch = idx & 31, tt = c * 64 - 3 + row;
        r.qk[j] = (idx < 67 * 32 && tt >= 0) ? *(const GAS u32x4*)(QKRAW + (size_t)(b * T + tt) * 1024 + (ch >> 4) * 512 + h * 128 + (ch & 15) * 8) : (u32x4){0u, 0u, 0u, 0u}; }
    r.fl = 0.f; r.ip = 0.f;
    if (tid < 64) { r.fl = gates[(size_t)(R0 + tid) * 8 + 4 + h]; r.ip = gates[(size_t)(R0 + tid) * 8 + h]; }
}
__device__ __forceinline__ void ha_load(int it, int tid, const GAS bf16* HF, const GAS bf16* HI, HaRegs& r) {
    const int b = it >> 9, h = (it >> 6) & 7, c = it & 63, R0 = b * T + c * 64;
#pragma unroll
    for (int i = 0; i < 2; ++i) { const int idx = tid + NTHR * i, row = idx >> 4, ch = idx & 15;
        r.hr[i] = *(const GAS u32x4*)(HI + (size_t)(R0 + row) * 1024 + h * 128 + ch * 8); r.fr[i] = *(const GAS u32x4*)(HF + (size_t)(R0 + row) * 1024 + h * 128 + ch * 8); }
}
__device__ __forceinline__ void mlstm_stage_convw(LAS unsigned char* lds, int h, int tid, const GAS float* convw, const GAS float* convb) {
    LAS float* CW = (LAS float*)(lds + 2048 + 18432 + 36864 + 35376 + 33792);
    if (tid < 320) { const int j = tid >> 6, c4 = tid & 63, col = (c4 >> 5) * 512 + h * 128 + (c4 & 31) * 4;
        *(LAS f32x4*)(CW + j * 256 + c4 * 4) = *(const GAS f32x4*)((j < 4 ? convw + j * 1024 : convb) + col); }
}
__device__ __forceinline__ void mlstm_state_item(LAS unsigned char* lds, int item, int tid, MaRegs& rg, int nxt, const GAS float* gates, const GAS float* convw, const GAS float* convb, const GAS bf16* QKRAW, GAS bf16* QC, GAS bf16* KC,
                                                 const GAS bf16* MV, GAS bf16* MST, GAS float* DN, GAS float* BLAST, GAS float* MLOC) {
    const int lane = tid & 63, w = __builtin_amdgcn_readfirstlane(tid >> 6), l15 = lane & 15, lg = lane >> 4;
    const int b = item >> 8, h = (item >> 6) & 3, c = item & 63, R0 = b * T + c * 64;
    LAS float* sc = (LAS float*)lds;
    LAS unsigned char* KWt = lds + 2048;
    LAS unsigned char* Vt = KWt + 18432;
    LAS unsigned char* RAW = Vt + 36864;
    LAS unsigned char* VR = RAW + 35376;
    const LAS float* CW = (const LAS float*)(VR + 33792);
    const int s = lane;
    if (w == 0) {
        const float bs = wave_scan_incl(rg.fl, lane); const float blast = __shfl(bs, 63);
        const float a = blast - bs + rg.ip; const float ml = wave_max(a);
        sc[128 + lane] = __expf(a - ml);
        if (lane == 0) { BLAST[item] = blast; MLOC[item] = ml; }
    }
#pragma unroll
    for (int i = 0; i < 4; ++i) { const int idx = tid + NTHR * i; *(LAS u32x4*)(VR + (idx >> 5) * 528 + (idx & 31) * 16) = rg.vr[i]; }
#pragma unroll
    for (int j = 0; j < 5; ++j) { const int idx = tid + NTHR * j; if (idx < 67 * 32) *(LAS u32x4*)(RAW + (idx >> 5) * 528 + (idx & 31) * 16) = rg.qk[j]; }
    if (nxt < 512) ma_load(nxt, tid, gates, QKRAW, MV, rg);
    __syncthreads();
#pragma unroll
    for (int i = 0; i < 4; ++i) put_t8(Vt, (w + 8 * i) * 8, s, *(const LAS u32x4*)(VR + s * 528 + (w + 8 * i) * 16));
    const float ws_ = sc[128 + s];
#pragma unroll
    for (int i = 0; i < 4; ++i) {
        const int g = w + 8 * i, isk = g >> 4, d0 = (g & 15) * 8, cc0 = isk * 512 + h * 128 + d0;
        float y[8];
        { const f32x4 b0 = *(const LAS f32x4*)(CW + 1024 + g * 8), b1 = *(const LAS f32x4*)(CW + 1024 + g * 8 + 4); y[0] = b0[0]; y[1] = b0[1]; y[2] = b0[2]; y[3] = b0[3]; y[4] = b1[0]; y[5] = b1[1]; y[6] = b1[2]; y[7] = b1[3]; }
#pragma unroll
        for (int j = 0; j < 4; ++j) { const f32x4 w0 = *(const LAS f32x4*)(CW + j * 256 + g * 8), w1 = *(const LAS f32x4*)(CW + j * 256 + g * 8 + 4); float x[8]; unpack8(*(const LAS u32x4*)(RAW + (s + j) * 528 + g * 16), x);
            y[0] += w0[0] * x[0]; y[1] += w0[1] * x[1]; y[2] += w0[2] * x[2]; y[3] += w0[3] * x[3]; y[4] += w1[0] * x[4]; y[5] += w1[1] * x[5]; y[6] += w1[2] * x[6]; y[7] += w1[3] * x[7]; }
#pragma unroll
        for (int e = 0; e < 8; ++e) y[e] = siluf_(y[e]) * (isk ? 0.08838834764831845f : 1.0f);
        u32x4 o; o.x = pk2(y[0], y[1]); o.y = pk2(y[2], y[3]); o.z = pk2(y[4], y[5]); o.w = pk2(y[6], y[7]);
        if (!isk) *(GAS u32x4*)(QC + (size_t)(R0 + s) * 512 + h * 128 + d0) = o;
        else { *(GAS u32x4*)(KC + (size_t)(R0 + s) * 512 + h * 128 + d0) = o;
            float kr[8]; unpack8(o, kr);
            u32x4 kw; kw.x = pk2(kr[0] * ws_, kr[1] * ws_); kw.y = pk2(kr[2] * ws_, kr[3] * ws_); kw.z = pk2(kr[4] * ws_, kr[5] * ws_); kw.w = pk2(kr[6] * ws_, kr[7] * ws_);
            put_t8(KWt, d0, s, kw); }
    }
    __syncthreads();
    if (tid < 128) {
        float n = 0.f;
#pragma unroll
        for (int j = 0; j < 8; ++j) { const u32x4 kw = *(const LAS u32x4*)(KWt + tid * 144 + j * 16);
            n += (lo_bf(kw.x) + hi_bf(kw.x)) + (lo_bf(kw.y) + hi_bf(kw.y)) + (lo_bf(kw.z) + hi_bf(kw.z)) + (lo_bf(kw.w) + hi_bf(kw.w)); }
        DN[(size_t)item * 128 + tid] = n;
    }
    {
        bf16x8 vf[2][2];
#pragma unroll
        for (int je = 0; je < 2; ++je)
#pragma unroll
            for (int kk = 0; kk < 2; ++kk) vf[je][kk] = ldfrag(Vt, 16 * (2 * w + je) + l15, 144, (32 * kk + 8 * lg) * 2);
#pragma unroll 2
        for (int dt = 0; dt < 8; ++dt) {
            const bf16x8 k0 = ldfrag(KWt, 16 * dt + l15, 144, (8 * lg) * 2), k1 = ldfrag(KWt, 16 * dt + l15, 144, (32 + 8 * lg) * 2);
#pragma unroll
            for (int je = 0; je < 2; ++je) {
                f32x4 a = {0.f, 0.f, 0.f, 0.f};
                a = MFMA16(k0, vf[je][0], a); a = MFMA16(k1, vf[je][1], a);
                u32x2 o; o.x = pk2(a[0], a[1]); o.y = pk2(a[2], a[3]);
                *(GAS u32x2*)(MST + ((size_t)item * 256 + 16 * (2 * w + je) + l15) * 128 + 16 * dt + 4 * lg) = o;
            }
        }
    }
    __syncthreads();
}

__device__ __forceinline__ void hgrn_state_item(LAS unsigned char* lds, int it, int tid, HaRegs& rg, int nxt, const GAS bf16* HF, const GAS bf16* HI, const GAS float* lbl, GAS bf16* HST, GAS float* DEC) {
    const int lane = tid & 63, w = __builtin_amdgcn_readfirstlane(tid >> 6), l15 = lane & 15, lg = lane >> 4;
    const int b = it >> 9, h = (it >> 6) & 7, c = it & 63, R0 = b * T + c * 64;
    LAS float* Gt = (LAS float*)(lds + 2048);
    LAS unsigned char* KDt = lds + 2048 + 34816;
    LAS unsigned char* Vt = KDt + 18432;
    LAS unsigned char* HR = Vt + 18432;
    LAS unsigned char* FR = HR + 17408;
    const int s = lane;
#pragma unroll
    for (int i = 0; i < 2; ++i) { const int idx = tid + NTHR * i; *(LAS u32x4*)(HR + (idx >> 4) * 272 + (idx & 15) * 16) = rg.hr[i]; *(LAS u32x4*)(FR + (idx >> 4) * 272 + (idx & 15) * 16) = rg.fr[i]; }
    if (nxt < 1024) ha_load(nxt, tid, HF, HI, rg);
    __syncthreads();
    u32x4 hv[2], fv[2];
#pragma unroll
    for (int i = 0; i < 2; ++i) { hv[i] = *(const LAS u32x4*)(HR + s * 272 + (w + 8 * i) * 16); fv[i] = *(const LAS u32x4*)(FR + s * 272 + (w + 8 * i) * 16); }
#pragma unroll
    for (int i = 0; i < 2; ++i) {
        put_t8(Vt, (w + 8 * i) * 8, s, hv[i]);
        const int d0 = (w + 8 * i) * 8, dd = h * 128 + d0; float f[8], kd[8], dl[8]; unpack8(fv[i], f);
#pragma unroll
        for (int e = 0; e < 8; ++e) { const float lbv = ((const LAS float*)(FR + 17408))[dd + e]; const float sg = sigmoidf_(f[e]);
            const float Gs = wave_scan_incl(__logf(lbv + (1.f - lbv) * sg), lane); const float Gl = __shfl(Gs, 63);
            kd[e] = (1.f - lbv) * (1.f - sg) * __expf(Gl - Gs); dl[e] = __expf(Gl); }
        u32x4 o; o.x = pk2(kd[0], kd[1]); o.y = pk2(kd[2], kd[3]); o.z = pk2(kd[4], kd[5]); o.w = pk2(kd[6], kd[7]);
        put_t8(KDt, d0, s, o);
        if (lane == 63) { *(GAS f32x4*)(DEC + (size_t)it * 128 + d0) = (f32x4){dl[0], dl[1], dl[2], dl[3]}; *(GAS f32x4*)(DEC + (size_t)it * 128 + d0 + 4) = (f32x4){dl[4], dl[5], dl[6], dl[7]}; }
    }
    __syncthreads();
    {
        const bf16x8 v0 = ldfrag(Vt, 16 * w + l15, 144, (8 * lg) * 2), v1 = ldfrag(Vt, 16 * w + l15, 144, (32 + 8 * lg) * 2);
#pragma unroll 2
        for (int dt = 0; dt < 8; ++dt) {
            f32x4 a = {0.f, 0.f, 0.f, 0.f};
            a = MFMA16(ldfrag(KDt, 16 * dt + l15, 144, (8 * lg) * 2), v0, a); a = MFMA16(ldfrag(KDt, 16 * dt + l15, 144, (32 + 8 * lg) * 2), v1, a);
            u32x2 o; o.x = pk2(a[0], a[1]); o.y = pk2(a[2], a[3]);
            *(GAS u32x2*)(HST + ((size_t)it * 128 + 16 * w + l15) * 128 + 16 * dt + 4 * lg) = o;
        }
    }
    __syncthreads();
}

struct MoRegs { u32x4 vv[4], qq[2], kq[2], cs[8]; float fl, ip, mprev, npv; };
struct HoRegs { u32x4 hv[2], fv[2], qw[2], cs[4]; };
struct OutPtrs { const GAS float* gates; const GAS float* MPREV; const GAS float* NPREV; const GAS bf16* QC; const GAS bf16* KC; const GAS bf16* MV; const GAS bf16* MST; const GAS bf16* HQ; const GAS bf16* HF; const GAS bf16* HI; const GAS bf16* HST; };
__device__ __forceinline__ void mo_load(int item, int tid, const OutPtrs& P, MoRegs& r) {
    const int lane = tid & 63, w = __builtin_amdgcn_readfirstlane(tid >> 6);
    const int b = item >> 8, h = (item >> 6) & 3, c = item & 63, R0 = b * T + c * 64;
#pragma unroll
    for (int j = 0; j < 8; ++j) { const int q = tid + NTHR * j; r.cs[j] = *(const GAS u32x4*)(P.MST + ((size_t)item * 256 + (q >> 4)) * 128 + (q & 15) * 8); }
#pragma unroll
    for (int i = 0; i < 4; ++i) r.vv[i] = *(const GAS u32x4*)(P.MV + (size_t)(R0 + lane) * 1024 + h * 256 + (w + 8 * i) * 8);
#pragma unroll
    for (int i = 0; i < 2; ++i) { const int idx = tid + NTHR * i, s = idx >> 4, ch = idx & 15;
        r.qq[i] = *(const GAS u32x4*)(P.QC + (size_t)(R0 + s) * 512 + h * 128 + ch * 8); r.kq[i] = *(const GAS u32x4*)(P.KC + (size_t)(R0 + s) * 512 + h * 128 + ch * 8); }
    r.fl = 0.f; r.ip = 0.f; r.mprev = 0.f; r.npv = 0.f;
    if (w == 0) { r.fl = P.gates[(size_t)(R0 + lane) * 8 + 4 + h]; r.ip = P.gates[(size_t)(R0 + lane) * 8 + h]; r.mprev = P.MPREV[item]; }
    if (w == 1 || w == 2) r.npv = P.NPREV[(size_t)item * 128 + (w - 1) * 64 + lane];
}
__device__ __forceinline__ void ho_load(int it, int tid, const OutPtrs& P, HoRegs& r) {
    const int lane = tid & 63, w = __builtin_amdgcn_readfirstlane(tid >> 6), d8 = tid & 15, sr = tid >> 4;
    const int b = it >> 9, h = (it >> 6) & 7, c = it & 63, R0 = b * T + c * 64;
#pragma unroll
    for (int j = 0; j < 4; ++j) { const int q = tid + NTHR * j; r.cs[j] = *(const GAS u32x4*)(P.HST + ((size_t)it * 128 + (q >> 4)) * 128 + (q & 15) * 8); }
#pragma unroll
    for (int i = 0; i < 2; ++i) { r.hv[i] = *(const GAS u32x4*)(P.HI + (size_t)(R0 + lane) * 1024 + h * 128 + (w + 8 * i) * 8);
        r.fv[i] = *(const GAS u32x4*)(P.HF + (size_t)(R0 + sr + 32 * i) * 1024 + h * 128 + d8 * 8); r.qw[i] = *(const GAS u32x4*)(P.HQ + (size_t)(R0 + sr + 32 * i) * 1024 + h * 128 + d8 * 8); }
}
__device__ __forceinline__ void mlstm_out_item(LAS unsigned char* lds, int item, int tid, const OutPtrs& P, MoRegs& rm, int nxt,
                                               const GAS bf16* MO, const GAS float* mhn, GAS bf16* YM) {
    const int lane = tid & 63, w = __builtin_amdgcn_readfirstlane(tid >> 6), l15 = lane & 15, lg = lane >> 4;
    const int b = item >> 8, h = (item >> 6) & 3, c = item & 63, R0 = b * T + c * 64;
    LAS float* sc = (LAS float*)lds;
    LAS unsigned char* Qs = lds + 4096;
    LAS unsigned char* Ks = Qs + 17408;
    LAS unsigned char* Ss = Ks + 17408;
    LAS unsigned char* Vt = Ss + 9216;
    LAS unsigned char* Cs = Vt + 36864;
    const int tt = w & 3, hh = w >> 2, t = 16 * tt + l15;
    {
#pragma unroll
        for (int i = 0; i < 2; ++i) { const int idx = tid + NTHR * i, s = idx >> 4, ch = idx & 15; *(LAS u32x4*)(Qs + s * 272 + ch * 16) = rm.qq[i]; *(LAS u32x4*)(Ks + s * 272 + ch * 16) = rm.kq[i]; }
#pragma unroll
        for (int i = 0; i < 4; ++i) put_t8(Vt, (w + 8 * i) * 8, lane, rm.vv[i]);
#pragma unroll
        for (int j = 0; j < 8; ++j) { const int q = tid + NTHR * j; *(LAS u32x4*)(Cs + (q >> 4) * 272 + (q & 15) * 16) = rm.cs[j]; }
        if (w == 0) {
            const float bs = wave_scan_incl(rm.fl, lane); float pm = rm.ip - bs;
#pragma unroll
            for (int o = 1; o < 64; o <<= 1) { const float u = __shfl_up(pm, o); if (lane >= o) pm = fmaxf(pm, u); }
            const float mt = bs + fmaxf(rm.mprev, pm);
            sc[lane] = bs; sc[64 + lane] = rm.ip; sc[128 + lane] = mt; sc[192 + lane] = __expf(bs + rm.mprev - mt);
        }
        if (w == 1 || w == 2) sc[512 + (w - 1) * 64 + lane] = rm.npv;
        if (nxt < 512) mo_load(nxt, tid, P, rm);
    }
    __syncthreads();
    bf16x8 qf[4];
#pragma unroll
    for (int kk = 0; kk < 4; ++kk) qf[kk] = ldfrag(Qs, t, 272, (32 * kk + 8 * lg) * 2);
    f32x4 a2[8];
#pragma unroll
    for (int et = 0; et < 8; ++et) { f32x4 a = {0.f, 0.f, 0.f, 0.f};
#pragma unroll
        for (int kk = 0; kk < 4; ++kk) a = MFMA16(ldfrag(Cs, 128 * hh + 16 * et + l15, 272, (32 * kk + 8 * lg) * 2), qf[kk], a);
        a2[et] = a; }
    float qn;
    {
        float acc = 0.f;
#pragma unroll
        for (int kk = 0; kk < 4; ++kk) { const f32x4 n0 = *(const LAS f32x4*)(sc + 512 + 32 * kk + 8 * lg), n1 = *(const LAS f32x4*)(sc + 512 + 32 * kk + 8 * lg + 4);
            float q8[8]; unpack8(__builtin_bit_cast(u32x4, qf[kk]), q8);
            acc += (q8[0] * n0[0] + q8[1] * n0[1]) + (q8[2] * n0[2] + q8[3] * n0[3]) + (q8[4] * n1[0] + q8[5] * n1[1]) + (q8[6] * n1[2] + q8[7] * n1[3]); }
        acc += __shfl_xor(acc, 16); acc += __shfl_xor(acc, 32); qn = acc;
    }
    {
        const float bt = sc[t], mt = sc[128 + t]; float rs = 0.f;
#pragma unroll
        for (int j = 0; j < 2; ++j) {
            const int st = 2 * hh + j; f32x4 a = {0.f, 0.f, 0.f, 0.f};
            if (st <= tt) {
#pragma unroll
                for (int kk = 0; kk < 4; ++kk) a = MFMA16(ldfrag(Ks, 16 * st + l15, 272, (32 * kk + 8 * lg) * 2), qf[kk], a);
            }
            float o[4];
#pragma unroll
            for (int r = 0; r < 4; ++r) { const int s = 16 * st + 4 * lg + r; o[r] = (s <= t) ? a[r] * __expf(bt - sc[s] + sc[64 + s] - mt) : 0.f; }
            u32x2 wv; wv.x = pk2(o[0], o[1]); wv.y = pk2(o[2], o[3]);
            *(LAS u32x2*)(Ss + t * 144 + (16 * st + 4 * lg) * 2) = wv;
            rs += (lo_bf(wv.x) + hi_bf(wv.x)) + (lo_bf(wv.y) + hi_bf(wv.y));
        }
        rs += __shfl_xor(rs, 16); rs += __shfl_xor(rs, 32);
        if (lg == 0) sc[256 + 64 * hh + t] = rs;
    }
    u32x2 mo[8];
#pragma unroll
    for (int et = 0; et < 8; ++et) mo[et] = *(const GAS u32x2*)(MO + (size_t)(R0 + t) * 1024 + h * 256 + 128 * hh + 16 * et + 4 * lg);
    __syncthreads();
    {
        const bf16x8 s0 = ldfrag(Ss, t, 144, (8 * lg) * 2), s1 = ldfrag(Ss, t, 144, (32 + 8 * lg) * 2);
        const float wi = sc[192 + t];
        const float den = (sc[256 + t] + sc[320 + t]) + wi * qn; const float dinv = 1.0f / fmaxf(fabsf(den), __expf(-sc[128 + t]));
        float q2 = 0.f;
#pragma unroll
        for (int et = 0; et < 8; ++et) {
            const int e0 = 128 * hh + 16 * et; f32x4 a1 = {0.f, 0.f, 0.f, 0.f};
            a1 = MFMA16(ldfrag(Vt, e0 + l15, 144, (8 * lg) * 2), s0, a1); a1 = MFMA16(ldfrag(Vt, e0 + l15, 144, (32 + 8 * lg) * 2), s1, a1);
#pragma unroll
            for (int r = 0; r < 4; ++r) { const float hv = (a1[r] + wi * a2[et][r]) * dinv; a2[et][r] = hv; q2 += hv * hv; }
        }
        q2 += __shfl_xor(q2, 16); q2 += __shfl_xor(q2, 32);
        if (lg == 0) sc[384 + 64 * hh + t] = q2;
        __syncthreads();
        const float rn = rsqrtf((sc[384 + t] + sc[448 + t]) * (1.0f / 256.0f) + EPS);
#pragma unroll
        for (int et = 0; et < 8; ++et) {
            const int e = 128 * hh + 16 * et + 4 * lg; const f32x4 g4 = *(const LAS f32x4*)(Cs + 69632 + e * 4);
            u32x2 o; o.x = pk2(a2[et][0] * rn * g4[0] * lo_bf(mo[et].x), a2[et][1] * rn * g4[1] * hi_bf(mo[et].x)); o.y = pk2(a2[et][2] * rn * g4[2] * lo_bf(mo[et].y), a2[et][3] * rn * g4[3] * hi_bf(mo[et].y));
            *(GAS u32x2*)(YM + (size_t)(R0 + t) * 1024 + h * 256 + e) = o;
        }
    }
    __syncthreads();
}

__device__ __forceinline__ void hgrn_out_item(LAS unsigned char* lds, int it, int tid, const OutPtrs& P, HoRegs& rh, int nxt, const GAS bf16* HG, const GAS float* lbl, const GAS float* hhn, GAS bf16* YH) {
    const int lane = tid & 63, w = __builtin_amdgcn_readfirstlane(tid >> 6), l15 = lane & 15, lg = lane >> 4;
    const int b = it >> 9, h = (it >> 6) & 7, c = it & 63, R0 = b * T + c * 64;
    LAS float* sc = (LAS float*)lds;
    LAS float* Gs = (LAS float*)(lds + 4096);
    LAS unsigned char* Qt = lds + 4096 + 32768;
    LAS unsigned char* Kt = Qt + 17408;
    LAS unsigned char* Qe = Kt + 17408;
    LAS unsigned char* As = Qe + 17408;
    LAS unsigned char* Vt = As + 9216;
    LAS unsigned char* Cs = Vt + 18432;
    const int d8 = tid & 15, sr = tid >> 4;
    const int tt = w & 3, hh = w >> 2, t = 16 * tt + l15;
    float qv[2][8], kv[2][8];
    {
#pragma unroll
        for (int j = 0; j < 4; ++j) { const int q = tid + NTHR * j; *(LAS u32x4*)(Cs + (q >> 4) * 272 + (q & 15) * 16) = rh.cs[j]; }
        float lbv[8];
        { const LAS float* LBV = (const LAS float*)(Cs + 34816); const int dd = h * 128 + d8 * 8; const f32x4 a0 = *(const LAS f32x4*)(LBV + dd), a1 = *(const LAS f32x4*)(LBV + dd + 4);
#pragma unroll
          for (int e = 0; e < 4; ++e) { lbv[e] = a0[e]; lbv[4 + e] = a1[e]; } }
#pragma unroll
        for (int i = 0; i < 2; ++i) {
            put_t8(Vt, (w + 8 * i) * 8, lane, rh.hv[i]);
            float f[8]; unpack8(rh.fv[i], f); unpack8(rh.qw[i], qv[i]); f32x4 g0, g1;
#pragma unroll
            for (int e = 0; e < 8; ++e) { const float sg = sigmoidf_(f[e]); const float g = __logf(lbv[e] + (1.f - lbv[e]) * sg); kv[i][e] = (1.f - lbv[e]) * (1.f - sg); if (e < 4) g0[e] = g; else g1[e - 4] = g; }
            *(LAS f32x4*)(Gs + (sr + 32 * i) * 128 + d8 * 8) = g0; *(LAS f32x4*)(Gs + (sr + 32 * i) * 128 + d8 * 8 + 4) = g1;
        }
    }
    u32x2 hg[4];
#pragma unroll
    for (int et = 0; et < 4; ++et) hg[et] = *(const GAS u32x2*)(HG + (size_t)(R0 + t) * 1024 + h * 128 + 64 * hh + 16 * et + 4 * lg);
    if (nxt < 512 + 1024) ho_load(nxt - 512, tid, P, rh);
    __syncthreads();
    {
        const int d = tid & 127, seg = tid >> 7; float g[16]; float Gc = 0.f;
#pragma unroll
        for (int j = 0; j < 16; ++j) g[j] = Gs[(16 * seg + j) * 128 + d];
#pragma unroll
        for (int j = 0; j < 16; ++j) { Gc += g[j]; Gs[(16 * seg + j) * 128 + d] = Gc; }
        sc[128 + seg * 128 + d] = Gc;
    }
    __syncthreads();
    {
        float t0[8], t1[8], t2[8], gm[8];
        { const f32x4 a0 = *(const LAS f32x4*)(sc + 128 + d8 * 8), a1 = *(const LAS f32x4*)(sc + 128 + d8 * 8 + 4), b0 = *(const LAS f32x4*)(sc + 256 + d8 * 8), b1 = *(const LAS f32x4*)(sc + 256 + d8 * 8 + 4),
                      c0 = *(const LAS f32x4*)(sc + 384 + d8 * 8), c1 = *(const LAS f32x4*)(sc + 384 + d8 * 8 + 4), m0 = *(const LAS f32x4*)(Gs + 31 * 128 + d8 * 8), m1 = *(const LAS f32x4*)(Gs + 31 * 128 + d8 * 8 + 4);
#pragma unroll
          for (int e = 0; e < 4; ++e) { t0[e] = a0[e]; t0[4 + e] = a1[e]; t1[e] = b0[e]; t1[4 + e] = b1[e]; t2[e] = c0[e]; t2[4 + e] = c1[e]; gm[e] = m0[e] + a0[e]; gm[4 + e] = m1[e] + a1[e]; } }
#pragma unroll
        for (int i = 0; i < 2; ++i) { const int s = sr + 32 * i, seg = s >> 4;
            const f32x4 g0 = *(const LAS f32x4*)(Gs + s * 128 + d8 * 8), g1 = *(const LAS f32x4*)(Gs + s * 128 + d8 * 8 + 4);
            float g[8] = {g0[0], g0[1], g0[2], g0[3], g1[0], g1[1], g1[2], g1[3]};
            float a[8], bq[8], cq[8];
#pragma unroll
            for (int e = 0; e < 8; ++e) { g[e] += (seg > 0 ? t0[e] : 0.f) + (seg > 1 ? t1[e] : 0.f) + (seg > 2 ? t2[e] : 0.f);
                a[e] = qv[i][e] * __expf(g[e] - gm[e]); bq[e] = kv[i][e] * __expf(gm[e] - g[e]); cq[e] = qv[i][e] * __expf(g[e]); }
            u32x4 o; o.x = pk2(a[0], a[1]); o.y = pk2(a[2], a[3]); o.z = pk2(a[4], a[5]); o.w = pk2(a[6], a[7]); *(LAS u32x4*)(Qt + s * 272 + d8 * 16) = o;
            o.x = pk2(bq[0], bq[1]); o.y = pk2(bq[2], bq[3]); o.z = pk2(bq[4], bq[5]); o.w = pk2(bq[6], bq[7]); *(LAS u32x4*)(Kt + s * 272 + d8 * 16) = o;
            o.x = pk2(cq[0], cq[1]); o.y = pk2(cq[2], cq[3]); o.z = pk2(cq[4], cq[5]); o.w = pk2(cq[6], cq[7]); *(LAS u32x4*)(Qe + s * 272 + d8 * 16) = o; }
    }
    __syncthreads();
    {
        bf16x8 qf[4];
#pragma unroll
        for (int kk = 0; kk < 4; ++kk) qf[kk] = ldfrag(Qt, t, 272, (32 * kk + 8 * lg) * 2);
#pragma unroll
        for (int j = 0; j < 2; ++j) {
            const int st = 2 * hh + j; f32x4 a = {0.f, 0.f, 0.f, 0.f};
            if (st <= tt) {
#pragma unroll
                for (int kk = 0; kk < 4; ++kk) a = MFMA16(ldfrag(Kt, 16 * st + l15, 272, (32 * kk + 8 * lg) * 2), qf[kk], a);
            }
            float o[4];
#pragma unroll
            for (int r = 0; r < 4; ++r) { const int s = 16 * st + 4 * lg + r; o[r] = (s <= t) ? a[r] : 0.f; }
            u32x2 wv; wv.x = pk2(o[0], o[1]); wv.y = pk2(o[2], o[3]);
            *(LAS u32x2*)(As + t * 144 + (16 * st + 4 * lg) * 2) = wv;
        }
    }
    f32x4 oacc[4];
    {
        bf16x8 qe[4];
#pragma unroll
        for (int kk = 0; kk < 4; ++kk) qe[kk] = ldfrag(Qe, t, 272, (32 * kk + 8 * lg) * 2);
#pragma unroll
        for (int et = 0; et < 4; ++et) { f32x4 a = {0.f, 0.f, 0.f, 0.f};
#pragma unroll
            for (int kk = 0; kk < 4; ++kk) a = MFMA16(ldfrag(Cs, 64 * hh + 16 * et + l15, 272, (32 * kk + 8 * lg) * 2), qe[kk], a);
            oacc[et] = a; }
    }
    __syncthreads();
    {
        const bf16x8 a0 = ldfrag(As, t, 144, (8 * lg) * 2), a1 = ldfrag(As, t, 144, (32 + 8 * lg) * 2);
        float q2 = 0.f;
#pragma unroll
        for (int et = 0; et < 4; ++et) {
            const int e0 = 64 * hh + 16 * et; f32x4 a = oacc[et];
            a = MFMA16(ldfrag(Vt, e0 + l15, 144, (8 * lg) * 2), a0, a); a = MFMA16(ldfrag(Vt, e0 + l15, 144, (32 + 8 * lg) * 2), a1, a);
            oacc[et] = a; q2 += (a[0] * a[0] + a[1] * a[1]) + (a[2] * a[2] + a[3] * a[3]);
        }
        q2 += __shfl_xor(q2, 16); q2 += __shfl_xor(q2, 32);
        if (lg == 0) sc[64 * hh + t] = q2;
        __syncthreads();
        const float rn = rsqrtf((sc[t] + sc[64 + t]) * (1.0f / 128.0f) + EPS);
#pragma unroll
        for (int et = 0; et < 4; ++et) {
            const int e = 64 * hh + 16 * et + 4 * lg; const f32x4 g4 = *(const LAS f32x4*)(Cs + 34816 + 4096 + (h * 128 + e) * 4);
            u32x2 o; o.x = pk2(oacc[et][0] * rn * g4[0] * lo_bf(hg[et].x), oacc[et][1] * rn * g4[1] * hi_bf(hg[et].x)); o.y = pk2(oacc[et][2] * rn * g4[2] * lo_bf(hg[et].y), oacc[et][3] * rn * g4[3] * hi_bf(hg[et].y));
            *(GAS u32x2*)(YH + (size_t)(R0 + t) * 1024 + h * 128 + e) = o;
        }
    }
    __syncthreads();
}

typedef const volatile unsigned long long __attribute__((address_space(4)))* KArgs;
#define KINP(i) ((const float*)kargs[(i)])
constexpr int I0 = N_FFN_ITEMS, I1 = I0 + 7424, I2 = I1 + 4096, I3 = I2 + 1024, I4 = I3 + 1024, I5 = I4 + 2048, I6 = I5 + 4096, I7 = I6 + 2048;
__device__ __forceinline__ CvtDesc w_desc(KArgs kargs, unsigned char* ws, int it) {
    if (it < I0) return ffn_desc(it, KINP(I_F1W1), KINP(I_F1W3), KINP(I_F1W2), KINP(I_NFFN1), (bf16*)(ws + WS_W13), (bf16*)(ws + WS_W2T));
    if (it < I1) { const int r = it - I0, nb = r % 232, kb = r / 232;
        const int col0 = nb < 96 ? nb * 32 : (nb < 224 ? nb * 32 + 8 : 3072); const int nv = nb < 224 ? 32 : (nb == 224 ? 8 : 0);
        return mk_desc(KINP(I_WIN), DIN, col0, nv, kb * 64, KINP(I_NMIX), (bf16*)(ws + WS_WIN) + (size_t)nb * 32 * D, D); }
    if (it < I2) { const int r = it - I1, nb = r % 128, kb = r / 128; return mk_desc(KINP(I_WIN), DIN, 7176 + nb * 32, 32, kb * 64, KINP(I_NMIX), (bf16*)(ws + WS_WG) + (size_t)nb * 32 * D, D); }
    if (it < I3) { const int r = it - I2, nb = r % 64, kb = r / 64; return mk_desc(KINP(I_WPM), D, nb * 32, 32, kb * 64, nullptr, (bf16*)(ws + WS_WPM) + (size_t)nb * 32 * 1024, 1024); }
    if (it < I4) { const int r = it - I3, nb = r % 64, kb = r / 64; return mk_desc(KINP(I_WPH), D, nb * 32, 32, kb * 64, nullptr, (bf16*)(ws + WS_WPH) + (size_t)nb * 32 * 1024, 1024); }
    if (it < I5) { const int r = it - I4, nb = r % 64, kb = r / 64; return mk_desc(KINP(I_WOUT), D, nb * 32, 32, kb * 64, nullptr, (bf16*)(ws + WS_WOUT) + (size_t)nb * 32 * D, D); }
    if (it < I6) { const int r = it - I5, nb = r % 128, kb = r / 128; return mk_desc(KINP(I_WKV), 2 * D, nb * 32, 32, kb * 64, nullptr, (bf16*)(ws + WS_WKV) + (size_t)nb * 32 * D, D); }
    { const int r = it - I6, nb = r % 64, kb = r / 64; return mk_desc(KINP(I_WO), D, nb * 32, 32, kb * 64, nullptr, (bf16*)(ws + WS_WO) + (size_t)nb * 32 * D, D); }
}
constexpr int WIN_P0 = 3712;
template <bool EARLY>
__device__ __forceinline__ void copy_items(KArgs kargs, unsigned char* ws, int first, int count, int cw, int ncw) {
    int ln = threadIdx.x & 63; asm volatile("" : "+v"(ln));
#pragma unroll 1
    for (int base = cw; base < count; base += 4 * ncw) {
        CvtDesc d[4]; f32x4 v[4][8];
#pragma unroll
        for (int u = 0; u < 4; ++u) { const int j = base + u * ncw; if (j < count) { d[u] = w_desc(kargs, ws, EARLY ? (j < 11264 ? j : (j < 11264 + WIN_P0 ? (I1 - WIN_P0) + (j - 11264) : I4 + (j - 11264 - WIN_P0))) : first + j); cvt_load(d[u], ln, v[u]); } }
#pragma unroll
        for (int u = 0; u < 4; ++u) { const int j = base + u * ncw; if (j < count) cvt_store(d[u], ln, v[u]); }
    }
}
__device__ __forceinline__ void wq_row(KArgs kargs, unsigned char* ws, int d, int lane) {
    const float g = KINP(I_NX)[d]; const f32x4* src = (const f32x4*)(KINP(I_WQ) + (size_t)d * D) + lane; bf16* dst = (bf16*)(ws + WS_WQ) + (size_t)d * D;
    f32x4 v[8];
#pragma unroll
    for (int j = 0; j < 8; ++j) v[j] = __builtin_nontemporal_load(src + 64 * j);
#pragma unroll
    for (int j = 0; j < 8; ++j) { const f32x4 o = v[j] * g; u32x2 w; w.x = pk2(o[0], o[1]); w.y = pk2(o[2], o[3]); *(GAS u32x2*)(dst + 256 * j + 4 * lane) = w; }
}

__global__ void __launch_bounds__(NTHR, 2) fwd_kernel(Args args) {
    extern __shared__ __attribute__((aligned(16))) unsigned char lds_raw[];
    LAS unsigned char* lds = (LAS unsigned char*)lds_raw;
    volatile LAS unsigned* MISC = (volatile LAS unsigned*)(lds + MISC_OFF);
    const int tid = threadIdx.x, lane = tid & 63, wave = __builtin_amdgcn_readfirstlane(tid >> 6);
    const int G = gridDim.x, bid = blockIdx.x;
    KArgs kargs = (KArgs)__builtin_amdgcn_kernarg_segment_ptr();
#define INP(i) ((const float*)kargs[(i)])
    unsigned char* ws = (unsigned char*)kargs[29];
    unsigned* ctl = (unsigned*)(ws + WS_CTL);
    if (tid < 64) MISC[tid] = 0u;
    __syncthreads();
    XcdBarrier bar = xcd_barrier_post(ctl + CW_BAR, MISC + 8);
    u64* ss = (u64*)(ws + WS_CTL + CTL_SS);
    const int gw = bid * NWAVES + wave, NGW = G * NWAVES;
    float* X = (float*)(ws + WS_X); bf16* XB = (bf16*)(ws + WS_XB);
    float* smallf = (float*)(ws + WS_SMALL);

    const bool split = (G == 256);
    constexpr int NEARLY = 11264 + WIN_P0 + (I7 - I4), NMID = (I1 - WIN_P0) - 11264, NLATE = I4 - I1;

    for (int rep_ = 0; rep_ < NREP(0); ++rep_) if (rep_ == 0 || (xcd_barrier(bar), true))
    {
        if (split) copy_items<true>(kargs, ws, 0, NEARLY, gw, NGW); else copy_items<false>(kargs, ws, 0, I7, gw, NGW);
#pragma unroll 1
        for (int d = gw; d < D; d += NGW) wq_row(kargs, ws, d, lane);
#pragma unroll 1
        for (int it = gw; it < 8192 + 512; it += NGW) {
            if (it < 8192) { const int row = it;
                const f32x4* src = (const f32x4*)(INP(I_X) + (size_t)row * D) + lane; bf16* dst = XB + (size_t)row * D; float s = 0.f;
                f32x4 v[8];
#pragma unroll
                for (int j = 0; j < 8; ++j) v[j] = __builtin_nontemporal_load(src + 64 * j);
#pragma unroll
                for (int j = 0; j < 8; ++j) { s += (v[j][0] * v[j][0] + v[j][1] * v[j][1]) + (v[j][2] * v[j][2] + v[j][3] * v[j][3]); u32x2 w; w.x = pk2(v[j][0], v[j][1]); w.y = pk2(v[j][2], v[j][3]); *(u32x2*)(dst + 256 * j + 4 * lane) = w; }
                s = wave_sum(s); if (lane == 0) ss[row] = (u64)(s * SS_SCALE); }
            else { const int row = it - 8192;
                const f32x4* src = (const f32x4*)(INP(I_MEM) + (size_t)row * D) + lane; const f32x4* gp = (const f32x4*)INP(I_NMEM) + lane; bf16* dst = (bf16*)(ws + WS_MEMN) + (size_t)row * D;
                f32x4 v[8]; float s = 0.f;
#pragma unroll
                for (int j = 0; j < 8; ++j) { v[j] = __builtin_nontemporal_load(src + 64 * j); s += (v[j][0] * v[j][0] + v[j][1] * v[j][1]) + (v[j][2] * v[j][2] + v[j][3] * v[j][3]); }
                const float r = rsqrtf(wave_sum(s) * (1.0f / D) + EPS);
#pragma unroll
                for (int j = 0; j < 8; ++j) { const f32x4 o = v[j] * r * gp[64 * j]; u32x2 w; w.x = pk2(o[0], o[1]); w.y = pk2(o[2], o[3]); *(u32x2*)(dst + 256 * j + 4 * lane) = w; } }
        }
    }
    xcd_barrier(bar);

    const bool LOCF = (MISC[11] != 0u);
    const int lrf = (int)MISC[10], xf = (int)bar.x;
    unsigned* rdyMID = ctl + 12416; unsigned* rdyKV = ctl + 12480;
#define FRONT_BARRIER() do { if (LOCF) xcd_local_barrier(bar, lrf & 3, ctl + 13312); else xcd_barrier(bar); } while (0)
    for (int rep_ = 0; rep_ < NREP(1); ++rep_) if (rep_ == 0 || (xcd_barrier(bar), true))
    { SchedUpKv S; S.o.init(32, 44, G, bid); S.G = G; S.c = bid; S.XBp = (const char*)XB; S.W13p = (const char*)(ws + WS_W13); S.MEMNp = (const char*)(ws + WS_MEMN); S.WKVp = (const char*)(ws + WS_WKV);
      S.loc = 0; S.p0 = 0; S.xq = 0; if (LOCF) { S.loc = 1; S.p0 = 4 * xf; S.xq = xf; S.c = lrf; }
      EpiUpKv E{EpiUp{(bf16*)(ws + AR_ACT), ss + 0 * M}, (bf16*)(ws + WS_KV)};
      pg8::gemm_phase((const char*)ws, lds, D, D, S, E);
      if (LOCF) {
          if (lrf >= 16 && lrf < 20) publish_count(rdyKV);
          if (lrf >= 20) { copy_items<false>(kargs, ws, 11264, NMID, (xf * 12 + lrf - 20) * NWAVES + wave, 96 * NWAVES); publish_count(rdyMID); }
      } else if (split && bid >= 160) copy_items<false>(kargs, ws, 11264, NMID, (bid - 160) * NWAVES + wave, 96 * NWAVES); }
    FRONT_BARRIER();
    if (LOCF) await_count(rdyMID, 96u, bar.bar);
    for (int rep_ = 0; rep_ < NREP(2); ++rep_) if (rep_ == 0 || (xcd_barrier(bar), true))
    { SchedStd S; S.o.init(32, 8, G, bid); if (LOCF) S.o.init_loc(8, 4 * xf, lrf);
      S.A = (const char*)(ws + AR_ACT); S.B = (const char*)(ws + WS_W2T); S.astep = (size_t)256 * FF * 2; S.bstep = (size_t)256 * FF * 2; S.bbatch = 0; S.nt = FF / 64;
      EpiRes<true> E{INP(I_X), XB, ss + 1 * M, 0.5f};
      pg8::gemm_phase((const char*)ws, lds, FF, FF, S, E); }
    FRONT_BARRIER();
    if (LOCF) await_count(rdyKV, 32u, bar.bar);
    for (int rep_ = 0; rep_ < NREP(3); ++rep_) if (rep_ == 0 || (xcd_barrier(bar), true))
    { SchedInW S; S.o.init(32, 29, G, bid); S.G = G; S.c = bid; S.XBp = (const char*)XB; S.WINp = (const char*)(ws + WS_WIN); S.Kp = (const char*)(ws + WS_KV); S.Vp = (const char*)(ws + WS_KV) + (size_t)512 * D * 2;
      S.WQp = (const char*)(ws + WS_WQ); S.WOp = (const char*)(ws + WS_WO);
      S.loc = 0; S.p0 = 0; S.xq = 0; if (LOCF) { S.loc = 1; S.p0 = 4 * xf; S.xq = xf; S.c = lrf; }
      EpiInW E{EpiInproj{ws, ss + 1 * M, INP(I_IGB), INP(I_FGB)}, (bf16*)(ws + WS_WQKT), (bf16*)(ws + WS_VWOT)};
      pg8::gemm_phase((const char*)ws, lds, D, D, S, E);
      if (LOCF) { if (lrf >= 24) copy_items<false>(kargs, ws, I1, NLATE, (xf * 8 + lrf - 24) * NWAVES + wave, 64 * NWAVES); }
      else if (split && bid >= 192) copy_items<false>(kargs, ws, I1, NLATE, (bid - 192) * NWAVES + wave, 64 * NWAVES); }
    xcd_barrier(bar);

    const bool LOCM = (MISC[11] != 0u);
    const int lrk = (int)MISC[10], xq = (int)bar.x;
    const int ms = LOCM ? 32 : G;
    const int m0 = LOCM ? xq * 64 + lrk : bid, m1 = LOCM ? xq * 64 + 64 : 512;
    const int h0 = LOCM ? xq * 128 + lrk : (bid + G - 512 % G) % G, h1 = LOCM ? xq * 128 + 128 : 1024;
#define MIX_BARRIER() do { if (LOCM) xcd_local_barrier(bar); else xcd_barrier(bar); } while (0)
    for (int rep_ = 0; rep_ < NREP(7); ++rep_) if (rep_ == 0 || (xcd_barrier(bar), true))
    {
        const GAS float* convw = (const GAS float*)INP(I_CONVW); const GAS float* convb = (const GAS float*)INP(I_CONVB); const GAS float* lbl = (const GAS float*)INP(I_LBL);
        const GAS float* gates = (const GAS float*)(smallf + SM_GATES / 4);
        GAS float* BLAST = (GAS float*)(smallf + SM_BLAST / 4); GAS float* MLOC = (GAS float*)(smallf + SM_MLOC / 4); GAS float* DN = (GAS float*)(smallf + SM_DN / 4); GAS float* DEC = (GAS float*)(smallf + SM_DEC / 4);
        int tid7 = threadIdx.x; asm volatile("" : "+v"(tid7));
        {   MaRegs rm; const GAS bf16* QKRAW = (const GAS bf16*)(ws + AR_QKRAW); const GAS bf16* MV = (const GAS bf16*)(ws + AR_MV);
            if (m0 < m1) { mlstm_stage_convw(lds, (m0 >> 6) & 3, tid7, convw, convb); ma_load(m0, tid7, gates, QKRAW, MV, rm); }
#pragma unroll 1
            for (int item = m0; item < m1; item += ms)
                mlstm_state_item(lds, item, tid7, rm, (item + ms < m1) ? item + ms : (1 << 20), gates, convw, convb, QKRAW, (GAS bf16*)(ws + AR_QC), (GAS bf16*)(ws + AR_KC), MV, (GAS bf16*)(ws + AR_MST), DN, BLAST, MLOC);
        }
        {   HaRegs rh;
            const GAS bf16* HF = (const GAS bf16*)(ws + AR_HF); const GAS bf16* HI = (const GAS bf16*)(ws + AR_HI);
            if (h0 < h1) { LAS float* LBV = (LAS float*)(lds + 2048 + 34816 + 18432 + 18432 + 17408 * 2);
                LBV[tid7] = sigmoidf_(lbl[1024 + tid7] - lbl[tid7]); LBV[512 + tid7] = sigmoidf_(lbl[1536 + tid7] - lbl[512 + tid7]);
                ha_load(h0, tid7, HF, HI, rh); }
#pragma unroll 1
            for (int it = h0; it < h1; it += ms)
                hgrn_state_item(lds, it, tid7, rh, (it + ms < h1) ? it + ms : (1 << 20), HF, HI, lbl, (GAS bf16*)(ws + AR_HST), DEC);
        }
    }
    MIX_BARRIER();

    for (int rep_ = 0; rep_ < NREP(8); ++rep_) if (rep_ == 0 || (xcd_barrier(bar), true))
    {
        const float* BLAST = smallf + SM_BLAST / 4; const float* MLOC = smallf + SM_MLOC / 4; float* MPREV = smallf + SM_MPREV / 4; float* DN = smallf + SM_DN / 4; const float* DEC = smallf + SM_DEC / 4;
        bf16* MST = (bf16*)(ws + AR_MST); bf16* HST = (bf16*)(ws + AR_HST);
        const int q8 = LOCM ? (lrk < 16 ? (xq << 13) + lrk * NTHR + tid : 65536 + ((2 * xq + ((lrk - 16) >> 3)) << 12) + ((lrk - 16) & 7) * NTHR + tid) : bid * NTHR + tid;
        const int q8s = LOCM ? (1 << 24) : G * NTHR;
#pragma unroll 1
        for (int q = q8; q < 131072; q += q8s) {
            if (q < 65536) {
                const int bh = q >> 13, qi = q & 8191; float m = 0.f; f32x4 C = {0.f, 0.f, 0.f, 0.f};
#define P8_LDM(c0, dw, bl, ml) _Pragma("unroll") for (int j = 0; j < 8; ++j) { const int item = bh * 64 + (c0) + j; dw[j] = *(const u32x2*)(MST + (size_t)item * 32768 + qi * 4); bl[j] = BLAST[item]; ml[j] = MLOC[item]; }
#define P8_PRM(c0, dw, bl, ml) _Pragma("unroll") for (int j = 0; j < 8; ++j) { \
                        const int item = bh * 64 + (c0) + j; u32x2 cw; cw.x = pk2(C[0], C[1]); cw.y = pk2(C[2], C[3]); *(u32x2*)(MST + (size_t)item * 32768 + qi * 4) = cw; \
                        if (qi == 0) MPREV[item] = m; \
                        const float mn = fmaxf(bl[j] + m, ml[j]), dec = __expf(bl[j] + m - mn), wl = __expf(ml[j] - mn); \
                        C[0] = dec * C[0] + wl * lo_bf(dw[j].x); C[1] = dec * C[1] + wl * hi_bf(dw[j].x); C[2] = dec * C[2] + wl * lo_bf(dw[j].y); C[3] = dec * C[3] + wl * hi_bf(dw[j].y); m = mn; }
                u32x2 dwA[8], dwB[8]; float blA[8], mlA[8], blB[8], mlB[8];
                P8_LDM(0, dwA, blA, mlA); P8_LDM(8, dwB, blB, mlB);
                P8_PRM(0, dwA, blA, mlA); P8_LDM(16, dwA, blA, mlA); P8_PRM(8, dwB, blB, mlB); P8_LDM(24, dwB, blB, mlB); P8_PRM(16, dwA, blA, mlA); P8_LDM(32, dwA, blA, mlA); P8_PRM(24, dwB, blB, mlB); P8_LDM(40, dwB, blB, mlB);
                P8_PRM(32, dwA, blA, mlA); P8_LDM(48, dwA, blA, mlA); P8_PRM(40, dwB, blB, mlB); P8_LDM(56, dwB, blB, mlB); P8_PRM(48, dwA, blA, mlA); P8_PRM(56, dwB, blB, mlB);
#undef P8_LDM
#undef P8_PRM
            } else {
                const int q2 = q - 65536, bh = q2 >> 12, qi = q2 & 4095, d = (qi * 4) & 127; f32x4 Sx = {0.f, 0.f, 0.f, 0.f};
#define P8_LDH(c0, dw, dc) _Pragma("unroll") for (int j = 0; j < 8; ++j) { const int it = bh * 64 + (c0) + j; dw[j] = *(const u32x2*)(HST + (size_t)it * 16384 + qi * 4); dc[j] = *(const f32x4*)(DEC + (size_t)it * 128 + d); }
#define P8_PRH(c0, dw, dc) _Pragma("unroll") for (int j = 0; j < 8; ++j) { \
                        const int it = bh * 64 + (c0) + j; u32x2 cw; cw.x = pk2(Sx[0], Sx[1]); cw.y = pk2(Sx[2], Sx[3]); *(u32x2*)(HST + (size_t)it * 16384 + qi * 4) = cw; \
                        Sx[0] = dc[j][0] * Sx[0] + lo_bf(dw[j].x); Sx[1] = dc[j][1] * Sx[1] + hi_bf(dw[j].x); Sx[2] = dc[j][2] * Sx[2] + lo_bf(dw[j].y); Sx[3] = dc[j][3] * Sx[3] + hi_bf(dw[j].y); }
                u32x2 dwA[8], dwB[8]; f32x4 dcA[8], dcB[8];
                P8_LDH(0, dwA, dcA); P8_LDH(8, dwB, dcB);
                P8_PRH(0, dwA, dcA); P8_LDH(16, dwA, dcA); P8_PRH(8, dwB, dcB); P8_LDH(24, dwB, dcB); P8_PRH(16, dwA, dcA); P8_LDH(32, dwA, dcA); P8_PRH(24, dwB, dcB); P8_LDH(40, dwB, dcB);
                P8_PRH(32, dwA, dcA); P8_LDH(48, dwA, dcA); P8_PRH(40, dwB, dcB); P8_LDH(56, dwB, dcB); P8_PRH(48, dwA, dcA); P8_PRH(56, dwB, dcB);
#undef P8_LDH
#undef P8_PRH
            }
        }
#pragma unroll 1
        for (int q = LOCM ? ((lrk == 0 && tid < 128) ? xq * 128 + tid : 1024) : bid * NTHR + tid; q < 1024; q += q8s) {
            const int bh = q >> 7, d = q & 127; float m = 0.f, n = 0.f;
#pragma unroll 1
            for (int c0 = 0; c0 < 64; c0 += 16) {
                float dn[16], bl[16], ml[16];
#pragma unroll
                for (int j = 0; j < 16; ++j) { const int item = bh * 64 + c0 + j; dn[j] = DN[(size_t)item * 128 + d]; bl[j] = BLAST[item]; ml[j] = MLOC[item]; }
#pragma unroll
                for (int j = 0; j < 16; ++j) { const int item = bh * 64 + c0 + j; DN[(size_t)item * 128 + d] = n;
                    const float mn = fmaxf(bl[j] + m, ml[j]), dec = __expf(bl[j] + m - mn), wl = __expf(ml[j] - mn); n = dec * n + wl * dn[j]; m = mn; }
            }
        }
    }
    MIX_BARRIER();
    for (int rep_ = 0; rep_ < NREP(9); ++rep_) if (rep_ == 0 || (xcd_barrier(bar), true))
    {
        const GAS float* lbl = (const GAS float*)INP(I_LBL); const GAS float* mhn = (const GAS float*)INP(I_MHN); const GAS float* hhn = (const GAS float*)INP(I_HHN);
        const GAS float* gates = (const GAS float*)(smallf + SM_GATES / 4); const GAS float* MPREV = (const GAS float*)(smallf + SM_MPREV / 4); const GAS float* NPREV = (const GAS float*)(smallf + SM_DN / 4);
        int tid9 = threadIdx.x; asm volatile("" : "+v"(tid9));
        const OutPtrs OP{gates, MPREV, NPREV, (const GAS bf16*)(ws + AR_QC), (const GAS bf16*)(ws + AR_KC), (const GAS bf16*)(ws + AR_MV), (const GAS bf16*)(ws + AR_MST),
                         (const GAS bf16*)(ws + AR_HQ), (const GAS bf16*)(ws + AR_HF), (const GAS bf16*)(ws + AR_HI), (const GAS bf16*)(ws + AR_HST)};
        {   MoRegs rm;
            if (m0 < m1) { if (tid9 < 64) *(LAS f32x4*)(lds + 4096 + 17408 * 2 + 9216 + 36864 + 69632 + tid9 * 16) = *(const GAS f32x4*)(mhn + ((m0 >> 6) & 3) * 256 + tid9 * 4);
                             mo_load(m0, tid9, OP, rm); }
#pragma unroll 1
            for (int item = m0; item < m1; item += ms)
                mlstm_out_item(lds, item, tid9, OP, rm, (item + ms < m1) ? item + ms : (1 << 20), (const GAS bf16*)(ws + AR_MO), mhn, (GAS bf16*)(ws + AR_YM));
        }
        {   HoRegs rh; const int first = 512 + h0;
            if (h0 < h1) {
                LAS float* LBV = (LAS float*)(lds + 4096 + 32768 + 17408 * 3 + 9216 + 18432 + 34816);
                LBV[tid9] = sigmoidf_(lbl[1024 + tid9] - lbl[tid9]); LBV[512 + tid9] = sigmoidf_(lbl[1536 + tid9] - lbl[512 + tid9]);
                LBV[1024 + tid9] = hhn[tid9]; LBV[1536 + tid9] = hhn[512 + tid9];
                __syncthreads();
                ho_load(first - 512, tid9, OP, rh); }
#pragma unroll 1
            for (int item = first; item < 512 + h1; item += ms)
                hgrn_out_item(lds, item - 512, tid9, OP, rh, (item + ms < 512 + h1) ? item + ms : (1 << 20), (const GAS bf16*)(ws + AR_HG), lbl, hhn, (GAS bf16*)(ws + AR_YH));
        }
    }

    for (int rep_ = 0; rep_ < NREP(10); ++rep_) if (rep_ == 0 || (xcd_barrier(bar), true))
    { SchedStd S; S.o.init(32, 16, G, bid); if (LOCM) S.o.init_loc(16, 4 * xq, lrk);
      S.A = (const char*)XB; S.B = (const char*)(ws + WS_WG); S.astep = 256 * D * 2; S.bstep = 256 * D * 2; S.bbatch = 0; S.nt = 32;
      EpiGates E{(bf16*)(ws + AR_GM), (bf16*)(ws + AR_GH), ss + 1 * M};
      pg8::gemm_phase((const char*)ws, lds, D, D, S, E); }
    xcd_barrier(bar);
    const bool LOC = (MISC[11] != 0u);
    const int lrank = (int)MISC[10], lp0 = 4 * (int)bar.x;
    unsigned* rdyW13 = ctl + 12288; unsigned* rdyW2T = ctl + 12352;
#define PHASE_BARRIER() do { if (LOC) xcd_local_barrier(bar, lrank & 3, ctl + 13312); else xcd_barrier(bar); } while (0)
    for (int rep_ = 0; rep_ < NREP(11); ++rep_) if (rep_ == 0 || (xcd_barrier(bar), true))
    { SchedPair S{G, bid, (const char*)(ws + AR_YM), (const char*)(ws + AR_YH), (const char*)(ws + WS_WPM), (const char*)(ws + WS_WPH), 0, 0};
      if (LOC) { S.loc = 1; S.p0 = lp0; S.c = lrank; }
      EpiProj E{(const bf16*)(ws + AR_GM), (const bf16*)(ws + AR_GH), (bf16*)(ws + AR_MERGED)};
      pg8::gemm_phase((const char*)ws, lds, 1024, 1024, S, E); }
    PHASE_BARRIER();
    for (int rep_ = 0; rep_ < NREP(12); ++rep_) if (rep_ == 0 || (xcd_barrier(bar), true))
    { SchedStd S; S.o.init(32, 8, G, bid); if (LOC) S.o.init_loc(8, lp0, lrank);
      S.A = (const char*)(ws + AR_MERGED); S.B = (const char*)(ws + WS_WOUT); S.astep = 256 * D * 2; S.bstep = 256 * D * 2; S.bbatch = 0; S.nt = 32;
      EpiRes<false> E{nullptr, XB, ss + 2 * M, 1.0f};
      pg8::gemm_phase((const char*)ws, lds, D, D, S, E); }
    PHASE_BARRIER();
    for (int rep_ = 0; rep_ < NREP(13); ++rep_) if (rep_ == 0 || (xcd_barrier(bar), true))
    { SchedStd S; S.o.init(32, 4, G, bid); if (LOC) S.o.init_loc(4, lp0, lrank);
      S.A = (const char*)XB; S.B = (const char*)(ws + WS_WQKT); S.astep = 256 * D * 2; S.bstep = 256 * D * 2; S.bbatch = (size_t)1024 * D * 2; S.nt = 32;
      EpiScores E{(bf16*)(ws + AR_P), ss + 2 * M, (LAS float*)(lds + RING_BYTES)};
      pg8::gemm_phase((const char*)ws, lds, D, D, S, E);
      const int cfirst = (G > 128) ? 128 : 0, nconv = (G - cfirst) * NWAVES;
      const bool copier = LOC ? (lrank >= 16) : (bid >= cfirst); const int cidx = LOC ? ((int)bar.x * 16 + lrank - 16) : (bid - cfirst);
      if (copier) {
          const float* w1 = INP(I_F2W1); const float* w3 = INP(I_F2W3); const float* w2 = INP(I_F2W2); const float* gn = INP(I_NFFN2);
          const int nit = (G == 256) ? 11264 : N_FFN_ITEMS;
#pragma unroll 1
          for (int base = cidx * NWAVES + wave; base < nit; base += 4 * nconv) {
              CvtDesc d[4]; f32x4 v[4][8];
#pragma unroll
              for (int u = 0; u < 4; ++u) { const int it = base + u * nconv; if (it < nit) { d[u] = ffn_desc(it, w1, w3, w2, gn, (bf16*)(ws + WS_W13), (bf16*)(ws + WS_W2T)); cvt_load(d[u], lane, v[u]); } }
#pragma unroll
              for (int u = 0; u < 4; ++u) { const int it = base + u * nconv; if (it < nit) cvt_store(d[u], lane, v[u]); }
          }
          if (LOC) publish_count(rdyW13);
      } }
    PHASE_BARRIER();
    for (int rep_ = 0; rep_ < NREP(15); ++rep_) if (rep_ == 0 || (xcd_barrier(bar), true))
    { SchedStd S; S.o.init(32, 8, G, bid); if (LOC) S.o.init_loc(8, lp0, lrank);
      S.A = (const char*)(ws + AR_P); S.B = (const char*)(ws + WS_VWOT); S.astep = 256 * 1024 * 2; S.bstep = 256 * 1024 * 2; S.bbatch = (size_t)2048 * 1024 * 2; S.nt = 16;
      EpiRes<false> E{nullptr, XB, ss + 3 * M, 1.0f};
      pg8::gemm_phase((const char*)ws, lds, 1024, 1024, S, E); }
    PHASE_BARRIER();
    if (LOC) await_count(rdyW13, 128u, bar.bar);
    for (int rep_ = 0; rep_ < NREP(16); ++rep_) if (rep_ == 0 || (xcd_barrier(bar), true))
    { SchedStd S; S.o.init(32, 44, G, bid); if (LOC) S.o.init_loc(44, lp0, lrank);
      S.A = (const char*)XB; S.B = (const char*)(ws + WS_W13); S.astep = 256 * D * 2; S.bstep = 256 * D * 2; S.bbatch = 0; S.nt = 32;
      EpiUp E{(bf16*)(ws + AR_ACT), ss + 3 * M};
      pg8::gemm_phase((const char*)ws, lds, D, D, S, E);
      const bool copier16 = LOC ? (lrank >= 16) : (bid >= 128); const int cidx16 = LOC ? ((int)bar.x * 16 + lrank - 16) : (bid - 128);
      if (G == 256 && copier16) {
          const float* w1 = INP(I_F2W1); const float* w3 = INP(I_F2W3); const float* w2 = INP(I_F2W2); const float* gn = INP(I_NFFN2); const int nconv = 128 * NWAVES;
          int ln16 = threadIdx.x & 63; asm volatile("" : "+v"(ln16));
#pragma unroll 1
          for (int base = 11264 + cidx16 * NWAVES + wave; base < N_FFN_ITEMS; base += 4 * nconv) {
              CvtDesc d[4]; f32x4 v[4][8];
#pragma unroll
              for (int u = 0; u < 4; ++u) { const int it = base + u * nconv; if (it < N_FFN_ITEMS) { d[u] = ffn_desc(it, w1, w3, w2, gn, (bf16*)(ws + WS_W13), (bf16*)(ws + WS_W2T)); cvt_load(d[u], ln16, v[u]); } }
#pragma unroll
              for (int u = 0; u < 4; ++u) { const int it = base + u * nconv; if (it < N_FFN_ITEMS) cvt_store(d[u], ln16, v[u]); }
          }
          if (LOC) publish_count(rdyW2T);
      } }
    PHASE_BARRIER();
    if (LOC) await_count(rdyW2T, 128u, bar.bar);
    if (G == 256) {
        SchedStd S; S.o.init(32, 8, G, bid); if (LOC) S.o.init_loc(8, lp0, lrank); S.A = (const char*)(ws + AR_ACT); S.B = (const char*)(ws + WS_W2T); S.astep = (size_t)256 * FF * 2; S.bstep = (size_t)256 * FF * 2; S.bbatch = 0; S.nt = FF / 64;
        EpiResFinal E{XB, (float*)kargs[28], INP(I_NFIN), ss + 4 * M, ctl + CW_PANEL, 0.5f};
        pg8::gemm_phase((const char*)ws, lds, FF, FF, S, E);
    } else {
        { SchedStd S; S.o.init(32, 8, G, bid); S.A = (const char*)(ws + AR_ACT); S.B = (const char*)(ws + WS_W2T); S.astep = (size_t)256 * FF * 2; S.bstep = (size_t)256 * FF * 2; S.bbatch = 0; S.nt = FF / 64;
          EpiRes<false> E{nullptr, XB, ss + 4 * M, 0.5f};
          pg8::gemm_phase((const char*)ws, lds, FF, FF, S, E); }
        xcd_barrier(bar);
        for (int row = gw; row < M; row += NGW) {
            const float r = rinv_of(ss + 4 * M, row);
            const u32x2* src = (const u32x2*)(XB + (size_t)row * D) + lane; const f32x4* gp = (const f32x4*)INP(I_NFIN) + lane; f32x4* dst = (f32x4*)((float*)kargs[28] + (size_t)row * D) + lane;
#pragma unroll
            for (int j = 0; j < 8; ++j) { const u32x2 xw = src[64 * j]; const f32x4 xv = {lo_bf(xw.x), hi_bf(xw.x), lo_bf(xw.y), hi_bf(xw.y)}; dst[64 * j] = xv * r * gp[64 * j]; }
        }
    }
}

extern "C" void kernel_launch(void* const* d_in, const int* in_sizes, int n_in, void* d_out, int out_size, void* d_ws, size_t ws_size, hipStream_t stream) {
    static int grid = 0;
    if (grid == 0) {
        if (n_in != 28 || in_sizes[0] != M * D || out_size != M * D || ws_size < WS_END) {
            fprintf(stderr, "kernel_launch: unexpected problem: n_in %d in0 %d out %d ws %zu (need %zu)\n", n_in, n_in > 0 ? in_sizes[0] : -1, out_size, ws_size, (size_t)WS_END); grid = -1; return; }
        int dev = 0, cus = 0;
        if (hipGetDevice(&dev) != hipSuccess || hipDeviceGetAttribute(&cus, hipDeviceAttributeMultiprocessorCount, dev) != hipSuccess) { fprintf(stderr, "kernel_launch: device query failed\n"); grid = -1; return; }
        if (hipFuncSetAttribute((const void*)fwd_kernel, hipFuncAttributeMaxDynamicSharedMemorySize, LDS_BYTES) != hipSuccess) { fprintf(stderr, "kernel_launch: hipFuncSetAttribute failed\n"); grid = -1; return; }
        int per_cu = 0;
        if (hipOccupancyMaxActiveBlocksPerMultiprocessor(&per_cu, (const void*)fwd_kernel, NTHR, LDS_BYTES) != hipSuccess || per_cu < 1) fprintf(stderr, "kernel_launch: note: occupancy query reports %d\n", per_cu);
        (void)hipGetLastError();
        grid = cus;
    }
    if (grid < 0) return;
    if (hipMemsetAsync((char*)d_ws + WS_CTL, 0, CTL_ZERO_BYTES, stream) != hipSuccess) { fprintf(stderr, "kernel_launch: memset failed\n"); return; }
    Args a{};
    for (int i = 0; i < 28; ++i) a.in[i] = (const float*)d_in[i];
    a.out = (float*)d_out; a.ws = (unsigned char*)d_ws;
    hipLaunchKernelGGL(fwd_kernel, dim3(grid), dim3(NTHR), LDS_BYTES, stream, a);
}
```

```cpp
#include <hip/hip_runtime.h>
#include <cstdio>
#include <cstdint>

#define LAS __attribute__((address_space(3)))
#define GAS __attribute__((address_space(1)))
typedef unsigned short bf16;
typedef short bf16x8 __attribute__((ext_vector_type(8)));
typedef float f32x4 __attribute__((ext_vector_type(4)));
typedef float f32x2 __attribute__((ext_vector_type(2)));
typedef unsigned u32x4 __attribute__((ext_vector_type(4)));
typedef unsigned u32x2 __attribute__((ext_vector_type(2)));
typedef unsigned long long u64;

constexpr int NB = 2, T = 4096, D = 2048, FF = 5632, M = NB * T;
constexpr int MEM = 256, DIN = 11272;
constexpr float EPS = 1e-6f;
constexpr int NWAVES = 8, NTHR = 512;

constexpr size_t MiB = 1u << 20;
constexpr size_t WS_CTL = 0, CTL_ZERO_BYTES = 1 * MiB;
constexpr size_t WS_SMALL = 1 * MiB;
constexpr size_t WS_MEMN = 3 * MiB;
constexpr size_t WS_KV = 5 * MiB;
constexpr size_t WS_WQKT = 9 * MiB;
constexpr size_t WS_VWOT = 17 * MiB;
constexpr size_t WS_W13 = 25 * MiB;
constexpr size_t WS_W2T = 69 * MiB;
constexpr size_t WS_WIN = 91 * MiB;
constexpr size_t WS_WG = 120 * MiB;
constexpr size_t WS_WPM = 136 * MiB, WS_WPH = 140 * MiB;
constexpr size_t WS_WOUT = 144 * MiB;
constexpr size_t WS_WQ = 152 * MiB;
constexpr size_t WS_WKV = 160 * MiB;
constexpr size_t WS_WO = 176 * MiB;
constexpr size_t WS_X = 184 * MiB;
constexpr size_t WS_XB = 248 * MiB;
constexpr size_t WS_AR = 280 * MiB;
constexpr size_t WS_END = 512 * MiB;
constexpr size_t AR_ACT = WS_AR;
constexpr size_t AR_QKRAW = WS_AR, AR_QC = WS_AR + 16 * MiB, AR_KC = WS_AR + 24 * MiB, AR_MV = WS_AR + 32 * MiB, AR_MO = WS_AR + 48 * MiB;
constexpr size_t AR_HQ = WS_AR + 64 * MiB, AR_HF = WS_AR + 80 * MiB, AR_HI = WS_AR + 96 * MiB, AR_HG = WS_AR + 112 * MiB;
constexpr size_t AR_MST = WS_AR + 128 * MiB;
constexpr size_t AR_HST = WS_AR + 160 * MiB;
constexpr size_t AR_YM = WS_AR + 192 * MiB, AR_YH = WS_AR + 208 * MiB;
constexpr size_t AR_GM = WS_X, AR_GH = WS_X + 32 * MiB;
constexpr size_t AR_TMP = WS_AR;
constexpr size_t AR_MERGED = WS_AR + 64 * MiB;
constexpr size_t AR_SC = WS_AR;
constexpr size_t AR_P = WS_AR + 32 * MiB;
static_assert(AR_YH + 16 * MiB <= WS_END, "arena");
constexpr size_t SM_GATES = 0;
constexpr size_t SM_BLAST = 256 * 1024;
constexpr size_t SM_MLOC = SM_BLAST + 2048;
constexpr size_t SM_MPREV = SM_MLOC + 2048;
constexpr size_t SM_DN = 512 * 1024;
constexpr size_t SM_DEC = 768 * 1024;
constexpr int CW_BAR = 4096;
constexpr int CW_PANEL = 8192;
constexpr size_t CTL_SS = 64 * 1024;
constexpr float SS_SCALE = 16777216.0f, SS_INV = 1.0f / (16777216.0f * 2048.0f);

constexpr int LDS_BYTES = 163840, RING_BYTES = 131072, MISC_OFF = LDS_BYTES - 256;

#define RLX_AGENT __ATOMIC_RELAXED, __HIP_MEMORY_SCOPE_AGENT
__device__ __forceinline__ unsigned f2bf(float f) { unsigned u = __builtin_bit_cast(unsigned, f); return (u + 0x7fffu + ((u >> 16) & 1u)) >> 16; }
__device__ __forceinline__ float bf2f(unsigned h) { return __builtin_bit_cast(float, (h & 0xffffu) << 16); }
typedef float f32x2_t __attribute__((ext_vector_type(2))); typedef __bf16 bf16x2_t __attribute__((ext_vector_type(2)));
__device__ __forceinline__ unsigned pk2(float lo, float hi) { f32x2_t v = {lo, hi}; bf16x2_t b = __builtin_convertvector(v, bf16x2_t); return __builtin_bit_cast(unsigned, b); }
__device__ __forceinline__ float lo_bf(unsigned w) { return __builtin_bit_cast(float, w << 16); }
__device__ __forceinline__ float hi_bf(unsigned w) { return __builtin_bit_cast(float, w & 0xffff0000u); }
__device__ __forceinline__ float sigmoidf_(float x) { return __builtin_amdgcn_rcpf(1.0f + __expf(-x)); }
__device__ __forceinline__ float siluf_(float x) { return x * __builtin_amdgcn_rcpf(1.0f + __expf(-x)); }
__device__ __forceinline__ float wave_sum(float v) {
#pragma unroll
    for (int o = 1; o < 64; o <<= 1) v += __shfl_xor(v, o);
    return v;
}
__device__ __forceinline__ float wave_max(float v) {
#pragma unroll
    for (int o = 1; o < 64; o <<= 1) v = fmaxf(v, __shfl_xor(v, o));
    return v;
}

#define XB_TMO      128
#define XB_XCNT(j)  (256  + 64 * (j))
#define XB_XSUB(j)  (1280 + 64 * (j))
#define XB_XGEN(j)  (2304 + 64 * (j))
#define XB_TOP      3328
#define XB_TOPGEN   3392
#define XCD_BAR_WORDS 3456
#define XB_LSUB(j)  (3456 + 32 * (j))
#define XB_LGEN(j)  (3712 + 32 * (j))
#define XB_SPIN_CAP (1u << 18)
__device__ __forceinline__ unsigned xb_ld(unsigned* p)              { return __hip_atomic_load(p, __ATOMIC_RELAXED, __HIP_MEMORY_SCOPE_AGENT); }
__device__ __forceinline__ unsigned xb_add(unsigned* p, unsigned v) { return __hip_atomic_fetch_add(p, v, __ATOMIC_RELAXED, __HIP_MEMORY_SCOPE_AGENT); }
__device__ __forceinline__ unsigned xb_xcc_id() { return (unsigned)__builtin_amdgcn_s_getreg((3 << 11) | 20) & 0xFu; }
#define XB_SPIN(cond, bar) do { unsigned _sp = 0; while (cond) { __builtin_amdgcn_s_sleep(1); \
    if ((++_sp & 255u) == 0u) { if (xb_ld(&(bar)[XB_TMO])) break; if (_sp > XB_SPIN_CAP) { atomicAdd(&(bar)[XB_TMO], 1u); break; } } } } while (0)
struct XcdBarrier { unsigned* bar; unsigned x; volatile LAS unsigned* st; };
__device__ __forceinline__ XcdBarrier xcd_barrier_post(unsigned* bar, volatile LAS unsigned* st) {
    XcdBarrier b; b.bar = bar; b.x = xb_xcc_id(); b.st = st;
    if (threadIdx.x == 0) st[2] = xb_add(&bar[XB_XCNT(b.x)], 1u);
    return b;
}
__device__ __forceinline__ void xcd_barrier_complete(unsigned* bar, unsigned x, unsigned& nloc, unsigned& nx, unsigned& uniform) {
    const unsigned G = gridDim.x * gridDim.y * gridDim.z;
    unsigned sum, cnt, mine, sp = 0u;
    for (;;) {
        sum = 0u; cnt = 0u; mine = 0u;
#pragma unroll
        for (unsigned j = 0; j < 16; ++j) { const unsigned c = xb_ld(&bar[XB_XCNT(j)]); sum += c; cnt += (c > 0u) ? 1u : 0u; mine = (j == x) ? c : mine; }
        if (sum == G) break;
        __builtin_amdgcn_s_sleep(1);
        if ((++sp & 255u) == 0u) { if (xb_ld(&bar[XB_TMO])) break; if (sp > XB_SPIN_CAP) { atomicAdd(&bar[XB_TMO], 1u); break; } }
    }
    nloc = mine > 0u ? mine : 1u; nx = cnt > 0u ? cnt : 1u;
    uniform = (G == 256u && cnt == 8u) ? 1u : 0u;
#pragma unroll
    for (unsigned j = 0; j < 8; ++j) if (xb_ld(&bar[XB_XCNT(j)]) != 32u) uniform = 0u;
}
__device__ __forceinline__ void xcd_barrier(const XcdBarrier& b) {
    asm volatile("s_waitcnt vmcnt(0)" ::: "memory");
    __syncthreads();
    if (threadIdx.x == 0) {
        unsigned* bar = b.bar;
        __builtin_amdgcn_s_waitcnt(0);
        unsigned nloc = b.st[0], nx = b.st[1];
        if (nloc == 0u) { unsigned uni; xcd_barrier_complete(bar, b.x, nloc, nx, uni); b.st[0] = nloc; b.st[1] = nx; b.st[3] = uni; }
        const unsigned old = xb_add(&bar[XB_XSUB(b.x)], 1u);
        const unsigned gen = old / nloc;
        if (old + 1u == (gen + 1u) * nloc) {
            __builtin_amdgcn_fence(__ATOMIC_RELEASE, "agent");
            asm volatile("s_waitcnt vmcnt(0)" ::: "memory");
            const unsigned og = xb_add(&bar[XB_TOP], 1u);
            const unsigned tg = og / nx;
            if (og + 1u == (tg + 1u) * nx) xb_add(&bar[XB_TOPGEN], 1u);
            else XB_SPIN(xb_ld(&bar[XB_TOPGEN]) == tg, bar);
            xb_add(&bar[XB_XGEN(b.x)], 1u);
            __builtin_amdgcn_fence(__ATOMIC_ACQUIRE, "agent");
            asm volatile("s_waitcnt vmcnt(0)" ::: "memory");
        } else {
            XB_SPIN(xb_ld(&bar[XB_XGEN(b.x)]) == gen, bar);
            __builtin_amdgcn_fence(__ATOMIC_ACQUIRE, "agent");
            asm volatile("s_waitcnt vmcnt(0)" ::: "memory");
        }
    }
    __syncthreads();
}

__device__ __forceinline__ void xcd_local_barrier(const XcdBarrier& b, const int pg = -1, unsigned* pgw = nullptr) {
    asm volatile("s_waitcnt vmcnt(0)" ::: "memory");
    __syncthreads();
    if (threadIdx.x == 0) {
        unsigned* bar = b.bar;
        __builtin_amdgcn_s_waitcnt(0);
        const unsigned nloc = pg < 0 ? b.st[0] : 8u;
        unsigned* sub = pg < 0 ? &bar[XB_LSUB(b.x)] : pgw + 64 * (4 * (int)b.x + pg); unsigned* gnp = pg < 0 ? &bar[XB_LGEN(b.x)] : pgw + 64 * (4 * (int)b.x + pg) + 32;
        const unsigned old = xb_add(sub, 1u);
        asm volatile("buffer_inv sc1" ::: "memory");
        const unsigned gen = old / nloc;
        if (old + 1u == (gen + 1u) * nloc) xb_add(gnp, 1u);
        else XB_SPIN(xb_ld(gnp) == gen, bar);
        asm volatile("s_waitcnt vmcnt(0)" ::: "memory");
    }
    __syncthreads();
}
__device__ __forceinline__ void publish_count(unsigned* ctr) {
    asm volatile("s_waitcnt vmcnt(0)" ::: "memory");
    __syncthreads();
    if (threadIdx.x == 0) { __builtin_amdgcn_fence(__ATOMIC_RELEASE, "agent"); asm volatile("s_waitcnt vmcnt(0)" ::: "memory"); xb_add(ctr, 1u); }
}
__device__ __forceinline__ void await_before_barrier(unsigned* ctr, unsigned n, unsigned* bar) {
    if (threadIdx.x == 0) { XB_SPIN(xb_ld(ctr) < n, bar); }
}
__device__ __forceinline__ void await_count(unsigned* ctr, unsigned n, unsigned* bar) {
    if (threadIdx.x == 0) { XB_SPIN(xb_ld(ctr) < n, bar); __builtin_amdgcn_fence(__ATOMIC_ACQUIRE, "agent"); asm volatile("s_waitcnt vmcnt(0)" ::: "memory"); }
    __syncthreads();
}

namespace pg8 {
constexpr int BM = 256, BK = 64, HALF = 128, HTB = HALF * BK * 2, STAGE_BYTES = 8 * HTB, NXCD = 8, WGM = 8;
__host__ __device__ __forceinline__ int lds_byte(int r, int c) { return r * 128 + (((c >> 3) ^ (r & 7)) * 16) + (c & 7) * 2; }
__host__ __device__ __forceinline__ void stage_rc(int b, int& R, int& C) { const int pc = b / 1024, sb = b % 1024, r8 = sb / 128, pos = (sb % 128) / 16; R = pc * 8 + r8; C = (pos ^ r8) * 8; }
__host__ __device__ __forceinline__ int perm32(int rho) { const int n = rho >> 4, i = rho & 15; return 8 * (i >> 2) + 4 * n + (i & 3); }

struct Unit { int pm, pn, kind, aux, nt; };

struct TileOrder {
    int nM, nN, nwg, G, c, loc, p0;
    __device__ void init(int nM_, int nN_, int G_, int c_) { nM = nM_; nN = nN_; nwg = nM * nN; G = G_; c = c_; loc = 0; p0 = 0; }
    __device__ void init_loc(int nN_, int p0_, int lrank) { nM = 4; nN = nN_; nwg = 4 * nN_; G = 32; c = lrank; loc = 1; p0 = p0_; }
    __device__ bool tile(int i, int& pm, int& pn) const {
        if (loc) { const int L = i * 32 + c; if (L >= nwg) return false; pm = p0 + (L & 3); pn = L >> 2; return true; }
        return tileL((long)i * G + c, pm, pn); }
    __device__ bool tileL(long L, int& pm, int& pn) const {
        if (L >= nwg) return false;
        int wgid = (int)L; { const int q = nwg / NXCD, r = nwg % NXCD, xcd = wgid % NXCD, off = wgid / NXCD; wgid = (xcd < r ? xcd * (q + 1) : r * (q + 1) + (xcd - r) * q) + off; }
        const int nig = WGM * nN, gid = wgid / nig, fm = gid * WGM, gsz = (nM - fm) < WGM ? (nM - fm) : WGM;
        pm = fm + ((wgid % nig) % gsz); pn = (wgid % nig) / gsz; return true;
    }
};

template <class Epi, class Sched>
__device__ __forceinline__ void gemm_phase(const char* wsb, LAS unsigned char* lds, const int lda, const int ldb, const Sched& S, const Epi& E) {
    int tid_ = threadIdx.x; asm volatile("" : "+v"(tid_));
    const int tid = tid_, wid = __builtin_amdgcn_readfirstlane(tid >> 6), lane = tid & 63, wr = wid >> 2, wc = wid & 3, fr = lane & 15, fq = lane >> 4;
    unsigned voffA, voffB;
    { int R, C; stage_rc(tid * 16, R, C); const int Rb = (R & ~31) + perm32(R & 31);
      voffA = (unsigned)(R * lda + C) * 2u; voffB = (unsigned)(Rb * ldb + C) * 2u; }
    const unsigned hpA = 64u * (unsigned)lda * 2u, hpB = 64u * (unsigned)ldb * 2u;
    const __amdgpu_buffer_rsrc_t rsW = __builtin_amdgcn_make_buffer_rsrc((void*)wsb, (short)0, 0x7fffffff, 0x00020000);
    const size_t kstep = (size_t)(BK * 2);
    const size_t hstepA = (size_t)HALF * lda * 2, hstepB = (size_t)HALF * ldb * 2;
    const unsigned ldsw = (unsigned)wid * 1024u;
    const int aoff = lds_byte(wr * 64 + fr, fq * 8), boff = lds_byte(wc * 32 + fr, fq * 8), aoff1 = aoff ^ 64, boff1 = boff ^ 64;
#define PG8_SA(b, h) (((b) * 2 + (h)) * HTB)
#define PG8_SB(b, h) ((4 + (b) * 2 + (h)) * HTB)
#define PG8_STAGE(bufoff, gbase, voff, hp) do { const unsigned so_ = (unsigned)((const char*)(gbase) - wsb); \
        __builtin_amdgcn_raw_ptr_buffer_load_lds(rsW, (LAS unsigned*)(lds + (bufoff) + ldsw), 16, (voff), so_, 0, 0); \
        __builtin_amdgcn_raw_ptr_buffer_load_lds(rsW, (LAS unsigned*)(lds + (bufoff) + ldsw + 8192), 16, (voff), so_ + (hp), 0, 0); } while (0)
#define PG8_LDA(dst, b, h) do { _Pragma("unroll") for (int m = 0; m < 4; ++m) _Pragma("unroll") for (int k = 0; k < 2; ++k) dst[m][k] = *(const LAS bf16x8*)(lds + PG8_SA(b, h) + (k ? aoff1 : aoff) + m * 2048); } while (0)
#define PG8_LDB(dst, b, h) do { _Pragma("unroll") for (int n = 0; n < 2; ++n) _Pragma("unroll") for (int k = 0; k < 2; ++k) dst[n][k] = *(const LAS bf16x8*)(lds + PG8_SB(b, h) + (k ? boff1 : boff) + n * 2048); } while (0)
#define PG8_MMA(ai, bj, At, Bt) do { __builtin_amdgcn_s_setprio(1); _Pragma("unroll") for (int m = 0; m < 4; ++m) _Pragma("unroll") for (int n = 0; n < 2; ++n) _Pragma("unroll") for (int k = 0; k < 2; ++k) \
        acc[ai][bj][m][n] = __builtin_amdgcn_mfma_f32_16x16x32_bf16(Bt[n][k], At[m][k], acc[ai][bj][m][n], 0, 0, 0); __builtin_amdgcn_s_setprio(0); } while (0)
#define PG8_WAIT_V(n) asm volatile("s_waitcnt vmcnt(" #n ")" ::: "memory")
#define PG8_WAIT_L(n) asm volatile("s_waitcnt lgkmcnt(" #n ")" ::: "memory")
#define PG8_BAR __builtin_amdgcn_s_barrier()
#define PG8_SCHED __builtin_amdgcn_sched_barrier(0)
    Unit cur, nxt; int ui = 0;
    if (!S.next(0, cur)) return;
    f32x4 acc[2][2][4][2];
#pragma unroll
    for (int a = 0; a < 2; ++a)
#pragma unroll
        for (int b = 0; b < 2; ++b)
#pragma unroll
            for (int m = 0; m < 4; ++m)
#pragma unroll
                for (int n = 0; n < 2; ++n) acc[a][b][m][n] = (f32x4){0.f, 0.f, 0.f, 0.f};
    bf16x8 At[4][2], B0[2][2], B1[2][2];
    const char* cA; const char* cB; S.ptrs(cur, cA, cB);
    typename Epi::Pre pre; E.prefetch(cur, wr, fr, pre);
    PG8_STAGE(PG8_SB(0, 0), cB, voffB, hpB); PG8_STAGE(PG8_SB(0, 1), cB + hstepB, voffB, hpB); PG8_STAGE(PG8_SA(0, 0), cA, voffA, hpA); PG8_STAGE(PG8_SA(0, 1), cA + hstepA, voffA, hpA);
    if (wr == 1) PG8_BAR;
    PG8_WAIT_V(2); PG8_BAR;
    PG8_STAGE(PG8_SB(1, 0), cB + kstep, voffB, hpB); PG8_STAGE(PG8_SA(1, 0), cA + kstep, voffA, hpA); PG8_STAGE(PG8_SB(1, 1), cB + hstepB + kstep, voffB, hpB);
    PG8_WAIT_V(6); PG8_BAR;
    for (;;) {
        const bool has_next = S.next(ui + 1, nxt);
        const char* nA = cA + (size_t)(cur.nt - 2) * kstep; const char* nB = cB + (size_t)(cur.nt - 2) * kstep;
        if (has_next) S.ptrs(nxt, nA, nB);
        const int nt = cur.nt;
        for (int t = 0; t < nt; t += 2) {
            const bool last = (t == nt - 2);
            const char* a1 = cA + (size_t)(t + 1) * kstep;
            const char* a2 = last ? nA : cA + (size_t)(t + 2) * kstep; const char* b2 = last ? nB : cB + (size_t)(t + 2) * kstep;
            const char* a3 = a2 + kstep; const char* b3 = b2 + kstep;
            PG8_LDB(B0, 0, 0); PG8_LDB(B1, 0, 1); PG8_SCHED; PG8_LDA(At, 0, 0); PG8_STAGE(PG8_SA(1, 1), a1 + hstepA, voffA, hpA);
            PG8_WAIT_V(8); PG8_WAIT_L(0); PG8_BAR; PG8_MMA(0, 0, At, B0); PG8_MMA(0, 1, At, B1); PG8_BAR; PG8_SCHED;
            PG8_LDA(At, 0, 1); PG8_STAGE(PG8_SB(0, 0), b2, voffB, hpB); PG8_STAGE(PG8_SB(0, 1), b2 + hstepB, voffB, hpB); PG8_STAGE(PG8_SA(0, 0), a2, voffA, hpA);
            PG8_WAIT_V(8); PG8_WAIT_L(0); PG8_BAR; PG8_MMA(1, 0, At, B0); PG8_MMA(1, 1, At, B1); PG8_BAR; PG8_SCHED;
            PG8_LDB(B0, 1, 0); PG8_LDB(B1, 1, 1); PG8_SCHED; PG8_LDA(At, 1, 0); PG8_STAGE(PG8_SA(0, 1), a2 + hstepA, voffA, hpA);
            PG8_WAIT_V(8); PG8_WAIT_L(0); PG8_BAR; PG8_MMA(0, 0, At, B0); PG8_MMA(0, 1, At, B1); PG8_BAR; PG8_SCHED;
            PG8_LDA(At, 1, 1); PG8_STAGE(PG8_SB(1, 0), b3, voffB, hpB); PG8_STAGE(PG8_SB(1, 1), b3 + hstepB, voffB, hpB); PG8_STAGE(PG8_SA(1, 0), a3, voffA, hpA);
            PG8_WAIT_V(8); PG8_WAIT_L(0); PG8_BAR; PG8_MMA(1, 0, At, B0); PG8_MMA(1, 1, At, B1); PG8_BAR; PG8_SCHED;
        }
        if (wr == 0) PG8_BAR;
        { int fr_e = fr, fq_e = fq; asm volatile("" : "+v"(fr_e), "+v"(fq_e));
          E(acc, cur, wr, wc, fr_e, fq_e, pre);
          }
        if (!has_next) break;
        if (!(Sched::PAIR && cur.kind == 0)) {
#pragma unroll
        for (int a = 0; a < 2; ++a)
#pragma unroll
            for (int b = 0; b < 2; ++b)
#pragma unroll
                for (int m = 0; m < 4; ++m)
#pragma unroll
                    for (int n = 0; n < 2; ++n) acc[a][b][m][n] = (f32x4){0.f, 0.f, 0.f, 0.f};
        }
        cur = nxt; cA = nA; cB = nB; ++ui;
        E.prefetch(cur, wr, fr, pre);
        if (wr == 1) PG8_BAR;
    }
    PG8_WAIT_V(0);
    PG8_BAR;
#undef PG8_SA
#undef PG8_SB
#undef PG8_STAGE
#undef PG8_LDA
#undef PG8_LDB
#undef PG8_MMA
#undef PG8_WAIT_V
#undef PG8_WAIT_L
#undef PG8_BAR
#undef PG8_SCHED
}
}
using pg8::Unit;

struct SchedStd { static constexpr bool PAIR = false;
    pg8::TileOrder o; const char* A; const char* B; size_t astep, bstep, bbatch; int nt;
    __device__ bool next(int i, Unit& u) const { u.kind = 0; u.aux = 0; u.nt = nt; return o.tile(i, u.pm, u.pn); }
    __device__ void ptrs(const Unit& u, const char*& a, const char*& b) const { a = A + (size_t)u.pm * astep; b = B + (size_t)u.pn * bstep + (size_t)(u.pm >> 4) * bbatch; }
};
struct SchedPair { static constexpr bool PAIR = true;
    int G, c; const char *A0, *A1, *B0, *B1; int loc, p0;
    __device__ bool next(int i, Unit& u) const {
        u.kind = i & 1; u.aux = 0; u.nt = 16;
        if (loc) { if (i >= 2) return false; u.pm = p0 + (c & 3); u.pn = c >> 2; return true; }
        const int p = (i >> 1) * G + c; if (p >= 256) return false; u.pm = p >> 3; u.pn = p & 7; return true; }
    __device__ void ptrs(const Unit& u, const char*& a, const char*& b) const { a = (u.kind ? A1 : A0) + (size_t)u.pm * (256 * 1024 * 2); b = (u.kind ? B1 : B0) + (size_t)u.pn * (256 * 1024 * 2); }
};
constexpr size_t TSTEP = (size_t)256 * D * 2;
struct SchedUpKv { static constexpr bool PAIR = false;
    pg8::TileOrder o; int G, c; const char *XBp, *W13p, *MEMNp, *WKVp; int loc, p0, xq;
    __device__ bool next(int i, Unit& u) const { const long L = loc ? (long)i * 32 + c : (long)i * G + c; u.aux = 0; u.nt = 32;
        if (loc) {
            if (L < 176) { u.kind = 0; u.pm = p0 + ((int)L & 3); u.pn = (int)L >> 2; return true; }
            if (L < 180) { const int r = xq * 4 + ((int)L - 176); u.kind = 1; u.pm = r & 1; u.pn = r >> 1; return true; }
            return false; }
        if (L < 1408) { u.kind = 0; return o.tileL(L, u.pm, u.pn); }
        if (L < 1440) { const int r = (int)L - 1408; u.kind = 1; u.pm = r & 1; u.pn = r >> 1; return true; }
        return false; }
    __device__ void ptrs(const Unit& u, const char*& a, const char*& b) const { a = (u.kind ? MEMNp : XBp) + (size_t)u.pm * TSTEP; b = (u.kind ? WKVp : W13p) + (size_t)u.pn * TSTEP; }
};
struct SchedInW { static constexpr bool PAIR = false;
    pg8::TileOrder o; int G, c; const char *XBp, *WINp, *Kp, *Vp, *WQp, *WOp; int loc, p0, xq;
    __device__ bool wunit(int r, Unit& u) const { const int rr = r & 63; u.kind = 1 + (r >> 6); u.aux = ((rr >> 5) << 2) | ((rr >> 3) & 3); u.pm = rr & 7; u.pn = 0; u.nt = 8; return true; }
    __device__ bool next(int i, Unit& u) const {
        u.aux = 0; u.nt = 32; u.kind = 0;
        if (loc) {
            const int L = i * 32 + c;
            if (L < 116) { u.pm = p0 + (L & 3); u.pn = L >> 2; return true; }
            if (i == 3) return wunit(xq * 16 + (c - 20), u);
            if (i == 4 && c >= 20 && c < 24) return wunit(xq * 16 + 12 + (c - 20), u);
            return false; }
        if (G == 256) {
            if (i < 3) return o.tileL((long)i * 256 + c, u.pm, u.pn);
            if (i == 3) { if (768 + c < 928) return o.tileL(768 + c, u.pm, u.pn); return wunit(c - 160, u); }
            if (i == 4 && c >= 160 && c < 192) return wunit(96 + c - 160, u);
            return false;
        }
        const long L = (long)i * G + c;
        if (L < 928) return o.tileL(L, u.pm, u.pn);
        if (L < 1056) return wunit((int)L - 928, u);
        return false; }
    __device__ void ptrs(const Unit& u, const char*& a, const char*& b) const {
        const int bb = u.aux >> 2, hh = u.aux & 3;
        if (u.kind == 0) { a = XBp + (size_t)u.pm * TSTEP; b = WINp + (size_t)u.pn * TSTEP; }
        else if (u.kind == 1) { a = Kp + (size_t)bb * TSTEP + hh * 1024; b = WQp + (size_t)u.pm * TSTEP + hh * 1024; }
        else { a = WOp + (size_t)u.pm * TSTEP + hh * 1024; b = Vp + (size_t)bb * TSTEP + hh * 1024; } }
};

#define EPI_ROWS(ai, m) (u.pm * 256 + (ai) * 128 + wr * 64 + (m) * 16 + fr)
#define EPI_COL8(bj) ((bj) * 128 + wc * 32 + 8 * fq)
struct NoPre {};
struct RowPre { u64 s[8]; };
__device__ __forceinline__ void rowpre_load(const u64* ss, const int pm, int wr, int fr, RowPre& p) {
#pragma unroll
    for (int k = 0; k < 8; ++k) p.s[k] = ((const GAS u64*)ss)[pm * 256 + (k >> 2) * 128 + wr * 64 + (k & 3) * 16 + fr]; }
__device__ __forceinline__ float rinv_of(const u64* ss, int row) { return rsqrtf((float)((const GAS u64*)ss)[row] * SS_INV + EPS); }

struct EpiUp {
    struct Pre { u64 s[8]; };
    __device__ __forceinline__ void prefetch(const Unit& u, int wr, int fr, Pre& p) const {
#pragma unroll
        for (int k = 0; k < 8; ++k) p.s[k] = ((const GAS u64*)ss)[u.pm * 256 + (k >> 2) * 128 + wr * 64 + (k & 3) * 16 + fr]; }
    bf16* act; const u64* ss;
    __device__ __forceinline__ void operator()(const f32x4 (&acc)[2][2][4][2], const Unit& u, int wr, int wc, int fr, int fq, const Pre& pre) const {
#ifdef EPI_TWICE
      for (int rep2 = 0; rep2 < 2; ++rep2) { asm volatile("" : "+v"(fr), "+v"(fq));
#endif
#pragma unroll
        for (int ai = 0; ai < 2; ++ai)
#pragma unroll
            for (int m = 0; m < 4; ++m) {
                const int row = EPI_ROWS(ai, m); const float r = rsqrtf((float)pre.s[ai * 4 + m] * SS_INV + EPS);
                float o[8];
#pragma unroll
                for (int n = 0; n < 2; ++n)
#pragma unroll
                    for (int i = 0; i < 4; ++i) { const float a = acc[ai][0][m][n][i] * r, b = acc[ai][1][m][n][i] * r; o[n * 4 + i] = siluf_(a) * b; }
                u32x4 w; w.x = pk2(o[0], o[1]); w.y = pk2(o[2], o[3]); w.z = pk2(o[4], o[5]); w.w = pk2(o[6], o[7]);
                *(GAS u32x4*)(act + (size_t)row * FF + u.pn * 128 + wc * 32 + 8 * fq) = w;
            }
#ifdef EPI_TWICE
      }
#endif
    }
};
template <bool IN_F32>
struct EpiRes {
    typedef NoPre Pre; __device__ __forceinline__ void prefetch(const Unit&, int, int, Pre&) const {}
    const float* xin32; bf16* xb; u64* ssn; float scale;
    __device__ __forceinline__ void operator()(const f32x4 (&acc)[2][2][4][2], const Unit& u, int wr, int wc, int fr, int fq, const Pre& pre) const {
#pragma unroll
        for (int ai = 0; ai < 2; ++ai)
#pragma unroll
            for (int m = 0; m < 4; ++m) {
                const int row = EPI_ROWS(ai, m); float q = 0.f;
#pragma unroll
                for (int bj = 0; bj < 2; ++bj) {
                    const size_t off = (size_t)row * D + u.pn * 256 + EPI_COL8(bj);
                    f32x4 x0, x1;
                    if (IN_F32) { x0 = *(const GAS f32x4*)(xin32 + off); x1 = *(const GAS f32x4*)(xin32 + off + 4); }
                    else { const u32x4 xw = *(const GAS u32x4*)(xb + off); x0[0] = lo_bf(xw.x); x0[1] = hi_bf(xw.x); x0[2] = lo_bf(xw.y); x0[3] = hi_bf(xw.y); x1[0] = lo_bf(xw.z); x1[1] = hi_bf(xw.z); x1[2] = lo_bf(xw.w); x1[3] = hi_bf(xw.w); }
                    const f32x4 o0 = x0 + acc[ai][bj][m][0] * scale, o1 = x1 + acc[ai][bj][m][1] * scale;
                    u32x4 w; w.x = pk2(o0[0], o0[1]); w.y = pk2(o0[2], o0[3]); w.z = pk2(o1[0], o1[1]); w.w = pk2(o1[2], o1[3]); *(GAS u32x4*)(xb + off) = w;
                    q += (o0[0] * o0[0] + o0[1] * o0[1]) + (o0[2] * o0[2] + o0[3] * o0[3]) + (o1[0] * o1[0] + o1[1] * o1[1]) + (o1[2] * o1[2] + o1[3] * o1[3]);
                }
                q += __shfl_xor(q, 16); q += __shfl_xor(q, 32);
                if (fq == 0) atomicAdd((u64*)(ssn + row), (u64)(q * SS_SCALE));
            }
    }
};
struct EpiResFinal {
    typedef NoPre Pre; __device__ __forceinline__ void prefetch(const Unit&, int, int, Pre&) const {}
    const bf16* xin; float* out; const float* gfin; u64* ssn; unsigned* cnt; float scale;
    __device__ __forceinline__ void operator()(f32x4 (&acc)[2][2][4][2], const Unit& u, int wr, int wc, int fr, int fq, const Pre& pre) const {
#pragma unroll
        for (int ai = 0; ai < 2; ++ai)
#pragma unroll
            for (int m = 0; m < 4; ++m) {
                const int row = EPI_ROWS(ai, m); float q = 0.f;
#pragma unroll
                for (int bj = 0; bj < 2; ++bj) {
                    const size_t off = (size_t)row * D + u.pn * 256 + EPI_COL8(bj);
                    const u32x4 xw = *(const GAS u32x4*)(xin + off);
                    f32x4 x0, x1; x0[0] = lo_bf(xw.x); x0[1] = hi_bf(xw.x); x0[2] = lo_bf(xw.y); x0[3] = hi_bf(xw.y); x1[0] = lo_bf(xw.z); x1[1] = hi_bf(xw.z); x1[2] = lo_bf(xw.w); x1[3] = hi_bf(xw.w);
                    const f32x4 o0 = x0 + acc[ai][bj][m][0] * scale, o1 = x1 + acc[ai][bj][m][1] * scale;
                    acc[ai][bj][m][0] = o0; acc[ai][bj][m][1] = o1;
                    q += (o0[0] * o0[0] + o0[1] * o0[1]) + (o0[2] * o0[2] + o0[3] * o0[3]) + (o1[0] * o1[0] + o1[1] * o1[1]) + (o1[2] * o1[2] + o1[3] * o1[3]);
                }
                q += __shfl_xor(q, 16); q += __shfl_xor(q, 32);
                if (fq == 0) atomicAdd((u64*)(ssn + row), (u64)(q * SS_SCALE));
            }
        asm volatile("s_waitcnt vmcnt(0)" ::: "memory");
        unsigned* c = cnt + 64 * u.pm;
        if (fr == 0 && fq == 0) __hip_atomic_fetch_add(c, 1u, __ATOMIC_RELAXED, __HIP_MEMORY_SCOPE_AGENT);
        if (wr == 0 && wc == 0) {
            unsigned spins = 0;
            while ((unsigned)__builtin_amdgcn_readfirstlane(__hip_atomic_load(c, __ATOMIC_RELAXED, __HIP_MEMORY_SCOPE_AGENT)) < 64u) { __builtin_amdgcn_s_sleep(2); if (++spins > (1u << 22)) break; }
            __builtin_amdgcn_fence(__ATOMIC_ACQUIRE, "agent");
            asm volatile("s_waitcnt vmcnt(0)" ::: "memory");
        }
        asm volatile("" ::: "memory"); __builtin_amdgcn_s_barrier(); asm volatile("" ::: "memory");
#pragma unroll
        for (int ai = 0; ai < 2; ++ai)
#pragma unroll
            for (int m = 0; m < 4; ++m) {
                const int row = EPI_ROWS(ai, m);
                const float r = rsqrtf((float)__hip_atomic_load(ssn + row, __ATOMIC_RELAXED, __HIP_MEMORY_SCOPE_AGENT) * SS_INV + EPS);
#pragma unroll
                for (int bj = 0; bj < 2; ++bj) {
                    const size_t off = (size_t)row * D + u.pn * 256 + EPI_COL8(bj); const int col = u.pn * 256 + EPI_COL8(bj);
                    const f32x4 o0 = acc[ai][bj][m][0], o1 = acc[ai][bj][m][1];
                    *(GAS f32x4*)(out + off) = o0 * r * *(const GAS f32x4*)(gfin + col); *(GAS f32x4*)(out + off + 4) = o1 * r * *(const GAS f32x4*)(gfin + col + 4);
                }
            }
    }
};
struct EpiInproj {
    typedef RowPre Pre; __device__ __forceinline__ void prefetch(const Unit& u, int wr, int fr, Pre& p) const { rowpre_load(ss, u.pm, wr, fr, p); }
    unsigned char* ws; const u64* ss; const float* igb; const float* fgb;
    __device__ __forceinline__ void operator()(const f32x4 (&acc)[2][2][4][2], const Unit& u, int wr, int wc, int fr, int fq, const Pre& pre) const {
        if (u.pn == 28) {
            if (wc == 0 && fq == 0) {
                float* gates = (float*)(ws + WS_SMALL + SM_GATES);
#pragma unroll
                for (int ai = 0; ai < 2; ++ai)
#pragma unroll
                    for (int m = 0; m < 4; ++m) {
                        const int row = EPI_ROWS(ai, m); const float r = rsqrtf((float)pre.s[ai * 4 + m] * SS_INV + EPS);
                        f32x4 gi, gf;
#pragma unroll
                        for (int i = 0; i < 4; ++i) {
                            gi[i] = acc[ai][0][m][0][i] * r + igb[i];
                            const float xf = acc[ai][0][m][1][i] * r + fgb[i];
                            gf[i] = fminf(xf, 0.f) - __logf(1.0f + __expf(-fabsf(xf)));
                        }
                        *(GAS f32x4*)(gates + (size_t)row * 8) = gi; *(GAS f32x4*)(gates + (size_t)row * 8 + 4) = gf;
                    }
            }
            return;
        }
        const int ty = u.pn >> 2;
        bf16* base = (bf16*)(ws + (ty == 0 ? AR_QKRAW : ty == 1 ? AR_MV : ty == 2 ? AR_MO : ty == 3 ? AR_HQ : ty == 4 ? AR_HF : ty == 5 ? AR_HI : AR_HG));
#pragma unroll
        for (int ai = 0; ai < 2; ++ai)
#pragma unroll
            for (int m = 0; m < 4; ++m) {
                const int row = EPI_ROWS(ai, m); const float r = rsqrtf((float)pre.s[ai * 4 + m] * SS_INV + EPS);
#pragma unroll
                for (int bj = 0; bj < 2; ++bj) {
                    float o[8];
#pragma unroll
                    for (int n = 0; n < 2; ++n)
#pragma unroll
                        for (int i = 0; i < 4; ++i) {
                            float v = acc[ai][bj][m][n][i] * r;
                            if (ty == 2) v = sigmoidf_(v); else if (ty == 3) v = siluf_(v) * 0.08838834764831845f; else if (ty == 6) v = siluf_(v);
                            o[n * 4 + i] = v;
                        }
                    u32x4 w; w.x = pk2(o[0], o[1]); w.y = pk2(o[2], o[3]); w.z = pk2(o[4], o[5]); w.w = pk2(o[6], o[7]);
                    *(GAS u32x4*)(base + (size_t)row * 1024 + (u.pn & 3) * 256 + EPI_COL8(bj)) = w;
                }
            }
    }
};
struct EpiGates {
    typedef RowPre Pre; __device__ __forceinline__ void prefetch(const Unit& u, int wr, int fr, Pre& p) const { rowpre_load(ss, u.pm, wr, fr, p); }
    bf16* gm; bf16* gh; const u64* ss;
    __device__ __forceinline__ void operator()(const f32x4 (&acc)[2][2][4][2], const Unit& u, int wr, int wc, int fr, int fq, const Pre& pre) const {
        bf16* base = (u.pn < 8) ? gm : gh;
#pragma unroll
        for (int ai = 0; ai < 2; ++ai)
#pragma unroll
            for (int m = 0; m < 4; ++m) {
                const int row = EPI_ROWS(ai, m); const float r = rsqrtf((float)pre.s[ai * 4 + m] * SS_INV + EPS);
#pragma unroll
                for (int bj = 0; bj < 2; ++bj) {
                    float o[8];
#pragma unroll
                    for (int n = 0; n < 2; ++n)
#pragma unroll
                        for (int i = 0; i < 4; ++i) o[n * 4 + i] = sigmoidf_(acc[ai][bj][m][n][i] * r);
                    u32x4 w; w.x = pk2(o[0], o[1]); w.y = pk2(o[2], o[3]); w.z = pk2(o[4], o[5]); w.w = pk2(o[6], o[7]);
                    *(GAS u32x4*)(base + (size_t)row * D + (u.pn & 7) * 256 + EPI_COL8(bj)) = w;
                }
            }
    }
};
struct EpiProj {
    typedef NoPre Pre; __device__ __forceinline__ void prefetch(const Unit&, int, int, Pre&) const {}
    const bf16* gm; const bf16* gh; bf16* merged;
    __device__ __forceinline__ void operator()(f32x4 (&acc)[2][2][4][2], const Unit& u, int wr, int wc, int fr, int fq, const Pre& pre) const {
#pragma unroll
        for (int ai = 0; ai < 2; ++ai)
#pragma unroll
            for (int m = 0; m < 4; ++m) {
                const int row = EPI_ROWS(ai, m);
#pragma unroll
                for (int bj = 0; bj < 2; ++bj) {
                    const size_t off = (size_t)row * D + u.pn * 256 + EPI_COL8(bj);
                    const u32x4 hw = *(const GAS u32x4*)(gh + off);
                    float h8[8] = {lo_bf(hw.x), hi_bf(hw.x), lo_bf(hw.y), hi_bf(hw.y), lo_bf(hw.z), hi_bf(hw.z), lo_bf(hw.w), hi_bf(hw.w)};
                    if (u.kind == 0) {
                        const u32x4 gw = *(const GAS u32x4*)(gm + off);
                        const float g8[8] = {lo_bf(gw.x), hi_bf(gw.x), lo_bf(gw.y), hi_bf(gw.y), lo_bf(gw.z), hi_bf(gw.z), lo_bf(gw.w), hi_bf(gw.w)};
#pragma unroll
                        for (int i = 0; i < 4; ++i) { acc[ai][bj][m][0][i] *= g8[i] * __builtin_amdgcn_rcpf(fmaxf(h8[i], 1e-30f)); acc[ai][bj][m][1][i] *= g8[4 + i] * __builtin_amdgcn_rcpf(fmaxf(h8[4 + i], 1e-30f)); }
                    } else {
                        const f32x4 a = acc[ai][bj][m][0], b = acc[ai][bj][m][1];
                        u32x4 w; w.x = pk2(a[0] * h8[0], a[1] * h8[1]); w.y = pk2(a[2] * h8[2], a[3] * h8[3]); w.z = pk2(b[0] * h8[4], b[1] * h8[5]); w.w = pk2(b[2] * h8[6], b[3] * h8[7]); *(GAS u32x4*)(merged + off) = w;
                    }
                }
            }
    }
};
struct EpiScores {
    typedef RowPre Pre; __device__ __forceinline__ void prefetch(const Unit& u, int wr, int fr, Pre& p) const { rowpre_load(ss, u.pm, wr, fr, p); }
    bf16* p; const u64* ss; LAS float* xch;
    __device__ __forceinline__ void operator()(const f32x4 (&acc)[2][2][4][2], const Unit& u, int wr, int wc, int fr, int fq, const Pre& pre) const {
        float v[2][4][16];
#pragma unroll
        for (int ai = 0; ai < 2; ++ai)
#pragma unroll
            for (int m = 0; m < 4; ++m) {
                const int row = EPI_ROWS(ai, m), rl = ai * 128 + wr * 64 + m * 16 + fr; const float r = rsqrtf((float)pre.s[ai * 4 + m] * SS_INV + EPS) * 0.04419417382415922f;
                float mx = -INFINITY;
#pragma unroll
                for (int bj = 0; bj < 2; ++bj)
#pragma unroll
                    for (int n = 0; n < 2; ++n)
#pragma unroll
                        for (int i = 0; i < 4; ++i) { const float x = acc[ai][bj][m][n][i] * r; v[ai][m][bj * 8 + n * 4 + i] = x; mx = fmaxf(mx, x); }
                mx = fmaxf(mx, __shfl_xor(mx, 16)); mx = fmaxf(mx, __shfl_xor(mx, 32));
                if (fq == 0) xch[rl * 4 + wc] = mx;
            }
        asm volatile("s_waitcnt lgkmcnt(0)" ::: "memory"); __builtin_amdgcn_s_barrier(); asm volatile("" ::: "memory");
#pragma unroll
        for (int ai = 0; ai < 2; ++ai)
#pragma unroll
            for (int m = 0; m < 4; ++m) {
                const int rl = ai * 128 + wr * 64 + m * 16 + fr; const f32x4 pm = *(const LAS f32x4*)(xch + rl * 4);
                const float mx = fmaxf(fmaxf(pm[0], pm[1]), fmaxf(pm[2], pm[3])); float sm = 0.f;
#pragma unroll
                for (int k = 0; k < 16; ++k) { const float e = __expf(v[ai][m][k] - mx); v[ai][m][k] = e; sm += e; }
                sm += __shfl_xor(sm, 16); sm += __shfl_xor(sm, 32);
                if (fq == 0) xch[1024 + rl * 4 + wc] = sm;
            }
        asm volatile("s_waitcnt lgkmcnt(0)" ::: "memory"); __builtin_amdgcn_s_barrier(); asm volatile("" ::: "memory");
#pragma unroll
        for (int ai = 0; ai < 2; ++ai)
#pragma unroll
            for (int m = 0; m < 4; ++m) {
                const int row = EPI_ROWS(ai, m), rl = ai * 128 + wr * 64 + m * 16 + fr; const f32x4 ps = *(const LAS f32x4*)(xch + 1024 + rl * 4);
                const float inv = __builtin_amdgcn_rcpf((ps[0] + ps[1]) + (ps[2] + ps[3]));
#pragma unroll
                for (int bj = 0; bj < 2; ++bj) {
                    const float* e = &v[ai][m][bj * 8];
                    u32x4 w; w.x = pk2(e[0] * inv, e[1] * inv); w.y = pk2(e[2] * inv, e[3] * inv); w.z = pk2(e[4] * inv, e[5] * inv); w.w = pk2(e[6] * inv, e[7] * inv);
                    *(GAS u32x4*)(p + (size_t)row * 1024 + u.pn * 256 + EPI_COL8(bj)) = w;
                }
            }
    }
};
__device__ __forceinline__ void store_tile_bf16(const f32x4 (&acc)[2][2][4][2], bf16* base, int ldc, int wr, int wc, int fr, int fq) {
#pragma unroll
    for (int ai = 0; ai < 2; ++ai)
#pragma unroll
        for (int m = 0; m < 4; ++m) {
            const int rl = ai * 128 + wr * 64 + m * 16 + fr;
#pragma unroll
            for (int bj = 0; bj < 2; ++bj) {
                const f32x4 a = acc[ai][bj][m][0], b = acc[ai][bj][m][1];
                u32x4 w; w.x = pk2(a[0], a[1]); w.y = pk2(a[2], a[3]); w.z = pk2(b[0], b[1]); w.w = pk2(b[2], b[3]);
                *(GAS u32x4*)(base + (size_t)rl * ldc + EPI_COL8(bj)) = w;
            }
        }
}
struct EpiUpKv {
    typedef EpiUp::Pre Pre; __device__ __forceinline__ void prefetch(const Unit& u, int wr, int fr, Pre& p) const { if (u.kind == 0) up.prefetch(u, wr, fr, p); }
    EpiUp up; bf16* kv;
    __device__ __forceinline__ void operator()(const f32x4 (&acc)[2][2][4][2], const Unit& u, int wr, int wc, int fr, int fq, const Pre& pre) const {
        if (u.kind == 0) up(acc, u, wr, wc, fr, fq, pre);
        else store_tile_bf16(acc, kv + (size_t)(u.pn >> 3) * (512 * D) + (size_t)u.pm * (256 * D) + (u.pn & 7) * 256, D, wr, wc, fr, fq);
    }
};
struct EpiInW {
    typedef RowPre Pre; __device__ __forceinline__ void prefetch(const Unit& u, int wr, int fr, Pre& p) const { if (u.kind == 0) inp.prefetch(u, wr, fr, p); }
    EpiInproj inp; bf16* wqkt; bf16* vwot;
    __device__ __forceinline__ void operator()(const f32x4 (&acc)[2][2][4][2], const Unit& u, int wr, int wc, int fr, int fq, const Pre& pre) const {
        const int bb = u.aux >> 2, hh = u.aux & 3;
        if (u.kind == 0) inp(acc, u, wr, wc, fr, fq, pre);
        else if (u.kind == 1) store_tile_bf16(acc, wqkt + (size_t)bb * (1024 * D) + (size_t)hh * (256 * D) + u.pm * 256, D, wr, wc, fr, fq);
        else store_tile_bf16(acc, vwot + (size_t)bb * (2048 * 1024) + (size_t)u.pm * (256 * 1024) + hh * 256, 1024, wr, wc, fr, fq);
    }
};

struct Args { const float* in[28]; float* out; unsigned char* ws; };
enum { I_X = 0, I_MEM, I_NFFN1, I_F1W1, I_F1W3, I_F1W2, I_NMIX, I_WIN, I_CONVW, I_CONVB, I_IGB, I_FGB, I_MHN, I_LBL, I_HHN, I_WPM, I_WPH, I_WOUT, I_NX, I_NMEM, I_WQ, I_WKV, I_WO,
       I_NFFN2, I_F2W1, I_F2W3, I_F2W2, I_NFIN };

struct CvtDesc { const float* src; const float* gain; bf16* dst; int ld_src, ld_dst, col0, nvalid, k0; };
__device__ __forceinline__ void cvt_load(const CvtDesc& d, int lane, f32x4 (&v)[8]) {
    const int kc = lane & 7, ng = lane >> 3; const bool ok = (4 * ng) < d.nvalid;
#pragma unroll
    for (int j = 0; j < 8; ++j) v[j] = ok ? __builtin_nontemporal_load((const GAS f32x4*)(d.src + (size_t)(d.k0 + 8 * kc + j) * d.ld_src + d.col0 + 4 * ng)) : (f32x4){0.f, 0.f, 0.f, 0.f};
}
__device__ __forceinline__ void cvt_store(const CvtDesc& d, int lane, f32x4 (&v)[8]) {
    const int kc = lane & 7, ng = lane >> 3;
    if (d.gain) {
        const f32x4 g0 = *(const f32x4*)(d.gain + d.k0 + 8 * kc), g1 = *(const f32x4*)(d.gain + d.k0 + 8 * kc + 4);
        v[0] *= g0[0]; v[1] *= g0[1]; v[2] *= g0[2]; v[3] *= g0[3]; v[4] *= g1[0]; v[5] *= g1[1]; v[6] *= g1[2]; v[7] *= g1[3];
    }
#pragma unroll
    for (int i = 0; i < 4; ++i) {
        u32x4 w; w.x = pk2(v[0][i], v[1][i]); w.y = pk2(v[2][i], v[3][i]); w.z = pk2(v[4][i], v[5][i]); w.w = pk2(v[6][i], v[7][i]);
        *(u32x4*)(d.dst + (size_t)(4 * ng + i) * d.ld_dst + d.k0 + 8 * kc) = w;
    }
}
__device__ __forceinline__ CvtDesc mk_desc(const float* src, int ld_src, int col0, int nvalid, int k0, const float* gain, bf16* dst, int ld_dst) {
    CvtDesc d; d.src = src; d.gain = gain; d.dst = dst; d.ld_src = ld_src; d.ld_dst = ld_dst; d.col0 = col0; d.nvalid = nvalid; d.k0 = k0; return d; }
__device__ __forceinline__ CvtDesc ffn_desc(int it, const float* w1, const float* w3, const float* w2, const float* gain, bf16* w13, bf16* w2t) {
    if (it < 11264) { const int nb = it % 352, kb = it / 352; const int pn = nb >> 3, bj = (nb >> 2) & 1, cb = nb & 3;
        return mk_desc(bj ? w3 : w1, FF, pn * 128 + cb * 32, 32, kb * 64, gain, w13 + (size_t)nb * 32 * D, D); }
    it -= 11264;
    const int nb = it % 64, kb = it / 64; return mk_desc(w2, D, nb * 32, 32, kb * 64, nullptr, w2t + (size_t)nb * 32 * FF, FF);
}
constexpr int N_FFN_ITEMS = 11264 + 5632;
#ifndef PHASES
#define PHASES 0xFFFFFu
#endif
#define PH(k) ((PHASES >> (k)) & 1u)
#ifndef REPS
#define REPS 0x0u
#endif
#define NREP(k) ((int)PH(k) + (int)((REPS >> (k)) & 1u))

__device__ __forceinline__ bf16x8 ldfrag(const LAS unsigned char* base, int row, int stride, int kbyte) { return *(const LAS bf16x8*)(base + row * stride + kbyte); }
#define MFMA16(a, b, c) __builtin_amdgcn_mfma_f32_16x16x32_bf16((a), (b), (c), 0, 0, 0)
__device__ __forceinline__ float wave_scan_incl(float v, int lane) {
    (void)lane;
#define WS_DPP(ctrl, rmask) v += __builtin_bit_cast(float, __builtin_amdgcn_update_dpp(0, __builtin_bit_cast(int, v), (ctrl), (rmask), 0xf, false))
    WS_DPP(0x111, 0xf); WS_DPP(0x112, 0xf); WS_DPP(0x114, 0xf); WS_DPP(0x118, 0xf);
    WS_DPP(0x142, 0xa);
    WS_DPP(0x143, 0xc);
#undef WS_DPP
    return v;
}
__device__ __forceinline__ void unpack8(const u32x4 w, float (&f)[8]) { f[0] = lo_bf(w.x); f[1] = hi_bf(w.x); f[2] = lo_bf(w.y); f[3] = hi_bf(w.y); f[4] = lo_bf(w.z); f[5] = hi_bf(w.z); f[6] = lo_bf(w.w); f[7] = hi_bf(w.w); }
__device__ __forceinline__ void put_t8(LAS unsigned char* Tt, int col0, int s, const u32x4 vw) {
    LAS bf16* p = (LAS bf16*)(Tt + col0 * 144 + s * 2);
    p[0 * 72] = (bf16)(vw.x & 0xffffu); p[1 * 72] = (bf16)(vw.x >> 16); p[2 * 72] = (bf16)(vw.y & 0xffffu); p[3 * 72] = (bf16)(vw.y >> 16);
    p[4 * 72] = (bf16)(vw.z & 0xffffu); p[5 * 72] = (bf16)(vw.z >> 16); p[6 * 72] = (bf16)(vw.w & 0xffffu); p[7 * 72] = (bf16)(vw.w >> 16);
}

struct MaRegs { u32x4 vr[4], qk[5]; float fl, ip; };
struct HaRegs { u32x4 hr[2], fr[2]; };
__device__ __forceinline__ void ma_load(int item, int tid, const GAS float* gates, const GAS bf16* QKRAW, const GAS bf16* MV, MaRegs& r) {
    const int b = item >> 8, h = (item >> 6) & 3, c = item & 63, R0 = b * T + c * 64;
#pragma unroll
    for (int i = 0; i < 4; ++i) { const int idx = tid + NTHR * i, row = idx >> 5, ch = idx & 31; r.vr[i] = *(const GAS u32x4*)(MV + (size_t)(R0 + row) * 1024 + h * 256 + ch * 8); }
#pragma unroll
    for (int j = 0; j < 5; ++j) { const int idx = tid + NTHR * j, row = idx >> 5, ch = idx & 31, tt = c * 64 - 3 + row;
        r.qk[j] = (idx < 67 * 32 && tt >= 0) ? *(const GAS u32x4*)(QKRAW + (size_t)(b * T + tt) * 1024 + (ch >> 4) * 512 + h * 128 + (ch & 15) * 8) : (u32x4){0u, 0u, 0u, 0u}; }
    r.fl = 0.f; r.ip = 0.f;
    if (tid < 64) { r.fl = gates[(size_t)(R0 + tid) * 8 + 4 + h]; r.ip = gates[(size_t)(R0 + tid) * 8 + h]; }
}
__device__ __forceinline__ void ha_load(int it, int tid, const GAS bf16* HF, const GAS bf16* HI, HaRegs& r) {
    const int b = it >> 9, h = (it >> 6) & 7, c = it & 63, R0 = b * T + c * 64;
#pragma unroll
    for (int i = 0; i < 2; ++i) { const int idx = tid + NTHR * i, row = idx >> 4, ch = idx & 15;
        r.hr[i] = *(const GAS u32x4*)(HI + (size_t)(R0 + row) * 1024 + h * 128 + ch * 8); r.fr[i] = *(const GAS u32x4*)(HF + (size_t)(R0 + row) * 1024 + h * 128 + ch * 8); }
}
__device__ __forceinline__ void mlstm_stage_convw(LAS unsigned char* lds, int h, int tid, const GAS float* convw, const GAS float* convb) {
    LAS float* CW = (LAS float*)(lds + 2048 + 18432 + 36864 + 35376 + 33792);
    if (tid < 320) { const int j = tid >> 6, c4 = tid & 63, col = (c4 >> 5) * 512 + h * 128 + (c4 & 31) * 4;
        *(LAS f32x4*)(CW + j * 256 + c4 * 4) = *(const GAS f32x4*)((j < 4 ? convw + j * 1024 : convb) + col); }
}
__device__ __forceinline__ void mlstm_state_item(LAS unsigned char* lds, int item, int tid, MaRegs& rg, int nxt, const GAS float* gates, const GAS float* convw, const GAS float* convb, const GAS bf16* QKRAW, GAS bf16* QC, GAS bf16* KC,
                                                 const GAS bf16* MV, GAS bf16* MST, GAS float* DN, GAS float* BLAST, GAS float* MLOC) {
    const int lane = tid & 63, w = __builtin_amdgcn_readfirstlane(tid >> 6), l15 = lane & 15, lg = lane >> 4;
    const int b = item >> 8, h = (item >> 6) & 3, c = item & 63, R0 = b * T + c * 64;
    LAS float* sc = (LAS float*)lds;
    LAS unsigned char* KWt = lds + 2048;
    LAS unsigned char* Vt = KWt + 18432;
    LAS unsigned char* RAW = Vt + 36864;
    LAS unsigned char* VR = RAW + 35376;
    const LAS float* CW = (const LAS float*)(VR + 33792);
    const int s = lane;
    if (w == 0) {
        const float bs = wave_scan_incl(rg.fl, lane); const float blast = __shfl(bs, 63);
        const float a = blast - bs + rg.ip; const float ml = wave_max(a);
        sc[128 + lane] = __expf(a - ml);
        if (lane == 0) { BLAST[item] = blast; MLOC[item] = ml; }
    }
#pragma unroll
    for (int i = 0; i < 4; ++i) { const int idx = tid + NTHR * i; *(LAS u32x4*)(VR + (idx >> 5) * 528 + (idx & 31) * 16) = rg.vr[i]; }
#pragma unroll
    for (int j = 0; j < 5; ++j) { const int idx = tid + NTHR * j; if (idx < 67 * 32) *(LAS u32x4*)(RAW + (idx >> 5) * 528 + (idx & 31) * 16) = rg.qk[j]; }
    if (nxt < 512) ma_load(nxt, tid, gates, QKRAW, MV, rg);
    __syncthreads();
#pragma unroll
    for (int i = 0; i < 4; ++i) put_t8(Vt, (w + 8 * i) * 8, s, *(const LAS u32x4*)(VR + s * 528 + (w + 8 * i) * 16));
    const float ws_ = sc[128 + s];
#pragma unroll
    for (int i = 0; i < 4; ++i) {
        const int g = w + 8 * i, isk = g >> 4, d0 = (g & 15) * 8, cc0 = isk * 512 + h * 128 + d0;
        float y[8];
        { const f32x4 b0 = *(const LAS f32x4*)(CW + 1024 + g * 8), b1 = *(const LAS f32x4*)(CW + 1024 + g * 8 + 4); y[0] = b0[0]; y[1] = b0[1]; y[2] = b0[2]; y[3] = b0[3]; y[4] = b1[0]; y[5] = b1[1]; y[6] = b1[2]; y[7] = b1[3]; }
#pragma unroll
        for (int j = 0; j < 4; ++j) { const f32x4 w0 = *(const LAS f32x4*)(CW + j * 256 + g * 8), w1 = *(const LAS f32x4*)(CW + j * 256 + g * 8 + 4); float x[8]; unpack8(*(const LAS u32x4*)(RAW + (s + j) * 528 + g * 16), x);
            y[0] += w0[0] * x[0]; y[1] += w0[1] * x[1]; y[2] += w0[2] * x[2]; y[3] += w0[3] * x[3]; y[4] += w1[0] * x[4]; y[5] += w1[1] * x[5]; y[6] += w1[2] * x[6]; y[7] += w1[3] * x[7]; }
#pragma unroll
        for (int e = 0; e < 8; ++e) y[e] = siluf_(y[e]) * (isk ? 0.08838834764831845f : 1.0f);
        u32x4 o; o.x = pk2(y[0], y[1]); o.y = pk2(y[2], y[3]); o.z = pk2(y[4], y[5]); o.w = pk2(y[6], y[7]);
        if (!isk) *(GAS u32x4*)(QC + (size_t)(R0 + s) * 512 + h * 128 + d0) = o;
        else { *(GAS u32x4*)(KC + (size_t)(R0 + s) * 512 + h * 128 + d0) = o;
            float kr[8]; unpack8(o, kr);
            u32x4 kw; kw.x = pk2(kr[0] * ws_, kr[1] * ws_); kw.y = pk2(kr[2] * ws_, kr[3] * ws_); kw.z = pk2(kr[4] * ws_, kr[5] * ws_); kw.w = pk2(kr[6] * ws_, kr[7] * ws_);
            put_t8(KWt, d0, s, kw); }
    }
    __syncthreads();
    if (tid < 128) {
        float n = 0.f;
#pragma unroll
        for (int j = 0; j < 8; ++j) { const u32x4 kw = *(const LAS u32x4*)(KWt + tid * 144 + j * 16);
            n += (lo_bf(kw.x) + hi_bf(kw.x)) + (lo_bf(kw.y) + hi_bf(kw.y)) + (lo_bf(kw.z) + hi_bf(kw.z)) + (lo_bf(kw.w) + hi_bf(kw.w)); }
        DN[(size_t)item * 128 + tid] = n;
    }
    {
        bf16x8 vf[2][2];
#pragma unroll
        for (int je = 0; je < 2; ++je)
#pragma unroll
            for (int kk = 0; kk < 2; ++kk) vf[je][kk] = ldfrag(Vt, 16 * (2 * w + je) + l15, 144, (32 * kk + 8 * lg) * 2);
#pragma unroll 2
        for (int dt = 0; dt < 8; ++dt) {
            const bf16x8 k0 = ldfrag(KWt, 16 * dt + l15, 144, (8 * lg) * 2), k1 = ldfrag(KWt, 16 * dt + l15, 144, (32 + 8 * lg) * 2);
#pragma unroll
            for (int je = 0; je < 2; ++je) {
                f32x4 a = {0.f, 0.f, 0.f, 0.f};
                a = MFMA16(k0, vf[je][0], a); a = MFMA16(k1, vf[je][1], a);
                u32x2 o; o.x = pk2(a[0], a[1]); o.y = pk2(a[2], a[3]);
                *(GAS u32x2*)(MST + ((size_t)item * 256 + 16 * (2 * w + je) + l15) * 128 + 16 * dt + 4 * lg) = o;
            }
        }
    }
    __syncthreads();
}

__device__ __forceinline__ void hgrn_state_item(LAS unsigned char* lds, int it, int tid, HaRegs& rg, int nxt, const GAS bf16* HF, const GAS bf16* HI, const GAS float* lbl, GAS bf16* HST, GAS float* DEC) {
    const int lane = tid & 63, w = __builtin_amdgcn_readfirstlane(tid >> 6), l15 = lane & 15, lg = lane >> 4;
    const int b = it >> 9, h = (it >> 6) & 7, c = it & 63, R0 = b * T + c * 64;
    LAS float* Gt = (LAS float*)(lds + 2048);
    LAS unsigned char* KDt = lds + 2048 + 34816;
    LAS unsigned char* Vt = KDt + 18432;
    LAS unsigned char* HR = Vt + 18432;
    LAS unsigned char* FR = HR + 17408;
    const int s = lane;
#pragma unroll
    for (int i = 0; i < 2; ++i) { const int idx = tid + NTHR * i; *(LAS u32x4*)(HR + (idx >> 4) * 272 + (idx & 15) * 16) = rg.hr[i]; *(LAS u32x4*)(FR + (idx >> 4) * 272 + (idx & 15) * 16) = rg.fr[i]; }
    if (nxt < 1024) ha_load(nxt, tid, HF, HI, rg);
    __syncthreads();
    u32x4 hv[2], fv[2];
#pragma unroll
    for (int i = 0; i < 2; ++i) { hv[i] = *(const LAS u32x4*)(HR + s * 272 + (w + 8 * i) * 16); fv[i] = *(const LAS u32x4*)(FR + s * 272 + (w + 8 * i) * 16); }
#pragma unroll
    for (int i = 0; i < 2; ++i) {
        put_t8(Vt, (w + 8 * i) * 8, s, hv[i]);
        const int d0 = (w + 8 * i) * 8, dd = h * 128 + d0; float f[8], kd[8], dl[8]; unpack8(fv[i], f);
#pragma unroll
        for (int e = 0; e < 8; ++e) { const float lbv = ((const LAS float*)(FR + 17408))[dd + e]; const float sg = sigmoidf_(f[e]);
            const float Gs = wave_scan_incl(__logf(lbv + (1.f - lbv) * sg), lane); const float Gl = __shfl(Gs, 63);
            kd[e] = (1.f - lbv) * (1.f - sg) * __expf(Gl - Gs); dl[e] = __expf(Gl); }
        u32x4 o; o.x = pk2(kd[0], kd[1]); o.y = pk2(kd[2], kd[3]); o.z = pk2(kd[4], kd[5]); o.w = pk2(kd[6], kd[7]);
        put_t8(KDt, d0, s, o);
        if (lane == 63) { *(GAS f32x4*)(DEC + (size_t)it * 128 + d0) = (f32x4){dl[0], dl[1], dl[2], dl[3]}; *(GAS f32x4*)(DEC + (size_t)it * 128 + d0 + 4) = (f32x4){dl[4], dl[5], dl[6], dl[7]}; }
    }
    __syncthreads();
    {
        const bf16x8 v0 = ldfrag(Vt, 16 * w + l15, 144, (8 * lg) * 2), v1 = ldfrag(Vt, 16 * w + l15, 144, (32 + 8 * lg) * 2);
#pragma unroll 2
        for (int dt = 0; dt < 8; ++dt) {
            f32x4 a = {0.f, 0.f, 0.f, 0.f};
            a = MFMA16(ldfrag(KDt, 16 * dt + l15, 144, (8 * lg) * 2), v0, a); a = MFMA16(ldfrag(KDt, 16 * dt + l15, 144, (32 + 8 * lg) * 2), v1, a);
            u32x2 o; o.x = pk2(a[0], a[1]); o.y = pk2(a[2], a[3]);
            *(GAS u32x2*)(HST + ((size_t)it * 128 + 16 * w + l15) * 128 + 16 * dt + 4 * lg) = o;
        }
    }
    __syncthreads();
}

struct MoRegs { u32x4 vv[4], qq[2], kq[2], cs[8]; float fl, ip, mprev, npv; };
struct HoRegs { u32x4 hv[2], fv[2], qw[2], cs[4]; };
struct OutPtrs { const GAS float* gates; const GAS float* MPREV; const GAS float* NPREV; const GAS bf16* QC; const GAS bf16* KC; const GAS bf16* MV; const GAS bf16* MST; const GAS bf16* HQ; const GAS bf16* HF; const GAS bf16* HI; const GAS bf16* HST; };
__device__ __forceinline__ void mo_load(int item, int tid, const OutPtrs& P, MoRegs& r) {
    const int lane = tid & 63, w = __builtin_amdgcn_readfirstlane(tid >> 6);
    const int b = item >> 8, h = (item >> 6) & 3, c = item & 63, R0 = b * T + c * 64;
#pragma unroll
    for (int j = 0; j < 8; ++j) { const int q = tid + NTHR * j; r.cs[j] = *(const GAS u32x4*)(P.MST + ((size_t)item * 256 + (q >> 4)) * 128 + (q & 15) * 8); }
#pragma unroll
    for (int i = 0; i < 4; ++i) r.vv[i] = *(const GAS u32x4*)(P.MV + (size_t)(R0 + lane) * 1024 + h * 256 + (w + 8 * i) * 8);
#pragma unroll
    for (int i = 0; i < 2; ++i) { const int idx = tid + NTHR * i, s = idx >> 4, ch = idx & 15;
        r.qq[i] = *(const GAS u32x4*)(P.QC + (size_t)(R0 + s) * 512 + h * 128 + ch * 8); r.kq[i] = *(const GAS u32x4*)(P.KC + (size_t)(R0 + s) * 512 + h * 128 + ch * 8); }
    r.fl = 0.f; r.ip = 0.f; r.mprev = 0.f; r.npv = 0.f;
    if (w == 0) { r.fl = P.gates[(size_t)(R0 + lane) * 8 + 4 + h]; r.ip = P.gates[(size_t)(R0 + lane) * 8 + h]; r.mprev = P.MPREV[item]; }
    if (w == 1 || w == 2) r.npv = P.NPREV[(size_t)item * 128 + (w - 1) * 64 + lane];
}
__device__ __forceinline__ void ho_load(int it, int tid, const OutPtrs& P, HoRegs& r) {
    const int lane = tid & 63, w = __builtin_amdgcn_readfirstlane(tid >> 6), d8 = tid & 15, sr = tid >> 4;
    const int b = it >> 9, h = (it >> 6) & 7, c = it & 63, R0 = b * T + c * 64;
#pragma unroll
    for (int j = 0; j < 4; ++j) { const int q = tid + NTHR * j; r.cs[j] = *(const GAS u32x4*)(P.HST + ((size_t)it * 128 + (q >> 4)) * 128 + (q & 15) * 8); }
#pragma unroll
    for (int i = 0; i < 2; ++i) { r.hv[i] = *(const GAS u32x4*)(P.HI + (size_t)(R0 + lane) * 1024 + h * 128 + (w + 8 * i) * 8);
        r.fv[i] = *(const GAS u32x4*)(P.HF + (size_t)(R0 + sr + 32 * i) * 1024 + h * 128 + d8 * 8); r.qw[i] = *(const GAS u32x4*)(P.HQ + (size_t)(R0 + sr + 32 * i) * 1024 + h * 128 + d8 * 8); }
}
__device__ __forceinline__ void mlstm_out_item(LAS unsigned char* lds, int item, int tid, const OutPtrs& P, MoRegs& rm, int nxt,
                                               const GAS bf16* MO, const GAS float* mhn, GAS bf16* YM) {
    const int lane = tid & 63, w = __builtin_amdgcn_readfirstlane(tid >> 6), l15 = lane & 15, lg = lane >> 4;
    const int b = item >> 8, h = (item >> 6) & 3, c = item & 63, R0 = b * T + c * 64;
    LAS float* sc = (LAS float*)lds;
    LAS unsigned char* Qs = lds + 4096;
    LAS unsigned char* Ks = Qs + 17408;
    LAS unsigned char* Ss = Ks + 17408;
    LAS unsigned char* Vt = Ss + 9216;
    LAS unsigned char* Cs = Vt + 36864;
    const int tt = w & 3, hh = w >> 2, t = 16 * tt + l15;
    {
#pragma unroll
        for (int i = 0; i < 2; ++i) { const int idx = tid + NTHR * i, s = idx >> 4, ch = idx & 15; *(LAS u32x4*)(Qs + s * 272 + ch * 16) = rm.qq[i]; *(LAS u32x4*)(Ks + s * 272 + ch * 16) = rm.kq[i]; }
#pragma unroll
        for (int i = 0; i < 4; ++i) put_t8(Vt, (w + 8 * i) * 8, lane, rm.vv[i]);
#pragma unroll
        for (int j = 0; j < 8; ++j) { const int q = tid + NTHR * j; *(LAS u32x4*)(Cs + (q >> 4) * 272 + (q & 15) * 16) = rm.cs[j]; }
        if (w == 0) {
            const float bs = wave_scan_incl(rm.fl, lane); float pm = rm.ip - bs;
#pragma unroll
            for (int o = 1; o < 64; o <<= 1) { const float u = __shfl_up(pm, o); if (lane >= o) pm = fmaxf(pm, u); }
            const float mt = bs + fmaxf(rm.mprev, pm);
            sc[lane] = bs; sc[64 + lane] = rm.ip; sc[128 + lane] = mt; sc[192 + lane] = __expf(bs + rm.mprev - mt);
        }
        if (w == 1 || w == 2) sc[512 + (w - 1) * 64 + lane] = rm.npv;
        if (nxt < 512) mo_load(nxt, tid, P, rm);
    }
    __syncthreads();
    bf16x8 qf[4];
#pragma unroll
    for (int kk = 0; kk < 4; ++kk) qf[kk] = ldfrag(Qs, t, 272, (32 * kk + 8 * lg) * 2);
    f32x4 a2[8];
#pragma unroll
    for (int et = 0; et < 8; ++et) { f32x4 a = {0.f, 0.f, 0.f, 0.f};
#pragma unroll
        for (int kk = 0; kk < 4; ++kk) a = MFMA16(ldfrag(Cs, 128 * hh + 16 * et + l15, 272, (32 * kk + 8 * lg) * 2), qf[kk], a);
        a2[et] = a; }
    float qn;
    {
        float acc = 0.f;
#pragma unroll
        for (int kk = 0; kk < 4; ++kk) { const f32x4 n0 = *(const LAS f32x4*)(sc + 512 + 32 * kk + 8 * lg), n1 = *(const LAS f32x4*)(sc + 512 + 32 * kk + 8 * lg + 4);
            float q8[8]; unpack8(__builtin_bit_cast(u32x4, qf[kk]), q8);
            acc += (q8[0] * n0[0] + q8[1] * n0[1]) + (q8[2] * n0[2] + q8[3] * n0[3]) + (q8[4] * n1[0] + q8[5] * n1[1]) + (q8[6] * n1[2] + q8[7] * n1[3]); }
        acc += __shfl_xor(acc, 16); acc += __shfl_xor(acc, 32); qn = acc;
    }
    {
        const float bt = sc[t], mt = sc[128 + t]; float rs = 0.f;
#pragma unroll
        for (int j = 0; j < 2; ++j) {
            const int st = 2 * hh + j; f32x4 a = {0.f, 0.f, 0.f, 0.f};
            if (st <= tt) {
#pragma unroll
                for (int kk = 0; kk < 4; ++kk) a = MFMA16(ldfrag(Ks, 16 * st + l15, 272, (32 * kk + 8 * lg) * 2), qf[kk], a);
            }
            float o[4];
#pragma unroll
            for (int r = 0; r < 4; ++r) { const int s = 16 * st + 4 * lg + r; o[r] = (s <= t) ? a[r] * __expf(bt - sc[s] + sc[64 + s] - mt) : 0.f; }
            u32x2 wv; wv.x = pk2(o[0], o[1]); wv.y = pk2(o[2], o[3]);
            *(LAS u32x2*)(Ss + t * 144 + (16 * st + 4 * lg) * 2) = wv;
            rs += (lo_bf(wv.x) + hi_bf(wv.x)) + (lo_bf(wv.y) + hi_bf(wv.y));
        }
        rs += __shfl_xor(rs, 16); rs += __shfl_xor(rs, 32);
        if (lg == 0) sc[256 + 64 * hh + t] = rs;
    }
    u32x2 mo[8];
#pragma unroll
    for (int et = 0; et < 8; ++et) mo[et] = *(const GAS u32x2*)(MO + (size_t)(R0 + t) * 1024 + h * 256 + 128 * hh + 16 * et + 4 * lg);
    __syncthreads();
    {
        const bf16x8 s0 = ldfrag(Ss, t, 144, (8 * lg) * 2), s1 = ldfrag(Ss, t, 144, (32 + 8 * lg) * 2);
        const float wi = sc[192 + t];
        const float den = (sc[256 + t] + sc[320 + t]) + wi * qn; const float dinv = 1.0f / fmaxf(fabsf(den), __expf(-sc[128 + t]));
        float q2 = 0.f;
#pragma unroll
        for (int et = 0; et < 8; ++et) {
            const int e0 = 128 * hh + 16 * et; f32x4 a1 = {0.f, 0.f, 0.f, 0.f};
            a1 = MFMA16(ldfrag(Vt, e0 + l15, 144, (8 * lg) * 2), s0, a1); a1 = MFMA16(ldfrag(Vt, e0 + l15, 144, (32 + 8 * lg) * 2), s1, a1);
#pragma unroll
            for (int r = 0; r < 4; ++r) { const float hv = (a1[r] + wi * a2[et][r]) * dinv; a2[et][r] = hv; q2 += hv * hv; }
        }
        q2 += __shfl_xor(q2, 16); q2 += __shfl_xor(q2, 32);
        if (lg == 0) sc[384 + 64 * hh + t] = q2;
        __syncthreads();
        const float rn = rsqrtf((sc[384 + t] + sc[448 + t]) * (1.0f / 256.0f) + EPS);
#pragma unroll
        for (int et = 0; et < 8; ++et) {
            const int e = 128 * hh + 16 * et + 4 * lg; const f32x4 g4 = *(const LAS f32x4*)(Cs + 69632 + e * 4);
            u32x2 o; o.x = pk2(a2[et][0] * rn * g4[0] * lo_bf(mo[et].x), a2[et][1] * rn * g4[1] * hi_bf(mo[et].x)); o.y = pk2(a2[et][2] * rn * g4[2] * lo_bf(mo[et].y), a2[et][3] * rn * g4[3] * hi_bf(mo[et].y));
            *(GAS u32x2*)(YM + (size_t)(R0 + t) * 1024 + h * 256 + e) = o;
        }
    }
    __syncthreads();
}

__device__ __forceinline__ void hgrn_out_item(LAS unsigned char* lds, int it, int tid, const OutPtrs& P, HoRegs& rh, int nxt, const GAS bf16* HG, const GAS float* lbl, const GAS float* hhn, GAS bf16* YH) {
    const int lane = tid & 63, w = __builtin_amdgcn_readfirstlane(tid >> 6), l15 = lane & 15, lg = lane >> 4;
    const int b = it >> 9, h = (it >> 6) & 7, c = it & 63, R0 = b * T + c * 64;
    LAS float* sc = (LAS float*)lds;
    LAS float* Gs = (LAS float*)(lds + 4096);
    LAS unsigned char* Qt = lds + 4096 + 32768;
    LAS unsigned char* Kt = Qt + 17408;
    LAS unsigned char* Qe = Kt + 17408;
    LAS unsigned char* As = Qe + 17408;
    LAS unsigned char* Vt = As + 9216;
    LAS unsigned char* Cs = Vt + 18432;
    const int d8 = tid & 15, sr = tid >> 4;
    const int tt = w & 3, hh = w >> 2, t = 16 * tt + l15;
    float qv[2][8], kv[2][8];
    {
#pragma unroll
        for (int j = 0; j < 4; ++j) { const int q = tid + NTHR * j; *(LAS u32x4*)(Cs + (q >> 4) * 272 + (q & 15) * 16) = rh.cs[j]; }
        float lbv[8];
        { const LAS float* LBV = (const LAS float*)(Cs + 34816); const int dd = h * 128 + d8 * 8; const f32x4 a0 = *(const LAS f32x4*)(LBV + dd), a1 = *(const LAS f32x4*)(LBV + dd + 4);
#pragma unroll
          for (int e = 0; e < 4; ++e) { lbv[e] = a0[e]; lbv[4 + e] = a1[e]; } }
#pragma unroll
        for (int i = 0; i < 2; ++i) {
            put_t8(Vt, (w + 8 * i) * 8, lane, rh.hv[i]);
            float f[8]; unpack8(rh.fv[i], f); unpack8(rh.qw[i], qv[i]); f32x4 g0, g1;
#pragma unroll
            for (int e = 0; e < 8; ++e) { const float sg = sigmoidf_(f[e]); const float g = __logf(lbv[e] + (1.f - lbv[e]) * sg); kv[i][e] = (1.f - lbv[e]) * (1.f - sg); if (e < 4) g0[e] = g; else g1[e - 4] = g; }
            *(LAS f32x4*)(Gs + (sr + 32 * i) * 128 + d8 * 8) = g0; *(LAS f32x4*)(Gs + (sr + 32 * i) * 128 + d8 * 8 + 4) = g1;
        }
    }
    u32x2 hg[4];
#pragma unroll
    for (int et = 0; et < 4; ++et) hg[et] = *(const GAS u32x2*)(HG + (size_t)(R0 + t) * 1024 + h * 128 + 64 * hh + 16 * et + 4 * lg);
    if (nxt < 512 + 1024) ho_load(nxt - 512, tid, P, rh);
    __syncthreads();
    {
        const int d = tid & 127, seg = tid >> 7; float g[16]; float Gc = 0.f;
#pragma unroll
        for (int j = 0; j < 16; ++j) g[j] = Gs[(16 * seg + j) * 128 + d];
#pragma unroll
        for (int j = 0; j < 16; ++j) { Gc += g[j]; Gs[(16 * seg + j) * 128 + d] = Gc; }
        sc[128 + seg * 128 + d] = Gc;
    }
    __syncthreads();
    {
        float t0[8], t1[8], t2[8], gm[8];
        { const f32x4 a0 = *(const LAS f32x4*)(sc + 128 + d8 * 8), a1 = *(const LAS f32x4*)(sc + 128 + d8 * 8 + 4), b0 = *(const LAS f32x4*)(sc + 256 + d8 * 8), b1 = *(const LAS f32x4*)(sc + 256 + d8 * 8 + 4),
                      c0 = *(const LAS f32x4*)(sc + 384 + d8 * 8), c1 = *(const LAS f32x4*)(sc + 384 + d8 * 8 + 4), m0 = *(const LAS f32x4*)(Gs + 31 * 128 + d8 * 8), m1 = *(const LAS f32x4*)(Gs + 31 * 128 + d8 * 8 + 4);
#pragma unroll
          for (int e = 0; e < 4; ++e) { t0[e] = a0[e]; t0[4 + e] = a1[e]; t1[e] = b0[e]; t1[4 + e] = b1[e]; t2[e] = c0[e]; t2[4 + e] = c1[e]; gm[e] = m0[e] + a0[e]; gm[4 + e] = m1[e] + a1[e]; } }
#pragma unroll
        for (int i = 0; i < 2; ++i) { const int s = sr + 32 * i, seg = s >> 4;
            const f32x4 g0 = *(const LAS f32x4*)(Gs + s * 128 + d8 * 8), g1 = *(const LAS f32x4*)(Gs + s * 128 + d8 * 8 + 4);
            float g[8] = {g0[0], g0[1], g0[2], g0[3], g1[0], g1[1], g1[2], g1[3]};
            float a[8], bq[8], cq[8];
#pragma unroll
            for (int e = 0; e < 8; ++e) { g[e] += (seg > 0 ? t0[e] : 0.f) + (seg > 1 ? t1[e] : 0.f) + (seg > 2 ? t2[e] : 0.f);
                a[e] = qv[i][e] * __expf(g[e] - gm[e]); bq[e] = kv[i][e] * __expf(gm[e] - g[e]); cq[e] = qv[i][e] * __expf(g[e]); }
            u32x4 o; o.x = pk2(a[0], a[1]); o.y = pk2(a[2], a[3]); o.z = pk2(a[4], a[5]); o.w = pk2(a[6], a[7]); *(LAS u32x4*)(Qt + s * 272 + d8 * 16) = o;
            o.x = pk2(bq[0], bq[1]); o.y = pk2(bq[2], bq[3]); o.z = pk2(bq[4], bq[5]); o.w = pk2(bq[6], bq[7]); *(LAS u32x4*)(Kt + s * 272 + d8 * 16) = o;
            o.x = pk2(cq[0], cq[1]); o.y = pk2(cq[2], cq[3]); o.z = pk2(cq[4], cq[5]); o.w = pk2(cq[6], cq[7]); *(LAS u32x4*)(Qe + s * 272 + d8 * 16) = o; }
    }
    __syncthreads();
    {
        bf16x8 qf[4];
#pragma unroll
        for (int kk = 0; kk < 4; ++kk) qf[kk] = ldfrag(Qt, t, 272, (32 * kk + 8 * lg) * 2);
#pragma unroll
        for (int j = 0; j < 2; ++j) {
            const int st = 2 * hh + j; f32x4 a = {0.f, 0.f, 0.f, 0.f};
            if (st <= tt) {
#pragma unroll
                for (int kk = 0; kk < 4; ++kk) a = MFMA16(ldfrag(Kt, 16 * st + l15, 272, (32 * kk + 8 * lg) * 2), qf[kk], a);
            }
            float o[4];
#pragma unroll
            for (int r = 0; r < 4; ++r) { const int s = 16 * st + 4 * lg + r; o[r] = (s <= t) ? a[r] : 0.f; }
            u32x2 wv; wv.x = pk2(o[0], o[1]); wv.y = pk2(o[2], o[3]);
            *(LAS u32x2*)(As + t * 144 + (16 * st + 4 * lg) * 2) = wv;
        }
    }
    f32x4 oacc[4];
    {
        bf16x8 qe[4];
#pragma unroll
        for (int kk = 0; kk < 4; ++kk) qe[kk] = ldfrag(Qe, t, 272, (32 * kk + 8 * lg) * 2);
#pragma unroll
        for (int et = 0; et < 4; ++et) { f32x4 a = {0.f, 0.f, 0.f, 0.f};
#pragma unroll
            for (int kk = 0; kk < 4; ++kk) a = MFMA16(ldfrag(Cs, 64 * hh + 16 * et + l15, 272, (32 * kk + 8 * lg) * 2), qe[kk], a);
            oacc[et] = a; }
    }
    __syncthreads();
    {
        const bf16x8 a0 = ldfrag(As, t, 144, (8 * lg) * 2), a1 = ldfrag(As, t, 144, (32 + 8 * lg) * 2);
        float q2 = 0.f;
#pragma unroll
        for (int et = 0; et < 4; ++et) {
            const int e0 = 64 * hh + 16 * et; f32x4 a = oacc[et];
            a = MFMA16(ldfrag(Vt, e0 + l15, 144, (8 * lg) * 2), a0, a); a = MFMA16(ldfrag(Vt, e0 + l15, 144, (32 + 8 * lg) * 2), a1, a);
            oacc[et] = a; q2 += (a[0] * a[0] + a[1] * a[1]) + (a[2] * a[2] + a[3] * a[3]);
        }
        q2 += __shfl_xor(q2, 16); q2 += __shfl_xor(q2, 32);
        if (lg == 0) sc[64 * hh + t] = q2;
        __syncthreads();
        const float rn = rsqrtf((sc[t] + sc[64 + t]) * (1.0f / 128.0f) + EPS);
#pragma unroll
        for (int et = 0; et < 4; ++et) {
            const int e = 64 * hh + 16 * et + 4 * lg; const f32x4 g4 = *(const LAS f32x4*)(Cs + 34816 + 4096 + (h * 128 + e) * 4);
            u32x2 o; o.x = pk2(oacc[et][0] * rn * g4[0] * lo_bf(hg[et].x), oacc[et][1] * rn * g4[1] * hi_bf(hg[et].x)); o.y = pk2(oacc[et][2] * rn * g4[2] * lo_bf(hg[et].y), oacc[et][3] * rn * g4[3] * hi_bf(hg[et].y));
            *(GAS u32x2*)(YH + (size_t)(R0 + t) * 1024 + h * 128 + e) = o;
        }
    }
    __syncthreads();
}

typedef const volatile unsigned long long __attribute__((address_space(4)))* KArgs;
#define KINP(i) ((const float*)kargs[(i)])
constexpr int I0 = N_FFN_ITEMS, I1 = I0 + 7424, I2 = I1 + 4096, I3 = I2 + 1024, I4 = I3 + 1024, I5 = I4 + 2048, I6 = I5 + 4096, I7 = I6 + 2048;
__device__ __forceinline__ CvtDesc w_desc(KArgs kargs, unsigned char* ws, int it) {
    if (it < I0) return ffn_desc(it, KINP(I_F1W1), KINP(I_F1W3), KINP(I_F1W2), KINP(I_NFFN1), (bf16*)(ws + WS_W13), (bf16*)(ws + WS_W2T));
    if (it < I1) { const int r = it - I0, nb = r % 232, kb = r / 232;
        const int col0 = nb < 96 ? nb * 32 : (nb < 224 ? nb * 32 + 8 : 3072); const int nv = nb < 224 ? 32 : (nb == 224 ? 8 : 0);
        return mk_desc(KINP(I_WIN), DIN, col0, nv, kb * 64, KINP(I_NMIX), (bf16*)(ws + WS_WIN) + (size_t)nb * 32 * D, D); }
    if (it < I2) { const int r = it - I1, nb = r % 128, kb = r / 128; return mk_desc(KINP(I_WIN), DIN, 7176 + nb * 32, 32, kb * 64, KINP(I_NMIX), (bf16*)(ws + WS_WG) + (size_t)nb * 32 * D, D); }
    if (it < I3) { const int r = it - I2, nb = r % 64, kb = r / 64; return mk_desc(KINP(I_WPM), D, nb * 32, 32, kb * 64, nullptr, (bf16*)(ws + WS_WPM) + (size_t)nb * 32 * 1024, 1024); }
    if (it < I4) { const int r = it - I3, nb = r % 64, kb = r / 64; return mk_desc(KINP(I_WPH), D, nb * 32, 32, kb * 64, nullptr, (bf16*)(ws + WS_WPH) + (size_t)nb * 32 * 1024, 1024); }
    if (it < I5) { const int r = it - I4, nb = r % 64, kb = r / 64; return mk_desc(KINP(I_WOUT), D, nb * 32, 32, kb * 64, nullptr, (bf16*)(ws + WS_WOUT) + (size_t)nb * 32 * D, D); }
    if (it < I6) { const int r = it - I5, nb = r % 128, kb = r / 128; return mk_desc(KINP(I_WKV), 2 * D, nb * 32, 32, kb * 64, nullptr, (bf16*)(ws + WS_WKV) + (size_t)nb * 32 * D, D); }
    { const int r = it - I6, nb = r % 64, kb = r / 64; return mk_desc(KINP(I_WO), D, nb * 32, 32, kb * 64, nullptr, (bf16*)(ws + WS_WO) + (size_t)nb * 32 * D, D); }
}
constexpr int WIN_P0 = 3712;
template <bool EARLY>
__device__ __forceinline__ void copy_items(KArgs kargs, unsigned char* ws, int first, int count, int cw, int ncw) {
    int ln = threadIdx.x & 63; asm volatile("" : "+v"(ln));
#pragma unroll 1
    for (int base = cw; base < count; base += 4 * ncw) {
        CvtDesc d[4]; f32x4 v[4][8];
#pragma unroll
        for (int u = 0; u < 4; ++u) { const int j = base + u * ncw; if (j < count) { d[u] = w_desc(kargs, ws, EARLY ? (j < 11264 ? j : (j < 11264 + WIN_P0 ? (I1 - WIN_P0) + (j - 11264) : I4 + (j - 11264 - WIN_P0))) : first + j); cvt_load(d[u], ln, v[u]); } }
#pragma unroll
        for (int u = 0; u < 4; ++u) { const int j = base + u * ncw; if (j < count) cvt_store(d[u], ln, v[u]); }
    }
}
__device__ __forceinline__ void wq_row(KArgs kargs, unsigned char* ws, int d, int lane) {
    const float g = KINP(I_NX)[d]; const f32x4* src = (const f32x4*)(KINP(I_WQ) + (size_t)d * D) + lane; bf16* dst = (bf16*)(ws + WS_WQ) + (size_t)d * D;
    f32x4 v[8];
#pragma unroll
    for (int j = 0; j < 8; ++j) v[j] = __builtin_nontemporal_load(src + 64 * j);
#pragma unroll
    for (int j = 0; j < 8; ++j) { const f32x4 o = v[j] * g; u32x2 w; w.x = pk2(o[0], o[1]); w.y = pk2(o[2], o[3]); *(GAS u32x2*)(dst + 256 * j + 4 * lane) = w; }
}

__global__ void __launch_bounds__(NTHR, 2) fwd_kernel(Args args) {
    extern __shared__ __attribute__((aligned(16))) unsigned char lds_raw[];
    LAS unsigned char* lds = (LAS unsigned char*)lds_raw;
    volatile LAS unsigned* MISC = (volatile LAS unsigned*)(lds + MISC_OFF);
    const int tid = threadIdx.x, lane = tid & 63, wave = __builtin_amdgcn_readfirstlane(tid >> 6);
    const int G = gridDim.x, bid = blockIdx.x;
    KArgs kargs = (KArgs)__builtin_amdgcn_kernarg_segment_ptr();
#define INP(i) ((const float*)kargs[(i)])
    unsigned char* ws = (unsigned char*)kargs[29];
    unsigned* ctl = (unsigned*)(ws + WS_CTL);
    if (tid < 64) MISC[tid] = 0u;
    __syncthreads();
    XcdBarrier bar = xcd_barrier_post(ctl + CW_BAR, MISC + 8);
    u64* ss = (u64*)(ws + WS_CTL + CTL_SS);
    const int gw = bid * NWAVES + wave, NGW = G * NWAVES;
    float* X = (float*)(ws + WS_X); bf16* XB = (bf16*)(ws + WS_XB);
    float* smallf = (float*)(ws + WS_SMALL);

    const bool split = (G == 256);
    constexpr int NEARLY = 11264 + WIN_P0 + (I7 - I4), NMID = (I1 - WIN_P0) - 11264, NLATE = I4 - I1;

    for (int rep_ = 0; rep_ < NREP(0); ++rep_) if (rep_ == 0 || (xcd_barrier(bar), true))
    {
        if (split) copy_items<true>(kargs, ws, 0, NEARLY, gw, NGW); else copy_items<false>(kargs, ws, 0, I7, gw, NGW);
#pragma unroll 1
        for (int d = gw; d < D; d += NGW) wq_row(kargs, ws, d, lane);
#pragma unroll 1
        for (int it = gw; it < 8192 + 512; it += NGW) {
            if (it < 8192) { const int row = it;
                const f32x4* src = (const f32x4*)(INP(I_X) + (size_t)row * D) + lane; bf16* dst = XB + (size_t)row * D; float s = 0.f;
                f32x4 v[8];
#pragma unroll
                for (int j = 0; j < 8; ++j) v[j] = __builtin_nontemporal_load(src + 64 * j);
#pragma unroll
                for (int j = 0; j < 8; ++j) { s += (v[j][0] * v[j][0] + v[j][1] * v[j][1]) + (v[j][2] * v[j][2] + v[j][3] * v[j][3]); u32x2 w; w.x = pk2(v[j][0], v[j][1]); w.y = pk2(v[j][2], v[j][3]); *(u32x2*)(dst + 256 * j + 4 * lane) = w; }
                s = wave_sum(s); if (lane == 0) ss[row] = (u64)(s * SS_SCALE); }
            else { const int row = it - 8192;
                const f32x4* src = (const f32x4*)(INP(I_MEM) + (size_t)row * D) + lane; const f32x4* gp = (const f32x4*)INP(I_NMEM) + lane; bf16* dst = (bf16*)(ws + WS_MEMN) + (size_t)row * D;
                f32x4 v[8]; float s = 0.f;
#pragma unroll
                for (int j = 0; j < 8; ++j) { v[j] = __builtin_nontemporal_load(src + 64 * j); s += (v[j][0] * v[j][0] + v[j][1] * v[j][1]) + (v[j][2] * v[j][2] + v[j][3] * v[j][3]); }
                const float r = rsqrtf(wave_sum(s) * (1.0f / D) + EPS);
#pragma unroll
                for (int j = 0; j < 8; ++j) { const f32x4 o = v[j] * r * gp[64 * j]; u32x2 w; w.x = pk2(o[0], o[1]); w.y = pk2(o[2], o[3]); *(u32x2*)(dst + 256 * j + 4 * lane) = w; } }
        }
    }
    xcd_barrier(bar);

    const bool LOCF = (MISC[11] != 0u);
    const int lrf = (int)MISC[10], xf = (int)bar.x;
    unsigned* rdyMID = ctl + 12416; unsigned* rdyKV = ctl + 12480;
#define FRONT_BARRIER() do { if (LOCF) xcd_local_barrier(bar, lrf & 3, ctl + 13312); else xcd_barrier(bar); } while (0)
    for (int rep_ = 0; rep_ < NREP(1); ++rep_) if (rep_ == 0 || (xcd_barrier(bar), true))
    { SchedUpKv S; S.o.init(32, 44, G, bid); S.G = G; S.c = bid; S.XBp = (const char*)XB; S.W13p = (const char*)(ws + WS_W13); S.MEMNp = (const char*)(ws + WS_MEMN); S.WKVp = (const char*)(ws + WS_WKV);
      S.loc = 0; S.p0 = 0; S.xq = 0; if (LOCF) { S.loc = 1; S.p0 = 4 * xf; S.xq = xf; S.c = lrf; }
      EpiUpKv E{EpiUp{(bf16*)(ws + AR_ACT), ss + 0 * M}, (bf16*)(ws + WS_KV)};
      pg8::gemm_phase((const char*)ws, lds, D, D, S, E);
      if (LOCF) {
          if (lrf >= 16 && lrf < 20) publish_count(rdyKV);
          if (lrf >= 20) { copy_items<false>(kargs, ws, 11264, NMID, (xf * 12 + lrf - 20) * NWAVES + wave, 96 * NWAVES); publish_count(rdyMID); }
      } else if (split && bid >= 160) copy_items<false>(kargs, ws, 11264, NMID, (bid - 160) * NWAVES + wave, 96 * NWAVES); }
    if (LOCF) await_before_barrier(rdyMID, 96u, bar.bar);
    FRONT_BARRIER();
    for (int rep_ = 0; rep_ < NREP(2); ++rep_) if (rep_ == 0 || (xcd_barrier(bar), true))
    { SchedStd S; S.o.init(32, 8, G, bid); if (LOCF) S.o.init_loc(8, 4 * xf, lrf);
      S.A = (const char*)(ws + AR_ACT); S.B = (const char*)(ws + WS_W2T); S.astep = (size_t)256 * FF * 2; S.bstep = (size_t)256 * FF * 2; S.bbatch = 0; S.nt = FF / 64;
      EpiRes<true> E{INP(I_X), XB, ss + 1 * M, 0.5f};
      pg8::gemm_phase((const char*)ws, lds, FF, FF, S, E); }
    if (LOCF) await_before_barrier(rdyKV, 32u, bar.bar);
    FRONT_BARRIER();
    for (int rep_ = 0; rep_ < NREP(3); ++rep_) if (rep_ == 0 || (xcd_barrier(bar), true))
    { SchedInW S; S.o.init(32, 29, G, bid); S.G = G; S.c = bid; S.XBp = (const char*)XB; S.WINp = (const char*)(ws + WS_WIN); S.Kp = (const char*)(ws + WS_KV); S.Vp = (const char*)(ws + WS_KV) + (size_t)512 * D * 2;
      S.WQp = (const char*)(ws + WS_WQ); S.WOp = (const char*)(ws + WS_WO);
      S.loc = 0; S.p0 = 0; S.xq = 0; if (LOCF) { S.loc = 1; S.p0 = 4 * xf; S.xq = xf; S.c = lrf; }
      EpiInW E{EpiInproj{ws, ss + 1 * M, INP(I_IGB), INP(I_FGB)}, (bf16*)(ws + WS_WQKT), (bf16*)(ws + WS_VWOT)};
      pg8::gemm_phase((const char*)ws, lds, D, D, S, E);
      if (LOCF) { if (lrf >= 24) copy_items<false>(kargs, ws, I1, NLATE, (xf * 8 + lrf - 24) * NWAVES + wave, 64 * NWAVES); }
      else if (split && bid >= 192) copy_items<false>(kargs, ws, I1, NLATE, (bid - 192) * NWAVES + wave, 64 * NWAVES); }
    xcd_barrier(bar);

    const bool LOCM = (MISC[11] != 0u);
    const int lrk = (int)MISC[10], xq = (int)bar.x;
    const int ms = LOCM ? 32 : G;
    const int m0 = LOCM ? xq * 64 + lrk : bid, m1 = LOCM ? xq * 64 + 64 : 512;
    const int h0 = LOCM ? xq * 128 + lrk : (bid + G - 512 % G) % G, h1 = LOCM ? xq * 128 + 128 : 1024;
#define MIX_BARRIER() do { if (LOCM) xcd_local_barrier(bar); else xcd_barrier(bar); } while (0)
    for (int rep_ = 0; rep_ < NREP(7); ++rep_) if (rep_ == 0 || (xcd_barrier(bar), true))
    {
        const GAS float* convw = (const GAS float*)INP(I_CONVW); const GAS float* convb = (const GAS float*)INP(I_CONVB); const GAS float* lbl = (const GAS float*)INP(I_LBL);
        const GAS float* gates = (const GAS float*)(smallf + SM_GATES / 4);
        GAS float* BLAST = (GAS float*)(smallf + SM_BLAST / 4); GAS float* MLOC = (GAS float*)(smallf + SM_MLOC / 4); GAS float* DN = (GAS float*)(smallf + SM_DN / 4); GAS float* DEC = (GAS float*)(smallf + SM_DEC / 4);
        int tid7 = threadIdx.x; asm volatile("" : "+v"(tid7));
        {   MaRegs rm; const GAS bf16* QKRAW = (const GAS bf16*)(ws + AR_QKRAW); const GAS bf16* MV = (const GAS bf16*)(ws + AR_MV);
            if (m0 < m1) { mlstm_stage_convw(lds, (m0 >> 6) & 3, tid7, convw, convb); ma_load(m0, tid7, gates, QKRAW, MV, rm); }
#pragma unroll 1
            for (int item = m0; item < m1; item += ms)
                mlstm_state_item(lds, item, tid7, rm, (item + ms < m1) ? item + ms : (1 << 20), gates, convw, convb, QKRAW, (GAS bf16*)(ws + AR_QC), (GAS bf16*)(ws + AR_KC), MV, (GAS bf16*)(ws + AR_MST), DN, BLAST, MLOC);
        }
        {   HaRegs rh;
            const GAS bf16* HF = (const GAS bf16*)(ws + AR_HF); const GAS bf16* HI = (const GAS bf16*)(ws + AR_HI);
            if (h0 < h1) { LAS float* LBV = (LAS float*)(lds + 2048 + 34816 + 18432 + 18432 + 17408 * 2);
                LBV[tid7] = sigmoidf_(lbl[1024 + tid7] - lbl[tid7]); LBV[512 + tid7] = sigmoidf_(lbl[1536 + tid7] - lbl[512 + tid7]);
                ha_load(h0, tid7, HF, HI, rh); }
#pragma unroll 1
            for (int it = h0; it < h1; it += ms)
                hgrn_state_item(lds, it, tid7, rh, (it + ms < h1) ? it + ms : (1 << 20), HF, HI, lbl, (GAS bf16*)(ws + AR_HST), DEC);
        }
    }
    MIX_BARRIER();

    for (int rep_ = 0; rep_ < NREP(8); ++rep_) if (rep_ == 0 || (xcd_barrier(bar), true))
    {
        const float* BLAST = smallf + SM_BLAST / 4; const float* MLOC = smallf + SM_MLOC / 4; float* MPREV = smallf + SM_MPREV / 4; float* DN = smallf + SM_DN / 4; const float* DEC = smallf + SM_DEC / 4;
        bf16* MST = (bf16*)(ws + AR_MST); bf16* HST = (bf16*)(ws + AR_HST);
        const int q8 = LOCM ? (lrk < 16 ? (xq << 13) + lrk * NTHR + tid : 65536 + ((2 * xq + ((lrk - 16) >> 3)) << 12) + ((lrk - 16) & 7) * NTHR + tid) : bid * NTHR + tid;
        const int q8s = LOCM ? (1 << 24) : G * NTHR;
#pragma unroll 1
        for (int q = q8; q < 131072; q += q8s) {
            if (q < 65536) {
                const int bh = q >> 13, qi = q & 8191; float m = 0.f; f32x4 C = {0.f, 0.f, 0.f, 0.f};
#define P8_LDM(c0, dw, bl, ml) _Pragma("unroll") for (int j = 0; j < 8; ++j) { const int item = bh * 64 + (c0) + j; dw[j] = *(const u32x2*)(MST + (size_t)item * 32768 + qi * 4); bl[j] = BLAST[item]; ml[j] = MLOC[item]; }
#define P8_PRM(c0, dw, bl, ml) _Pragma("unroll") for (int j = 0; j < 8; ++j) { \
                        const int item = bh * 64 + (c0) + j; u32x2 cw; cw.x = pk2(C[0], C[1]); cw.y = pk2(C[2], C[3]); *(u32x2*)(MST + (size_t)item * 32768 + qi * 4) = cw; \
                        if (qi == 0) MPREV[item] = m; \
                        const float mn = fmaxf(bl[j] + m, ml[j]), dec = __expf(bl[j] + m - mn), wl = __expf(ml[j] - mn); \
                        C[0] = dec * C[0] + wl * lo_bf(dw[j].x); C[1] = dec * C[1] + wl * hi_bf(dw[j].x); C[2] = dec * C[2] + wl * lo_bf(dw[j].y); C[3] = dec * C[3] + wl * hi_bf(dw[j].y); m = mn; }
                u32x2 dwA[8], dwB[8]; float blA[8], mlA[8], blB[8], mlB[8];
                P8_LDM(0, dwA, blA, mlA); P8_LDM(8, dwB, blB, mlB);
                P8_PRM(0, dwA, blA, mlA); P8_LDM(16, dwA, blA, mlA); P8_PRM(8, dwB, blB, mlB); P8_LDM(24, dwB, blB, mlB); P8_PRM(16, dwA, blA, mlA); P8_LDM(32, dwA, blA, mlA); P8_PRM(24, dwB, blB, mlB); P8_LDM(40, dwB, blB, mlB);
                P8_PRM(32, dwA, blA, mlA); P8_LDM(48, dwA, blA, mlA); P8_PRM(40, dwB, blB, mlB); P8_LDM(56, dwB, blB, mlB); P8_PRM(48, dwA, blA, mlA); P8_PRM(56, dwB, blB, mlB);
#undef P8_LDM
#undef P8_PRM
            } else {
                const int q2 = q - 65536, bh = q2 >> 12, qi = q2 & 4095, d = (qi * 4) & 127; f32x4 Sx = {0.f, 0.f, 0.f, 0.f};
#define P8_LDH(c0, dw, dc) _Pragma("unroll") for (int j = 0; j < 8; ++j) { const int it = bh * 64 + (c0) + j; dw[j] = *(const u32x2*)(HST + (size_t)it * 16384 + qi * 4); dc[j] = *(const f32x4*)(DEC + (size_t)it * 128 + d); }
#define P8_PRH(c0, dw, dc) _Pragma("unroll") for (int j = 0; j < 8; ++j) { \
                        const int it = bh * 64 + (c0) + j; u32x2 cw; cw.x = pk2(Sx[0], Sx[1]); cw.y = pk2(Sx[2], Sx[3]); *(u32x2*)(HST + (size_t)it * 16384 + qi * 4) = cw; \
                        Sx[0] = dc[j][0] * Sx[0] + lo_bf(dw[j].x); Sx[1] = dc[j][1] * Sx[1] + hi_bf(dw[j].x); Sx[2] = dc[j][2] * Sx[2] + lo_bf(dw[j].y); Sx[3] = dc[j][3] * Sx[3] + hi_bf(dw[j].y); }
                u32x2 dwA[8], dwB[8]; f32x4 dcA[8], dcB[8];
                P8_LDH(0, dwA, dcA); P8_LDH(8, dwB, dcB);
                P8_PRH(0, dwA, dcA); P8_LDH(16, dwA, dcA); P8_PRH(8, dwB, dcB); P8_LDH(24, dwB, dcB); P8_PRH(16, dwA, dcA); P8_LDH(32, dwA, dcA); P8_PRH(24, dwB, dcB); P8_LDH(40, dwB, dcB);
                P8_PRH(32, dwA, dcA); P8_LDH(48, dwA, dcA); P8_PRH(40, dwB, dcB); P8_LDH(56, dwB, dcB); P8_PRH(48, dwA, dcA); P8_PRH(56, dwB, dcB);
#undef P8_LDH
#undef P8_PRH
            }
        }
#pragma unroll 1
        for (int q = LOCM ? ((lrk == 0 && tid < 128) ? xq * 128 + tid : 1024) : bid * NTHR + tid; q < 1024; q += q8s) {
            const int bh = q >> 7, d = q & 127; float m = 0.f, n = 0.f;
#pragma unroll 1
            for (int c0 = 0; c0 < 64; c0 += 16) {
                float dn[16], bl[16], ml[16];
#pragma unroll
                for (int j = 0; j < 16; ++j) { const int item = bh * 64 + c0 + j; dn[j] = DN[(size_t)item * 128 + d]; bl[j] = BLAST[item]; ml[j] = MLOC[item]; }
#pragma unroll
                for (int j = 0; j < 16; ++j) { const int item = bh * 64 + c0 + j; DN[(size_t)item * 128 + d] = n;
                    const float mn = fmaxf(bl[j] + m, ml[j]), dec = __expf(bl[j] + m - mn), wl = __expf(ml[j] - mn); n = dec * n + wl * dn[j]; m = mn; }
            }
        }
    }
    MIX_BARRIER();
    for (int rep_ = 0; rep_ < NREP(9); ++rep_) if (rep_ == 0 || (xcd_barrier(bar), true))
    {
        const GAS float* lbl = (const GAS float*)INP(I_LBL); const GAS float* mhn = (const GAS float*)INP(I_MHN); const GAS float* hhn = (const GAS float*)INP(I_HHN);
        const GAS float* gates = (const GAS float*)(smallf + SM_GATES / 4); const GAS float* MPREV = (const GAS float*)(smallf + SM_MPREV / 4); const GAS float* NPREV = (const GAS float*)(smallf + SM_DN / 4);
        int tid9 = threadIdx.x; asm volatile("" : "+v"(tid9));
        const OutPtrs OP{gates, MPREV, NPREV, (const GAS bf16*)(ws + AR_QC), (const GAS bf16*)(ws + AR_KC), (const GAS bf16*)(ws + AR_MV), (const GAS bf16*)(ws + AR_MST),
                         (const GAS bf16*)(ws + AR_HQ), (const GAS bf16*)(ws + AR_HF), (const GAS bf16*)(ws + AR_HI), (const GAS bf16*)(ws + AR_HST)};
        {   MoRegs rm;
            if (m0 < m1) { if (tid9 < 64) *(LAS f32x4*)(lds + 4096 + 17408 * 2 + 9216 + 36864 + 69632 + tid9 * 16) = *(const GAS f32x4*)(mhn + ((m0 >> 6) & 3) * 256 + tid9 * 4);
                             mo_load(m0, tid9, OP, rm); }
#pragma unroll 1
            for (int item = m0; item < m1; item += ms)
                mlstm_out_item(lds, item, tid9, OP, rm, (item + ms < m1) ? item + ms : (1 << 20), (const GAS bf16*)(ws + AR_MO), mhn, (GAS bf16*)(ws + AR_YM));
        }
        {   HoRegs rh; const int first = 512 + h0;
            if (h0 < h1) {
                LAS float* LBV = (LAS float*)(lds + 4096 + 32768 + 17408 * 3 + 9216 + 18432 + 34816);
                LBV[tid9] = sigmoidf_(lbl[1024 + tid9] - lbl[tid9]); LBV[512 + tid9] = sigmoidf_(lbl[1536 + tid9] - lbl[512 + tid9]);
                LBV[1024 + tid9] = hhn[tid9]; LBV[1536 + tid9] = hhn[512 + tid9];
                __syncthreads();
                ho_load(first - 512, tid9, OP, rh); }
#pragma unroll 1
            for (int item = first; item < 512 + h1; item += ms)
                hgrn_out_item(lds, item - 512, tid9, OP, rh, (item + ms < 512 + h1) ? item + ms : (1 << 20), (const GAS bf16*)(ws + AR_HG), lbl, hhn, (GAS bf16*)(ws + AR_YH));
        }
    }

    for (int rep_ = 0; rep_ < NREP(10); ++rep_) if (rep_ == 0 || (xcd_barrier(bar), true))
    { SchedStd S; S.o.init(32, 16, G, bid); if (LOCM) S.o.init_loc(16, 4 * xq, lrk);
      S.A = (const char*)XB; S.B = (const char*)(ws + WS_WG); S.astep = 256 * D * 2; S.bstep = 256 * D * 2; S.bbatch = 0; S.nt = 32;
      EpiGates E{(bf16*)(ws + AR_GM), (bf16*)(ws + AR_GH), ss + 1 * M};
      pg8::gemm_phase((const char*)ws, lds, D, D, S, E); }
    xcd_barrier(bar);
    const bool LOC = (MISC[11] != 0u);
    const int lrank = (int)MISC[10], lp0 = 4 * (int)bar.x;
    unsigned* rdyW13 = ctl + 12288; unsigned* rdyW2T = ctl + 12352;
#define PHASE_BARRIER() do { if (LOC) xcd_local_barrier(bar, lrank & 3, ctl + 13312); else xcd_barrier(bar); } while (0)
    for (int rep_ = 0; rep_ < NREP(11); ++rep_) if (rep_ == 0 || (xcd_barrier(bar), true))
    { SchedPair S{G, bid, (const char*)(ws + AR_YM), (const char*)(ws + AR_YH), (const char*)(ws + WS_WPM), (const char*)(ws + WS_WPH), 0, 0};
      if (LOC) { S.loc = 1; S.p0 = lp0; S.c = lrank; }
      EpiProj E{(const bf16*)(ws + AR_GM), (const bf16*)(ws + AR_GH), (bf16*)(ws + AR_MERGED)};
      pg8::gemm_phase((const char*)ws, lds, 1024, 1024, S, E); }
    PHASE_BARRIER();
    for (int rep_ = 0; rep_ < NREP(12); ++rep_) if (rep_ == 0 || (xcd_barrier(bar), true))
    { SchedStd S; S.o.init(32, 8, G, bid); if (LOC) S.o.init_loc(8, lp0, lrank);
      S.A = (const char*)(ws + AR_MERGED); S.B = (const char*)(ws + WS_WOUT); S.astep = 256 * D * 2; S.bstep = 256 * D * 2; S.bbatch = 0; S.nt = 32;
      EpiRes<false> E{nullptr, XB, ss + 2 * M, 1.0f};
      pg8::gemm_phase((const char*)ws, lds, D, D, S, E); }
    PHASE_BARRIER();
    for (int rep_ = 0; rep_ < NREP(13); ++rep_) if (rep_ == 0 || (xcd_barrier(bar), true))
    { SchedStd S; S.o.init(32, 4, G, bid); if (LOC) S.o.init_loc(4, lp0, lrank);
      S.A = (const char*)XB; S.B = (const char*)(ws + WS_WQKT); S.astep = 256 * D * 2; S.bstep = 256 * D * 2; S.bbatch = (size_t)1024 * D * 2; S.nt = 32;
      EpiScores E{(bf16*)(ws + AR_P), ss + 2 * M, (LAS float*)(lds + RING_BYTES)};
      pg8::gemm_phase((const char*)ws, lds, D, D, S, E);
      const int cfirst = (G > 128) ? 128 : 0, nconv = (G - cfirst) * NWAVES;
      const bool copier = LOC ? (lrank >= 16) : (bid >= cfirst); const int cidx = LOC ? ((int)bar.x * 16 + lrank - 16) : (bid - cfirst);
      if (copier) {
          const float* w1 = INP(I_F2W1); const float* w3 = INP(I_F2W3); const float* w2 = INP(I_F2W2); const float* gn = INP(I_NFFN2);
          const int nit = (G == 256) ? 11264 : N_FFN_ITEMS;
#pragma unroll 1
          for (int base = cidx * NWAVES + wave; base < nit; base += 4 * nconv) {
              CvtDesc d[4]; f32x4 v[4][8];
#pragma unroll
              for (int u = 0; u < 4; ++u) { const int it = base + u * nconv; if (it < nit) { d[u] = ffn_desc(it, w1, w3, w2, gn, (bf16*)(ws + WS_W13), (bf16*)(ws + WS_W2T)); cvt_load(d[u], lane, v[u]); } }
#pragma unroll
              for (int u = 0; u < 4; ++u) { const int it = base + u * nconv; if (it < nit) cvt_store(d[u], lane, v[u]); }
          }
          if (LOC) publish_count(rdyW13);
      } }
    PHASE_BARRIER();
    for (int rep_ = 0; rep_ < NREP(15); ++rep_) if (rep_ == 0 || (xcd_barrier(bar), true))
    { SchedStd S; S.o.init(32, 8, G, bid); if (LOC) S.o.init_loc(8, lp0, lrank);
      S.A = (const char*)(ws + AR_P); S.B = (const char*)(ws + WS_VWOT); S.astep = 256 * 1024 * 2; S.bstep = 256 * 1024 * 2; S.bbatch = (size_t)2048 * 1024 * 2; S.nt = 16;
      EpiRes<false> E{nullptr, XB, ss + 3 * M, 1.0f};
      pg8::gemm_phase((const char*)ws, lds, 1024, 1024, S, E); }
    if (LOC) await_before_barrier(rdyW13, 128u, bar.bar);
    PHASE_BARRIER();
    for (int rep_ = 0; rep_ < NREP(16); ++rep_) if (rep_ == 0 || (xcd_barrier(bar), true))
    { SchedStd S; S.o.init(32, 44, G, bid); if (LOC) S.o.init_loc(44, lp0, lrank);
      S.A = (const char*)XB; S.B = (const char*)(ws + WS_W13); S.astep = 256 * D * 2; S.bstep = 256 * D * 2; S.bbatch = 0; S.nt = 32;
      EpiUp E{(bf16*)(ws + AR_ACT), ss + 3 * M};
      pg8::gemm_phase((const char*)ws, lds, D, D, S, E);
      const bool copier16 = LOC ? (lrank >= 16) : (bid >= 128); const int cidx16 = LOC ? ((int)bar.x * 16 + lrank - 16) : (bid - 128);
      if (G == 256 && copier16) {
          const float* w1 = INP(I_F2W1); const float* w3 = INP(I_F2W3); const float* w2 = INP(I_F2W2); const float* gn = INP(I_NFFN2); const int nconv = 128 * NWAVES;
          int ln16 = threadIdx.x & 63; asm volatile("" : "+v"(ln16));
#pragma unroll 1
          for (int base = 11264 + cidx16 * NWAVES + wave; base < N_FFN_ITEMS; base += 4 * nconv) {
              CvtDesc d[4]; f32x4 v[4][8];
#pragma unroll
              for (int u = 0; u < 4; ++u) { const int it = base + u * nconv; if (it < N_FFN_ITEMS) { d[u] = ffn_desc(it, w1, w3, w2, gn, (bf16*)(ws + WS_W13), (bf16*)(ws + WS_W2T)); cvt_load(d[u], ln16, v[u]); } }
#pragma unroll
              for (int u = 0; u < 4; ++u) { const int it = base + u * nconv; if (it < N_FFN_ITEMS) cvt_store(d[u], ln16, v[u]); }
          }
          if (LOC) publish_count(rdyW2T);
      } }
    if (LOC) await_before_barrier(rdyW2T, 128u, bar.bar);
    PHASE_BARRIER();
    if (G == 256) {
        SchedStd S; S.o.init(32, 8, G, bid); if (LOC) S.o.init_loc(8, lp0, lrank); S.A = (const char*)(ws + AR_ACT); S.B = (const char*)(ws + WS_W2T); S.astep = (size_t)256 * FF * 2; S.bstep = (size_t)256 * FF * 2; S.bbatch = 0; S.nt = FF / 64;
        EpiResFinal E{XB, (float*)kargs[28], INP(I_NFIN), ss + 4 * M, ctl + CW_PANEL, 0.5f};
        pg8::gemm_phase((const char*)ws, lds, FF, FF, S, E);
    } else {
        { SchedStd S; S.o.init(32, 8, G, bid); S.A = (const char*)(ws + AR_ACT); S.B = (const char*)(ws + WS_W2T); S.astep = (size_t)256 * FF * 2; S.bstep = (size_t)256 * FF * 2; S.bbatch = 0; S.nt = FF / 64;
          EpiRes<false> E{nullptr, XB, ss + 4 * M, 0.5f};
          pg8::gemm_phase((const char*)ws, lds, FF, FF, S, E); }
        xcd_barrier(bar);
        for (int row = gw; row < M; row += NGW) {
            const float r = rinv_of(ss + 4 * M, row);
            const u32x2* src = (const u32x2*)(XB + (size_t)row * D) + lane; const f32x4* gp = (const f32x4*)INP(I_NFIN) + lane; f32x4* dst = (f32x4*)((float*)kargs[28] + (size_t)row * D) + lane;
#pragma unroll
            for (int j = 0; j < 8; ++j) { const u32x2 xw = src[64 * j]; const f32x4 xv = {lo_bf(xw.x), hi_bf(xw.x), lo_bf(xw.y), hi_bf(xw.y)}; dst[64 * j] = xv * r * gp[64 * j]; }
        }
    }
}

extern "C" void kernel_launch(void* const* d_in, const int* in_sizes, int n_in, void* d_out, int out_size, void* d_ws, size_t ws_size, hipStream_t stream) {
    static int grid = 0;
    if (grid == 0) {
        if (n_in != 28 || in_sizes[0] != M * D || out_size != M * D || ws_size < WS_END) {
            fprintf(stderr, "kernel_launch: unexpected problem: n_in %d in0 %d out %d ws %zu (need %zu)\n", n_in, n_in > 0 ? in_sizes[0] : -1, out_size, ws_size, (size_t)WS_END); grid = -1; return; }
        int dev = 0, cus = 0;
        if (hipGetDevice(&dev) != hipSuccess || hipDeviceGetAttribute(&cus, hipDeviceAttributeMultiprocessorCount, dev) != hipSuccess) { fprintf(stderr, "kernel_launch: device query failed\n"); grid = -1; return; }
        if (hipFuncSetAttribute((const void*)fwd_kernel, hipFuncAttributeMaxDynamicSharedMemorySize, LDS_BYTES) != hipSuccess) { fprintf(stderr, "kernel_launch: hipFuncSetAttribute failed\n"); grid = -1; return; }
        int per_cu = 0;
        if (hipOccupancyMaxActiveBlocksPerMultiprocessor(&per_cu, (const void*)fwd_kernel, NTHR, LDS_BYTES) != hipSuccess || per_cu < 1) fprintf(stderr, "kernel_launch: note: occupancy query reports %d\n", per_cu);
        (void)hipGetLastError();
        grid = cus;
    }
    if (grid < 0) return;
    if (hipMemsetAsync((char*)d_ws + WS_CTL, 0, CTL_ZERO_BYTES, stream) != hipSuccess) { fprintf(stderr, "kernel_launch: memset failed\n"); return; }
    Args a{};
    for (int i = 0; i < 28; ++i) a.in[i] = (const float*)d_in[i];
    a.out = (float*)d_out; a.ws = (unsigned char*)d_ws;
    hipLaunchKernelGGL(fwd_kernel, dim3(grid), dim3(NTHR), LDS_BYTES, stream, a);
}
```
